# Optimizing an MI355X kernel written in HIP

```python
import math
import jax, jax.numpy as jnp
from jax import lax
import numpy as np


D_MODEL = 2048
BATCH = 8
SEQ = 2048
DEPTH = 2

CHUNK = 64
Q_BLOCK = 128
FOX_HEADS = 8
FOX_HEAD_DIM = 128
FOX_WIDTH = FOX_HEADS * FOX_HEAD_DIM
RET_HEADS = 8
RET_QK_DIM = 128
RET_V_DIM = 256
RET_QK_WIDTH = RET_HEADS * RET_QK_DIM
RET_V_WIDTH = RET_HEADS * RET_V_DIM
ROPE_BASE = 10000.0
N_GROUPS = 4
EXPERTS_PER_GROUP = 8
N_EXPERTS = N_GROUPS * EXPERTS_PER_GROUP
TOP_K = 2
D_EXPERT = 512
DEEPNORM_ALPHA = (2.0 * DEPTH) ** 0.25
DEEPNORM_BETA = (8.0 * DEPTH) ** -0.25
LN_EPS = 1e-5
RMS_EPS = 1e-6
IN_SIZES = (FOX_WIDTH, FOX_WIDTH, FOX_WIDTH, FOX_HEADS,
            RET_QK_WIDTH, RET_QK_WIDTH, RET_V_WIDTH, RET_V_WIDTH,
            D_MODEL, D_MODEL)
IN_WIDTH = sum(IN_SIZES)
VALUE_SLOTS = (2, 6)

kernel_name = 'hybrid_fox_retention_hmoe_deepnorm'


def layer_norm(x, g, b):
    xf = x.astype(jnp.float32)
    mu = jnp.mean(xf, axis=-1, keepdims=True)
    var = jnp.mean(jnp.square(xf - mu), axis=-1, keepdims=True)
    y = (xf - mu) * lax.rsqrt(var + LN_EPS) * g.astype(jnp.float32) + b.astype(jnp.float32)
    return y.astype(x.dtype)


def head_rms_norm(y):
    yf = y.astype(jnp.float32)
    return (yf * lax.rsqrt(jnp.mean(yf * yf, axis=-1, keepdims=True) + RMS_EPS)).astype(y.dtype)


def split_columns(proj):
    outs = []
    start = 0
    for size in IN_SIZES:
        outs.append(proj[..., start:start + size])
        start += size
    return outs


def to_heads(t, n_heads):
    b, s, w = t.shape
    return t.reshape(b, s, n_heads, w // n_heads).transpose(0, 2, 1, 3)


def from_heads(t):
    b, h, s, d = t.shape
    return t.transpose(0, 2, 1, 3).reshape(b, s, h * d)


def rotary(x, pos):
    half = x.shape[-1] // 2
    inv_freq = ROPE_BASE ** (-jnp.arange(half, dtype=jnp.float32) / half)
    ang = pos.astype(jnp.float32)[:, None] * inv_freq[None, :]
    cos = jnp.cos(ang).astype(x.dtype)
    sin = jnp.sin(ang).astype(x.dtype)
    x1, x2 = x[..., :half], x[..., half:]
    return jnp.concatenate([x1 * cos - x2 * sin, x1 * sin + x2 * cos], axis=-1)


def forgetting_attention(q, k, v, log_f):
    seq = q.shape[2]
    scale = FOX_HEAD_DIM ** -0.5
    cum = jnp.cumsum(log_f, axis=-1)
    outs = []
    for i in range(seq // Q_BLOCK):
        q0, q1 = i * Q_BLOCK, (i + 1) * Q_BLOCK
        logits = jnp.einsum('bhqd,bhkd->bhqk', q[:, :, q0:q1], k[:, :, :q1],
                            preferred_element_type=jnp.float32) * scale
        logits = logits + cum[:, :, q0:q1, None] - cum[:, :, None, :q1]
        t_idx = jnp.arange(q0, q1)[:, None]
        s_idx = jnp.arange(q1)[None, :]
        logits = jnp.where(s_idx <= t_idx, logits, -jnp.inf)
        p = jax.nn.softmax(logits, axis=-1)
        outs.append(jnp.einsum('bhqk,bhkd->bhqd', p.astype(v.dtype), v[:, :, :q1]))
    return jnp.concatenate(outs, axis=2)


def retention(q, k, v):
    b, h, seq, dk = q.shape
    dv = v.shape[-1]
    n_chunks = seq // CHUNK
    log_gamma = jnp.log1p(-(2.0 ** (-5.0 - jnp.arange(h, dtype=jnp.float32))))
    pos = jnp.arange(CHUNK, dtype=jnp.float32)
    intra_decay = jnp.exp(log_gamma[:, None, None] * jnp.abs(pos[:, None] - pos[None, :]))
    key_decay = jnp.exp(log_gamma[:, None] * (CHUNK - 1 - pos))[:, :, None]
    query_decay = jnp.exp(log_gamma[:, None] * (pos + 1.0))[:, :, None]
    chunk_decay = jnp.exp(log_gamma * CHUNK)[:, None, None]
    k = k * (dk ** -0.5)

    def to_chunks(t):
        return jnp.moveaxis(t.reshape(b, h, n_chunks, CHUNK, t.shape[-1]), 2, 0)

    def step(state, inp):
        qc, kc, vc = inp
        scores = jnp.einsum('bhcd,bhmd->bhcm', qc, kc) * intra_decay
        intra = jnp.einsum('bhcm,bhmv->bhcv', scores, vc)
        cross = jnp.einsum('bhcd,bhdv->bhcv', qc, state) * query_decay
        new_state = state * chunk_decay + jnp.einsum('bhmd,bhmv->bhdv', kc * key_decay, vc)
        return new_state, intra + cross

    state0 = jnp.zeros((b, h, dk, dv), jnp.float32)
    _, out = lax.scan(step, state0, (to_chunks(q), to_chunks(k), to_chunks(v)))
    out = jnp.moveaxis(out, 0, 2).reshape(b, h, seq, dv)
    return out.astype(v.dtype)


def token_mixers(h, w_in, b_forget, w_branch_fox, w_branch_ret, w_out):
    seq = h.shape[1]
    proj = h @ w_in
    fq, fk, fv, ff, rq, rk, rv, rg, gate_fox, gate_ret = split_columns(proj)
    log_f = jax.nn.log_sigmoid(ff.astype(jnp.float32) + b_forget.astype(jnp.float32))
    y_fox = forgetting_attention(to_heads(fq, FOX_HEADS), to_heads(fk, FOX_HEADS),
                                 to_heads(fv, FOX_HEADS), log_f.transpose(0, 2, 1))
    y_fox = from_heads(y_fox)
    pos = jnp.arange(seq, dtype=jnp.int32)
    y_ret = retention(rotary(to_heads(rq, RET_HEADS), pos), rotary(to_heads(rk, RET_HEADS), pos),
                      to_heads(rv, RET_HEADS))
    y_ret = jax.nn.silu(rg) * from_heads(head_rms_norm(y_ret))
    merged = jax.nn.sigmoid(gate_fox) * (y_fox @ w_branch_fox) + jax.nn.sigmoid(gate_ret) * (y_ret @ w_branch_ret)
    return merged @ w_out


def hierarchical_moe(h, w_router_group, b_router_group, w_router_expert, b_router_expert,
                     w_gate, w_up, w_down):
    b, s, d = h.shape
    n = b * s
    t = h.reshape(n, d)
    grp_prob = jax.nn.softmax((t @ w_router_group).astype(jnp.float32) + b_router_group.astype(jnp.float32), axis=-1)
    grp_w, grp_idx = lax.top_k(grp_prob, 1)
    exp_logits = ((t @ w_router_expert).astype(jnp.float32)
                  + b_router_expert.astype(jnp.float32)).reshape(n, N_GROUPS, EXPERTS_PER_GROUP)
    chosen = exp_logits[jnp.arange(n), grp_idx[:, 0]]
    top_w, top_idx = lax.top_k(jax.nn.softmax(chosen, axis=-1), TOP_K)
    top_w = top_w / jnp.sum(top_w, axis=-1, keepdims=True) * grp_w
    flat_idx = grp_idx * EXPERTS_PER_GROUP + top_idx
    combine = jnp.einsum('nk,nkx->nx', top_w, jax.nn.one_hot(flat_idx, N_EXPERTS, dtype=jnp.float32))
    combine = combine.reshape(n, N_GROUPS, EXPERTS_PER_GROUP).astype(h.dtype)
    out = jnp.zeros((n, d), h.dtype)
    for g in range(N_GROUPS):
        hid = jax.nn.silu(jnp.einsum('nd,edf->nef', t, w_gate[g])) * jnp.einsum('nd,edf->nef', t, w_up[g])
        out = out + jnp.einsum('nef,efd->nd', hid * combine[:, g, :, None], w_down[g])
    return out.reshape(b, s, d)


def setup_inputs(seed: int = 0) -> dict:
    key = jax.random.key(seed)
    ks = jax.random.split(key, 24)
    f32 = jnp.float32
    nrm = lambda k, shape, scale: jax.random.normal(k, shape, f32) * scale
    x = jax.random.normal(ks[0], (BATCH, SEQ, D_MODEL), f32)
    ln_in_g = 1.0 + nrm(ks[1], (D_MODEL,), 0.02)
    ln_in_b = nrm(ks[2], (D_MODEL,), 0.02)
    col_scale = jnp.concatenate([jnp.full((size,), DEEPNORM_BETA if i in VALUE_SLOTS else 1.0, f32)
                                 for i, size in enumerate(IN_SIZES)])
    w_in = nrm(ks[3], (DEPTH, D_MODEL, IN_WIDTH), D_MODEL ** -0.5) * col_scale
    b_forget = 2.0 + 4.0 * jax.random.uniform(ks[4], (DEPTH, FOX_HEADS), f32)
    w_branch_fox = nrm(ks[5], (DEPTH, FOX_WIDTH, D_MODEL), FOX_WIDTH ** -0.5 * DEEPNORM_BETA)
    w_branch_ret = nrm(ks[6], (DEPTH, RET_V_WIDTH, D_MODEL), RET_V_WIDTH ** -0.5 * DEEPNORM_BETA)
    w_out = nrm(ks[7], (DEPTH, D_MODEL, D_MODEL), D_MODEL ** -0.5 * DEEPNORM_BETA)
    ln1_g = 1.0 + nrm(ks[8], (DEPTH, D_MODEL), 0.02)
    ln1_b = nrm(ks[9], (DEPTH, D_MODEL), 0.02)
    w_router_group = nrm(ks[10], (DEPTH, D_MODEL, N_GROUPS), D_MODEL ** -0.5)
    b_router_group = nrm(ks[11], (DEPTH, N_GROUPS), 0.01)
    w_router_expert = nrm(ks[12], (DEPTH, D_MODEL, N_EXPERTS), D_MODEL ** -0.5)
    b_router_expert = nrm(ks[13], (DEPTH, N_EXPERTS), 0.01)
    w_gate = nrm(ks[14], (DEPTH, N_GROUPS, EXPERTS_PER_GROUP, D_MODEL, D_EXPERT), D_MODEL ** -0.5 * DEEPNORM_BETA)
    w_up = nrm(ks[15], (DEPTH, N_GROUPS, EXPERTS_PER_GROUP, D_MODEL, D_EXPERT), D_MODEL ** -0.5 * DEEPNORM_BETA)
    w_down = nrm(ks[16], (DEPTH, N_GROUPS, EXPERTS_PER_GROUP, D_EXPERT, D_MODEL), D_EXPERT ** -0.5 * DEEPNORM_BETA)
    ln2_g = 1.0 + nrm(ks[17], (DEPTH, D_MODEL), 0.02)
    ln2_b = nrm(ks[18], (DEPTH, D_MODEL), 0.02)
    return {'x': x, 'ln_in_g': ln_in_g, 'ln_in_b': ln_in_b, 'w_in': w_in, 'b_forget': b_forget,
            'w_branch_fox': w_branch_fox, 'w_branch_ret': w_branch_ret, 'w_out': w_out,
            'ln1_g': ln1_g, 'ln1_b': ln1_b,
            'w_router_group': w_router_group, 'b_router_group': b_router_group,
            'w_router_expert': w_router_expert, 'b_router_expert': b_router_expert,
            'w_gate': w_gate, 'w_up': w_up, 'w_down': w_down, 'ln2_g': ln2_g, 'ln2_b': ln2_b}


def reference(x, ln_in_g, ln_in_b, w_in, b_forget, w_branch_fox, w_branch_ret, w_out,
              ln1_g, ln1_b, w_router_group, b_router_group, w_router_expert, b_router_expert,
              w_gate, w_up, w_down, ln2_g, ln2_b):
    h = layer_norm(x, ln_in_g, ln_in_b)
    for l in range(DEPTH):
        mix = token_mixers(h, w_in[l], b_forget[l], w_branch_fox[l], w_branch_ret[l], w_out[l])
        h = layer_norm(DEEPNORM_ALPHA * h + mix, ln1_g[l], ln1_b[l])
        ffn = hierarchical_moe(h, w_router_group[l], b_router_group[l], w_router_expert[l],
                               b_router_expert[l], w_gate[l], w_up[l], w_down[l])
        h = layer_norm(DEEPNORM_ALPHA * h + ffn, ln2_g[l], ln2_b[l])
    return h
```

```cpp
#include <hip/hip_runtime.h>
#include <cstdio>
#include <cstdint>

#ifndef MK_N_LAUNCHES
#define MK_N_LAUNCHES 1
#endif

#define LAS __attribute__((address_space(3)))
#define GAS __attribute__((address_space(1)))
typedef unsigned short bf16_t;
typedef short bf16x8 __attribute__((ext_vector_type(8)));
typedef short s16x4 __attribute__((ext_vector_type(4)));
typedef float f32x4 __attribute__((ext_vector_type(4)));
typedef float f32x2 __attribute__((ext_vector_type(2)));
typedef float f32x16 __attribute__((ext_vector_type(16)));
typedef unsigned u32x4 __attribute__((ext_vector_type(4)));
typedef unsigned u32x2 __attribute__((ext_vector_type(2)));
typedef GAS unsigned gu32;
#define RLX_AGENT __ATOMIC_RELAXED, __HIP_MEMORY_SCOPE_AGENT
#define LDS_WAIT() asm volatile("s_waitcnt lgkmcnt(0)" ::: "memory")
#define VM_WAIT() asm volatile("s_waitcnt vmcnt(0)" ::: "memory")
#define SBAR() __builtin_amdgcn_sched_barrier(0)

constexpr int NTOK = 16384, DM = 2048, SEQ = 2048, NBATCH = 8, NLAYER = 2;
constexpr int NPROJ = 13312;
constexpr int C_FQ = 0, C_FK = 1024, C_FV = 2048, C_RQ = 3072, C_RK = 4096, C_RV = 5120, C_RG = 7168, C_GF = 9216, C_GR = 11264;
constexpr int W_IN_COLS = 13320;
constexpr int NEXP = 32, DEXP = 512;
constexpr int HID_ROWS = 40960;
constexpr float ALPHA = 1.4142135623730951f;
constexpr float LN_EPS = 1e-5f, RMS_EPS = 1e-6f;
constexpr float LOG2E = 1.4426950408889634f;
constexpr float QSCALE = 0.08838834764831845f * LOG2E;
constexpr float KSCALE = 0.08838834764831845f;

constexpr size_t MiB = 1u << 20;
constexpr size_t WS_CTL = 0, CTL_ZERO_BYTES = 1 * MiB;
constexpr size_t WS_ROPE = 1 * MiB;
constexpr size_t WS_SKW = 2 * MiB;
constexpr size_t SKW_FGT_BYTES = 16 * 2048 * 2 * 2, SKW_RTR_BYTES = 48 * 2048 * 2 * 2;
constexpr size_t WS_SKS = 3 * MiB;
constexpr size_t WS_LOGF = 3 * MiB + 512 * 1024;
constexpr size_t WS_ROUTE = 4 * MiB;
constexpr size_t WS_LIST = 5 * MiB;
constexpr size_t WS_WLIST = 7 * MiB;
constexpr size_t WS_W = 16 * MiB;
constexpr size_t WL_WIN = 0, WL_WBF = 52 * MiB, WL_WBR = 56 * MiB, WL_WOUT = 64 * MiB, WL_WGU = 72 * MiB, WL_WD = 200 * MiB, WL_BYTES = 264 * MiB;
constexpr size_t WS_HF = 280 * MiB;
constexpr size_t WS_HB = 408 * MiB;
constexpr size_t WS_YF = 472 * MiB, WS_YR = 504 * MiB, WS_MG = 568 * MiB;
constexpr size_t WS_PROJ = 632 * MiB;
constexpr size_t WS_Z1 = WS_PROJ, WS_HID = WS_PROJ + 128 * MiB, WS_FFO = WS_PROJ + 168 * MiB;
constexpr size_t WS_END = 1048 * MiB;
static_assert(WS_FFO + (size_t)HID_ROWS * 2048 * 2 <= WS_END && WS_HID + (size_t)HID_ROWS * 512 * 2 <= WS_FFO, "overlay map");
constexpr int CW_TMO = 0;
constexpr int CW_BAR = 4096;
constexpr int CW_QUEUE = 8192;
constexpr int CW_CNT = 9216;

constexpr int RING_BYTES = 131072;
constexpr int LDSCTL_OFF = RING_BYTES;
constexpr int MISC_OFF = LDSCTL_OFF;
constexpr int MOE_OFF = LDSCTL_OFF + 256;
constexpr int LNS_OFF = LDSCTL_OFF + 1024;
constexpr int LDS_BYTES = 163840;

__device__ __forceinline__ unsigned cvt_pk_bf16(float lo, float hi) { unsigned r; asm volatile("v_cvt_pk_bf16_f32 %0, %1, %2" : "=v"(r) : "v"(lo), "v"(hi)); return r; }
__device__ __forceinline__ unsigned f2bf(float f) { unsigned u = __builtin_bit_cast(unsigned, f); return (u + 0x7fffu + ((u >> 16) & 1u)) >> 16; }
__device__ __forceinline__ unsigned pk2(float lo, float hi) { return f2bf(lo) | (f2bf(hi) << 16); }
__device__ __forceinline__ float bf2f(unsigned short b) { return __builtin_bit_cast(float, ((unsigned)b) << 16); }
__device__ __forceinline__ float bflo(unsigned w) { return __builtin_bit_cast(float, w << 16); }
__device__ __forceinline__ float bfhi(unsigned w) { return __builtin_bit_cast(float, w & 0xffff0000u); }
__device__ __forceinline__ float fast_sigmoid(float x) { return __builtin_amdgcn_rcpf(1.0f + __builtin_amdgcn_exp2f(-x * LOG2E)); }
__device__ __forceinline__ int opaque_tid() { int t = threadIdx.x; asm volatile("" : "+v"(t)); return t; }
namespace gm {
constexpr int BM = 256, BK = 64, HALF = 128, HTB = HALF * BK * 2, STAGE_BYTES = 8 * HTB, NXCD = 8, WGM = 8;
__host__ __device__ __forceinline__ int lds_byte(int r, int c) { const int st = (r >> 4) * 2 + (c >> 5), rr = r & 15, cc = c & 31, ob = rr * 64 + cc * 2; return st * 1024 + (ob ^ (((ob >> 9) & 1) << 5)); }
__host__ __device__ __forceinline__ void stage_rc(int b, int& R, int& C) { const int st = b / 1024, sb = b % 1024, swz = sb ^ (((sb >> 9) & 1) << 5); R = (st >> 1) * 16 + swz / 64; C = (st & 1) * 32 + (swz % 64) / 2; }
__host__ __device__ __forceinline__ int perm32(int rho) { const int n = rho >> 4, i = rho & 15; return 8 * (i >> 2) + 4 * n + (i & 3); }

struct Unit {
    const char* A;
    const char* B;
    unsigned lda, ldb;
    int nt;
    int pm, pn;
    int kind;
    int e, rows;
    int keep;
};
__device__ __forceinline__ bool static_tile(int L, int nM, int nN, int& pm, int& pn) {
    const int nwg = nM * nN; if (L >= nwg) return false;
    int wgid = L; { const int q = nwg / NXCD, r = nwg % NXCD, xcd = wgid % NXCD, off = wgid / NXCD; wgid = (xcd < r ? xcd * (q + 1) : r * (q + 1) + (xcd - r) * q) + off; }
    const int nig = WGM * nN, gid = wgid / nig, fm = gid * WGM, gsz = (nM - fm) < WGM ? (nM - fm) : WGM;
    pm = fm + ((wgid % nig) % gsz); pn = (wgid % nig) / gsz; return true;
}

template <bool PERM, class Sched, class Epi>
__device__ __forceinline__ void gemm_phase(LAS unsigned char* lds, const Sched& S, const Epi& E) {
    const int tid = opaque_tid(), wid = __builtin_amdgcn_readfirstlane(tid >> 6), lane = tid & 63, wr = wid >> 2, wc = wid & 3, fr = lane & 15, fq = lane >> 4;
    int Rr[2], Cc[2], Rb[2];
#pragma unroll
    for (int i = 0; i < 2; ++i) { int R, C; stage_rc(tid * 16 + i * 8192, R, C); Rr[i] = R; Cc[i] = C; Rb[i] = PERM ? ((R & ~31) + perm32(R & 31)) : R; }
    const unsigned ldsw = (unsigned)wid * 1024u;
    const int aoff = lds_byte(wr * 64 + fr, fq * 8), boff = lds_byte(wc * 32 + fr, fq * 8);
#define PG8_SA(b, h) (((b) * 2 + (h)) * HTB)
#define PG8_SB(b, h) ((4 + (b) * 2 + (h)) * HTB)
#define PG8_STAGE(bufoff, gbase, voff) do { _Pragma("unroll") for (int _i = 0; _i < 2; ++_i) \
        __builtin_amdgcn_global_load_lds((const unsigned*)((const char*)(gbase) + (voff)[_i]), (LAS unsigned*)(lds + (bufoff) + ldsw + _i * 8192), 16, 0, 0); } while (0)
#define PG8_LDA(dst, b, h) do { _Pragma("unroll") for (int m = 0; m < 4; ++m) _Pragma("unroll") for (int k = 0; k < 2; ++k) dst[m][k] = *(const LAS bf16x8*)(lds + PG8_SA(b, h) + aoff + m * 2048 + k * 1024); } while (0)
#define PG8_LDB(dst, b, h) do { _Pragma("unroll") for (int n = 0; n < 2; ++n) _Pragma("unroll") for (int k = 0; k < 2; ++k) dst[n][k] = *(const LAS bf16x8*)(lds + PG8_SB(b, h) + boff + n * 2048 + k * 1024); } while (0)
#define PG8_MMA(ai, bj, At, Bt) do { __builtin_amdgcn_s_setprio(1); _Pragma("unroll") for (int m = 0; m < 4; ++m) _Pragma("unroll") for (int n = 0; n < 2; ++n) _Pragma("unroll") for (int k = 0; k < 2; ++k) \
        acc[ai][bj][m][n] = __builtin_amdgcn_mfma_f32_16x16x32_bf16(Bt[n][k], At[m][k], acc[ai][bj][m][n], 0, 0, 0); __builtin_amdgcn_s_setprio(0); } while (0)
#define PG8_WAIT_V(n) asm volatile("s_waitcnt vmcnt(" #n ")" ::: "memory")
#define PG8_WAIT_L(n) asm volatile("s_waitcnt lgkmcnt(" #n ")" ::: "memory")
#define PG8_BAR __builtin_amdgcn_s_barrier()
#define PG8_SCHED __builtin_amdgcn_sched_barrier(0)
#define PG8_OFFS(u, tk) do { _Pragma("unroll") for (int _i = 0; _i < 2; ++_i) { \
        vA0[_i] = (Sched::GATHER ? (unsigned)tk[_i] : (unsigned)Rr[_i]) * (u).lda + (unsigned)Cc[_i] * 2u; vA1[_i] = (Sched::GATHER ? (unsigned)tk[2 + _i] : (unsigned)(HALF + Rr[_i])) * (u).lda + (unsigned)Cc[_i] * 2u; \
        vB[_i] = (unsigned)Rb[_i] * (u).ldb + (unsigned)Cc[_i] * 2u; } } while (0)
#define PG8_TOKS(u, tk) do { if (Sched::GATHER) { tk[0] = S.tok(u, Rr[0]); tk[1] = S.tok(u, Rr[1]); tk[2] = S.tok(u, HALF + Rr[0]); tk[3] = S.tok(u, HALF + Rr[1]); } } while (0)
    Unit cur, nxt; int ui = 0;
    if (!S.next(0, cur)) return;
    f32x4 acc[2][2][4][2];
#pragma unroll
    for (int a = 0; a < 2; ++a)
#pragma unroll
        for (int b = 0; b < 2; ++b)
#pragma unroll
            for (int m = 0; m < 4; ++m)
#pragma unroll
                for (int n = 0; n < 2; ++n) acc[a][b][m][n] = (f32x4){0.f, 0.f, 0.f, 0.f};
    bf16x8 At[4][2], B0[2][2], B1[2][2];
    unsigned vA0[2], vA1[2], vB[2];
    int tk[4] = {0, 0, 0, 0};
    PG8_TOKS(cur, tk); PG8_OFFS(cur, tk);
    const char* cA = cur.A; const char* cB = cur.B; size_t hB = (size_t)HALF * cur.ldb;
    const size_t kstep = (size_t)(BK * 2);
    PG8_STAGE(PG8_SB(0, 0), cB, vB); PG8_STAGE(PG8_SB(0, 1), cB + hB, vB); PG8_STAGE(PG8_SA(0, 0), cA, vA0); PG8_STAGE(PG8_SA(0, 1), cA, vA1);
    if (wr == 1) PG8_BAR;
    PG8_WAIT_V(2); PG8_BAR;
    PG8_STAGE(PG8_SB(1, 0), cB + kstep, vB); PG8_STAGE(PG8_SA(1, 0), cA + kstep, vA0); PG8_STAGE(PG8_SB(1, 1), cB + hB + kstep, vB);
    PG8_WAIT_V(6); PG8_BAR;
    for (;;) {
        bool has_next = false;
        const char* nAp = cA; const char* nBp = cB; size_t nhB = hB;
        const int nt = cur.nt;
        for (int t = 0; t < nt; t += 2) {
            const bool last = (t == nt - 2);
            if (last) { has_next = S.next(ui + 1, nxt); if (has_next) { nAp = nxt.A; nBp = nxt.B; nhB = (size_t)HALF * nxt.ldb; } }
            const char* a1 = cA + (size_t)(t + 1) * kstep;
            const char* a2 = last ? nAp : cA + (size_t)(t + 2) * kstep; const char* b2 = last ? nBp : cB + (size_t)(t + 2) * kstep;
            const char* a3 = a2 + kstep; const char* b3 = b2 + kstep;
            const size_t h2 = last ? nhB : hB;
            PG8_LDB(B0, 0, 0); PG8_LDB(B1, 0, 1); PG8_SCHED; PG8_LDA(At, 0, 0); PG8_STAGE(PG8_SA(1, 1), a1, vA1);
            if (last && has_next) { PG8_TOKS(nxt, tk); PG8_OFFS(nxt, tk); }
            PG8_WAIT_V(8); PG8_WAIT_L(0); PG8_BAR; PG8_MMA(0, 0, At, B0); PG8_MMA(0, 1, At, B1); PG8_BAR; PG8_SCHED;
            PG8_LDA(At, 0, 1); PG8_STAGE(PG8_SB(0, 0), b2, vB); PG8_STAGE(PG8_SB(0, 1), b2 + h2, vB); PG8_STAGE(PG8_SA(0, 0), a2, vA0);
            PG8_WAIT_V(8); PG8_WAIT_L(0); PG8_BAR; PG8_MMA(1, 0, At, B0); PG8_MMA(1, 1, At, B1); PG8_BAR; PG8_SCHED;
            PG8_LDB(B0, 1, 0); PG8_LDB(B1, 1, 1); PG8_SCHED; PG8_LDA(At, 1, 0); PG8_STAGE(PG8_SA(0, 1), a2, vA1);
            PG8_WAIT_V(8); PG8_WAIT_L(0); PG8_BAR; PG8_MMA(0, 0, At, B0); PG8_MMA(0, 1, At, B1); PG8_BAR; PG8_SCHED;
            PG8_LDA(At, 1, 1); PG8_STAGE(PG8_SB(1, 0), b3, vB); PG8_STAGE(PG8_SB(1, 1), b3 + h2, vB); PG8_STAGE(PG8_SA(1, 0), a3, vA0);
            PG8_WAIT_V(8); PG8_WAIT_L(0); PG8_BAR; PG8_MMA(1, 0, At, B0); PG8_MMA(1, 1, At, B1); PG8_BAR; PG8_SCHED;
        }
        if (wr == 0) PG8_BAR;
        E(acc, cur, wr, wc, fr, fq);
        if (!has_next) break;
        if (!cur.keep) {
#pragma unroll
            for (int a = 0; a < 2; ++a)
#pragma unroll
                for (int b = 0; b < 2; ++b)
#pragma unroll
                    for (int m = 0; m < 4; ++m)
#pragma unroll
                        for (int n = 0; n < 2; ++n) acc[a][b][m][n] = (f32x4){0.f, 0.f, 0.f, 0.f};
        }
        cur = nxt; cA = nAp; cB = nBp; hB = nhB; ++ui;
        if (wr == 1) PG8_BAR;
    }
    PG8_WAIT_V(0);
    PG8_BAR;
#undef PG8_SA
#undef PG8_SB
#undef PG8_STAGE
#undef PG8_LDA
#undef PG8_LDB
#undef PG8_MMA
#undef PG8_WAIT_V
#undef PG8_WAIT_L
#undef PG8_BAR
#undef PG8_SCHED
#undef PG8_OFFS
#undef PG8_TOKS
}
}
namespace gm {
struct SchedDense {
    const char* A; const char* B; unsigned lda, ldb; int nt, nM, nN, G, c;
    __device__ __forceinline__ bool next(int i, Unit& u) const {
        int pm, pn; if (!static_tile(i * G + c, nM, nN, pm, pn)) return false;
        u.A = A + (size_t)pm * BM * lda; u.B = B + (size_t)pn * BM * ldb; u.lda = lda; u.ldb = ldb; u.nt = nt; u.pm = pm; u.pn = pn; u.kind = 0; u.e = 0; u.rows = BM; u.keep = 0; return true;
    }
    static constexpr bool GATHER = false;
    __device__ __forceinline__ int tok(const Unit&, int) const { return 0; }
};
struct SchedMerge {
    const char* Af; const char* Bf; const char* Ar; const char* Br; int nM, nN, G, c;
    __device__ __forceinline__ bool next(int i, Unit& u) const {
        int pm, pn; if (!static_tile((i >> 1) * G + c, nM, nN, pm, pn)) return false;
        if ((i & 1) == 0) { u.lda = 1024 * 2; u.ldb = 1024 * 2; u.A = Af + (size_t)pm * BM * u.lda; u.B = Bf + (size_t)pn * BM * u.ldb; u.nt = 16; u.kind = 0; u.keep = 1; }
        else { u.lda = 2048 * 2; u.ldb = 2048 * 2; u.A = Ar + (size_t)pm * BM * u.lda; u.B = Br + (size_t)pn * BM * u.ldb; u.nt = 32; u.kind = 1; u.keep = 0; }
        u.pm = pm; u.pn = pn; u.e = 0; u.rows = BM; return true;
    }
    static constexpr bool GATHER = false;
    __device__ __forceinline__ int tok(const Unit&, int) const { return 0; }
};
template <bool GATHER_> struct SchedMoe {
    static constexpr bool GATHER = GATHER_;
    const LAS int* tab;
    const char* A; const char* W;
    const int* list;
    int NCT, G, c;
    __device__ __forceinline__ bool next(int i, Unit& u) const {
        const int L = i * G + c, ntile = __builtin_amdgcn_readfirstlane(tab[96]); if (L >= ntile * NCT) return false;
        const int rt = L / NCT, ct = L % NCT; const int ln = opaque_tid() & 63;
        const int tbv = tab[64 + (ln & 31)];
        const int e = __builtin_amdgcn_readfirstlane(__popcll(__ballot(ln >= 1 && ln < 32 && tbv <= rt)));
        const int tl = rt - __builtin_amdgcn_readfirstlane(tab[64 + e]), rows = __builtin_amdgcn_readfirstlane(tab[e]) - tl * BM;
        u.e = e; u.rows = rows < BM ? rows : BM; u.pn = ct; u.kind = 0; u.keep = 0;
        if (GATHER) { u.lda = 2048 * 2; u.ldb = 2048 * 2; u.nt = 32; u.A = A; u.B = W + ((size_t)e * 1024 + (size_t)ct * BM) * u.ldb; u.pm = tl; }
        else { u.lda = 512 * 2; u.ldb = 512 * 2; u.nt = 8; u.pm = __builtin_amdgcn_readfirstlane(tab[32 + e]) / BM + tl; u.A = A + (size_t)u.pm * BM * u.lda; u.B = W + ((size_t)e * 2048 + (size_t)ct * BM) * u.ldb; }
        return true;
    }
    __device__ __forceinline__ int tok(const Unit& u, int r) const { return (r < u.rows) ? list[u.e * 16384 + u.pm * BM + r] : 0; }
};

struct EpiProj {
    bf16_t* proj; const float* cosT; const float* sinT;
    __device__ __forceinline__ void operator()(const f32x4 (&acc)[2][2][4][2], const Unit& u, int wr, int wc, int fr, int fq) const {
        const int colt = u.pn * BM; const int row0 = u.pm * BM + wr * 64 + fr, col0 = colt + wc * 32 + 8 * fq;
        int kind; float sc = 1.f;
        if (colt < C_FK) { kind = 0; sc = QSCALE; } else if (colt < C_RQ) kind = 0; else if (colt < C_RV) { kind = 1; sc = (colt >= C_RK) ? KSCALE : 1.f; } else if (colt < C_RG) kind = 0; else if (colt < C_GF) kind = 2; else kind = 3;
        const int j0 = 16 * wc + 4 * fq;
#pragma unroll
        for (int ai = 0; ai < 2; ++ai)
#pragma unroll
            for (int m = 0; m < 4; ++m) { const int row = row0 + ai * HALF + m * 16; bf16_t* rowp = proj + (size_t)row * NPROJ + col0;
                f32x4 cs = (f32x4){1.f, 1.f, 1.f, 1.f}, sn = (f32x4){0.f, 0.f, 0.f, 0.f};
                if (kind == 1) { const int pos = row & (SEQ - 1); cs = *(const f32x4*)(cosT + pos * 64 + j0); sn = *(const f32x4*)(sinT + pos * 64 + j0); }
#pragma unroll
                for (int bj = 0; bj < 2; ++bj) { f32x4 v0 = acc[ai][bj][m][0], v1 = acc[ai][bj][m][1];
                    if (kind == 1) { const f32x4 y1 = v0 * cs - v1 * sn, y2 = v0 * sn + v1 * cs; v0 = y1 * sc; v1 = y2 * sc; }
                    else if (kind == 2) {
#pragma unroll
                        for (int j = 0; j < 4; ++j) { v0[j] = v0[j] * fast_sigmoid(v0[j]); v1[j] = v1[j] * fast_sigmoid(v1[j]); } }
                    else if (kind == 3) {
#pragma unroll
                        for (int j = 0; j < 4; ++j) { v0[j] = fast_sigmoid(v0[j]); v1[j] = fast_sigmoid(v1[j]); } }
                    else { v0 = v0 * sc; v1 = v1 * sc; }
                    u32x4 w; w.x = cvt_pk_bf16(v0[0], v0[1]); w.y = cvt_pk_bf16(v0[2], v0[3]); w.z = cvt_pk_bf16(v1[0], v1[1]); w.w = cvt_pk_bf16(v1[2], v1[3]);
                    *(u32x4*)(rowp + bj * HALF) = w; } }
    }
};
struct EpiMerge {
    const bf16_t* proj; bf16_t* mg;
    __device__ __forceinline__ void operator()(f32x4 (&acc)[2][2][4][2], const Unit& u, int wr, int wc, int fr, int fq) const {
        const int row0 = u.pm * BM + wr * 64 + fr, col0 = u.pn * BM + wc * 32 + 8 * fq;
#pragma unroll
        for (int ai = 0; ai < 2; ++ai)
#pragma unroll
            for (int m = 0; m < 4; ++m) { const int row = row0 + ai * HALF + m * 16; const bf16_t* pr = proj + (size_t)row * NPROJ + col0;
#pragma unroll
                for (int bj = 0; bj < 2; ++bj) {
                    const u32x4 gr = *(const u32x4*)(pr + C_GR + bj * HALF);
                    f32x4 r0 = (f32x4){bflo(gr.x), bfhi(gr.x), bflo(gr.y), bfhi(gr.y)}, r1 = (f32x4){bflo(gr.z), bfhi(gr.z), bflo(gr.w), bfhi(gr.w)};
                    if (u.kind == 0) { const u32x4 gf = *(const u32x4*)(pr + C_GF + bj * HALF);
                        const f32x4 f0 = (f32x4){bflo(gf.x), bfhi(gf.x), bflo(gf.y), bfhi(gf.y)}, f1 = (f32x4){bflo(gf.z), bfhi(gf.z), bflo(gf.w), bfhi(gf.w)};
#pragma unroll
                        for (int j = 0; j < 4; ++j) { acc[ai][bj][m][0][j] *= f0[j] * __builtin_amdgcn_rcpf(r0[j]); acc[ai][bj][m][1][j] *= f1[j] * __builtin_amdgcn_rcpf(r1[j]); } }
                    else { const f32x4 v0 = acc[ai][bj][m][0] * r0, v1 = acc[ai][bj][m][1] * r1;
                        u32x4 w; w.x = cvt_pk_bf16(v0[0], v0[1]); w.y = cvt_pk_bf16(v0[2], v0[3]); w.z = cvt_pk_bf16(v1[0], v1[1]); w.w = cvt_pk_bf16(v1[2], v1[3]);
                        *(u32x4*)(mg + (size_t)row * DM + col0 + bj * HALF) = w; } } }
    }
};
struct EpiOut {
    const float* hf; float* z1;
    __device__ __forceinline__ void operator()(const f32x4 (&acc)[2][2][4][2], const Unit& u, int wr, int wc, int fr, int fq) const {
        const int row0 = u.pm * BM + wr * 64 + fr, col0 = u.pn * BM + wc * 32 + 4 * fq;
#pragma unroll
        for (int ai = 0; ai < 2; ++ai)
#pragma unroll
            for (int m = 0; m < 4; ++m) { const size_t off = (size_t)(row0 + ai * HALF + m * 16) * DM + col0;
#pragma unroll
                for (int bj = 0; bj < 2; ++bj)
#pragma unroll
                    for (int n = 0; n < 2; ++n) { const f32x4 hv = *(const f32x4*)(hf + off + bj * HALF + n * 16); *(f32x4*)(z1 + off + bj * HALF + n * 16) = hv * ALPHA + acc[ai][bj][m][n]; }
                asm volatile("" ::: "memory"); }
    }
};
struct EpiMoe1 {
    bf16_t* hid; const float* wlist; const LAS int* tab;
    __device__ __forceinline__ void operator()(const f32x4 (&acc)[2][2][4][2], const Unit& u, int wr, int wc, int fr, int fq) const {
        const int r0 = wr * 64 + fr, hc0 = u.pn * 128 + wc * 16 + 4 * fq; const int slot0 = __builtin_amdgcn_readfirstlane(tab[32 + u.e]) + u.pm * BM;
#pragma unroll
        for (int ai = 0; ai < 2; ++ai)
#pragma unroll
            for (int m = 0; m < 4; ++m) { const int r = r0 + ai * HALF + m * 16; if (r < u.rows) {
                const float w = wlist[u.e * 16384 + u.pm * BM + r]; bf16_t* rowp = hid + (size_t)(slot0 + r) * DEXP + hc0;
#pragma unroll
                for (int bj = 0; bj < 2; ++bj) { const f32x4 g = acc[ai][bj][m][0], up = acc[ai][bj][m][1]; f32x4 h;
#pragma unroll
                    for (int j = 0; j < 4; ++j) h[j] = g[j] * fast_sigmoid(g[j]) * up[j] * w;
                    u32x2 o; o.x = cvt_pk_bf16(h[0], h[1]); o.y = cvt_pk_bf16(h[2], h[3]); *(u32x2*)(rowp + bj * 64) = o; } } }
    }
};
struct EpiMoe2 {
    bf16_t* ffo;
    __device__ __forceinline__ void operator()(const f32x4 (&acc)[2][2][4][2], const Unit& u, int wr, int wc, int fr, int fq) const {
        const int r0 = wr * 64 + fr, col0 = u.pn * BM + wc * 32 + 8 * fq;
#pragma unroll
        for (int ai = 0; ai < 2; ++ai)
#pragma unroll
            for (int m = 0; m < 4; ++m) { const int r = r0 + ai * HALF + m * 16; if (r < u.rows) { bf16_t* rowp = ffo + (size_t)(u.pm * BM + r) * DM + col0;
#pragma unroll
                for (int bj = 0; bj < 2; ++bj) { const f32x4 v0 = acc[ai][bj][m][0], v1 = acc[ai][bj][m][1];
                    u32x4 w; w.x = cvt_pk_bf16(v0[0], v0[1]); w.y = cvt_pk_bf16(v0[2], v0[3]); w.z = cvt_pk_bf16(v1[0], v1[1]); w.w = cvt_pk_bf16(v1[2], v1[3]);
                    *(u32x4*)(rowp + bj * HALF) = w; } } }
    }
};
}
#define XB_TMO      128
#define XB_XCNT(j)  (256  + 64 * (j))
#define XB_XSUB(j)  (1280 + 64 * (j))
#define XB_XGEN(j)  (2304 + 64 * (j))
#define XB_TOP      3328
#define XB_TOPGEN   3392
#define XCD_BAR_WORDS 3456
#define XB_SPIN_CAP (1u << 18)
__device__ __forceinline__ unsigned xb_ld(unsigned* p)              { return __hip_atomic_load(p, __ATOMIC_RELAXED, __HIP_MEMORY_SCOPE_AGENT); }
__device__ __forceinline__ unsigned xb_add(unsigned* p, unsigned v) { return __hip_atomic_fetch_add(p, v, __ATOMIC_RELAXED, __HIP_MEMORY_SCOPE_AGENT); }
__device__ __forceinline__ unsigned xb_xcc_id() { return (unsigned)__builtin_amdgcn_s_getreg((3 << 11) | 20) & 0xFu; }
#define XB_SPIN(cond, bar) do { unsigned _sp = 0; while (cond) { __builtin_amdgcn_s_sleep(1); \
    if ((++_sp & 255u) == 0u) { if (xb_ld(&(bar)[XB_TMO])) break; if (_sp > XB_SPIN_CAP) { atomicAdd(&(bar)[XB_TMO], 1u); break; } } } } while (0)
struct XcdBarrier { unsigned* bar; unsigned x; volatile LAS unsigned* st; };
__device__ __forceinline__ XcdBarrier xcd_barrier_post(unsigned* bar, volatile LAS unsigned* st) {
    XcdBarrier b; b.bar = bar; b.x = xb_xcc_id(); b.st = st;
    if (threadIdx.x == 0) (void)xb_add(&bar[XB_XCNT(b.x)], 1u);
    return b;
}
__device__ __forceinline__ void xcd_barrier_complete(unsigned* bar, unsigned x, unsigned& nloc, unsigned& nx) {
    const unsigned G = gridDim.x * gridDim.y * gridDim.z;
    unsigned sum, cnt, mine, sp = 0u;
    for (;;) {
        sum = 0u; cnt = 0u; mine = 0u;
#pragma unroll
        for (unsigned j = 0; j < 16; ++j) { const unsigned c = xb_ld(&bar[XB_XCNT(j)]); sum += c; cnt += (c > 0u) ? 1u : 0u; mine = (j == x) ? c : mine; }
        if (sum == G) break;
        __builtin_amdgcn_s_sleep(1);
        if ((++sp & 255u) == 0u) { if (xb_ld(&bar[XB_TMO])) break; if (sp > XB_SPIN_CAP) { atomicAdd(&bar[XB_TMO], 1u); break; } }
    }
    nloc = mine > 0u ? mine : 1u; nx = cnt > 0u ? cnt : 1u;
}
__device__ __forceinline__ void xcd_barrier(const XcdBarrier& b) {
    asm volatile("s_waitcnt vmcnt(0)" ::: "memory");
    __syncthreads();
    if (threadIdx.x == 0) {
        unsigned* bar = b.bar;
        __builtin_amdgcn_s_waitcnt(0);
        unsigned nloc = b.st[0], nx = b.st[1];
        if (nloc == 0u) { xcd_barrier_complete(bar, b.x, nloc, nx); b.st[0] = nloc; b.st[1] = nx; }
        const unsigned old = xb_add(&bar[XB_XSUB(b.x)], 1u);
        const unsigned gen = old / nloc;
        if (old + 1u == (gen + 1u) * nloc) {
            __builtin_amdgcn_fence(__ATOMIC_RELEASE, "agent");
            asm volatile("s_waitcnt vmcnt(0)" ::: "memory");
            const unsigned og = xb_add(&bar[XB_TOP], 1u);
            const unsigned tg = og / nx;
            if (og + 1u == (tg + 1u) * nx) xb_add(&bar[XB_TOPGEN], 1u);
            else XB_SPIN(xb_ld(&bar[XB_TOPGEN]) == tg, bar);
            __builtin_amdgcn_fence(__ATOMIC_ACQUIRE, "agent");
            xb_add(&bar[XB_XGEN(b.x)], 1u);
            asm volatile("s_waitcnt vmcnt(0)" ::: "memory");
        } else {
            XB_SPIN(xb_ld(&bar[XB_XGEN(b.x)]) == gen, bar);
            __builtin_amdgcn_fence(__ATOMIC_ACQUIRE, "agent");
            asm volatile("s_waitcnt vmcnt(0)" ::: "memory");
        }
    }
    __syncthreads();
}

constexpr int NWAVES = 8;
struct Frame {
    LAS unsigned char* lds; volatile LAS unsigned* MISC; gu32* ctl;
    int tid, lane, wave, G, bx;
    unsigned char* ws;
    float* out;
};
#define INP(i) ((const float*)(const GAS float*)(((const float* const*)__builtin_amdgcn_kernarg_segment_ptr())[i]))
#define KWS() ((unsigned char*)(GAS unsigned char*)(((unsigned char* const*)__builtin_amdgcn_kernarg_segment_ptr())[20]))
__device__ __forceinline__ float wave_sum(float v) {
#pragma unroll
    for (int o = 1; o < 64; o <<= 1) v += __shfl_xor(v, o);
    return v;
}

__device__ __forceinline__ void p0_transpose_item(const float* colp, size_t pitch, bf16_t* WT, int K, int n0, int k0, LAS float* scr, int lane) {
    float tv[32];
#pragma unroll
    for (int i = 0; i < 32; ++i) { const int kk = 2 * i + (lane >> 5); tv[i] = colp[(size_t)(k0 + kk) * pitch]; }
#pragma unroll
    for (int i = 0; i < 32; ++i) { const int kk = 2 * i + (lane >> 5); scr[kk * 33 + (lane & 31)] = tv[i]; }
    LDS_WAIT(); asm volatile("" ::: "memory");
    const int c = lane & 7;
#pragma unroll
    for (int j = 0; j < 4; ++j) { const int n = (lane >> 3) + 8 * j; const LAS float* s = scr + (8 * c) * 33 + n;
        u32x4 o; o.x = pk2(s[0 * 33], s[1 * 33]); o.y = pk2(s[2 * 33], s[3 * 33]); o.z = pk2(s[4 * 33], s[5 * 33]); o.w = pk2(s[6 * 33], s[7 * 33]);
        *(GAS u32x4*)(WT + (size_t)(n0 + n) * K + k0 + 8 * c) = o; }
    LDS_WAIT(); asm volatile("" ::: "memory");
}
__device__ __forceinline__ int win_srccol(int n) {
    if (n < C_RQ) return n;
    if (n < C_RV) { const int hh = (n - C_RQ) >> 7, p = (n - C_RQ) & 127; return 3080 + hh * 128 + 4 * (p >> 3) + (p & 3) + 64 * ((p >> 2) & 1); }
    return n + 8;
}
constexpr int IT_WIN = 32 * 416, IT_BF = 16 * 64, IT_BR = 32 * 64, IT_OUT = 32 * 64, IT_GU = 32 * 32 * 32, IT_D = 32 * 8 * 64, IT_LAYER = IT_WIN + IT_BF + IT_BR + IT_OUT + IT_GU + IT_D;
__device__ __forceinline__ void p0_weights(Frame& F, int l) {
    LAS float* scr = (LAS float*)(F.lds + F.wave * 16384);
    const int gw = F.bx * NWAVES + F.wave, NGW = F.G * NWAVES, lane = F.lane, nl = lane & 31;
    for (int it = gw; it < IT_LAYER; it += NGW) {
        int r = it; unsigned char* wl = F.ws + WS_W;
        if (r < IT_WIN) { const int kb = r / 416, nb = r % 416; p0_transpose_item(INP(3) + (size_t)l * DM * W_IN_COLS + win_srccol(32 * nb + nl), W_IN_COLS, (bf16_t*)(wl + WL_WIN), 2048, 32 * nb, 64 * kb, scr, lane); continue; } r -= IT_WIN;
        if (r < IT_BF) { const int kb = r / 64, nb = r % 64; p0_transpose_item(INP(5) + (size_t)l * 1024 * DM + 32 * nb + nl, DM, (bf16_t*)(wl + WL_WBF), 1024, 32 * nb, 64 * kb, scr, lane); continue; } r -= IT_BF;
        if (r < IT_BR) { const int kb = r / 64, nb = r % 64; p0_transpose_item(INP(6) + (size_t)l * 2048 * DM + 32 * nb + nl, DM, (bf16_t*)(wl + WL_WBR), 2048, 32 * nb, 64 * kb, scr, lane); continue; } r -= IT_BR;
        if (r < IT_OUT) { const int kb = r / 64, nb = r % 64; p0_transpose_item(INP(7) + (size_t)l * 2048 * DM + 32 * nb + nl, DM, (bf16_t*)(wl + WL_WOUT), 2048, 32 * nb, 64 * kb, scr, lane); continue; } r -= IT_OUT;
        if (r < IT_GU) { const int e = r / 1024, q = r % 1024, kb = q / 32, nb = q % 32; const int row = 32 * nb + nl, col = 4 * (row >> 3) + (row & 3);
            const float* src = (((row >> 2) & 1) ? INP(15) : INP(14)) + (size_t)(l * NEXP + e) * DM * DEXP + col;
            p0_transpose_item(src, DEXP, (bf16_t*)(wl + WL_WGU) + (size_t)e * 1024 * 2048, 2048, 32 * nb, 64 * kb, scr, lane); continue; } r -= IT_GU;
        { const int e = r / 512, q = r % 512, kb = q / 64, nb = q % 64;
            p0_transpose_item(INP(16) + (size_t)(l * NEXP + e) * DEXP * DM + 32 * nb + nl, DM, (bf16_t*)(wl + WL_WD) + (size_t)e * 2048 * 512, 512, 32 * nb, 64 * kb, scr, lane); }
    }
}
__device__ __forceinline__ void p0_tables(Frame& F) {
    const int gw = F.bx * NWAVES + F.wave, NGW = F.G * NWAVES, lane = F.lane;
    { float* cosT = (float*)(F.ws + WS_ROPE); float* sinT = cosT + SEQ * 64;
      for (int i = (F.bx * NWAVES + F.wave) * 64 + lane; i < SEQ * 64; i += NGW * 64) { const int pos = i >> 6, j = i & 63;
          double pw = 1.0; for (int t = 0; t < j; ++t) pw *= 0.8659643233600653;
          const float inv = (float)pw; const double ang = (double)((float)pos * inv);
          const double qd = __builtin_rint(ang * 0.6366197723675814); const double r = ang - qd * 1.5707963267948966, r2 = r * r; const int qi = (int)qd & 3;
          const double sr = r * (1.0 + r2 * (-1.0 / 6 + r2 * (1.0 / 120 + r2 * (-1.0 / 5040 + r2 * (1.0 / 362880 + r2 * (-1.0 / 39916800))))));
          const double cr = 1.0 + r2 * (-0.5 + r2 * (1.0 / 24 + r2 * (-1.0 / 720 + r2 * (1.0 / 40320 + r2 * (-1.0 / 3628800 + r2 * (1.0 / 479001600))))));
          const double sv = (qi == 0) ? sr : (qi == 1) ? cr : (qi == 2) ? -sr : -cr, cv = (qi == 0) ? cr : (qi == 1) ? -sr : (qi == 2) ? -cr : sr;
          cosT[i] = (float)cv; sinT[i] = (float)sv; } }
    for (int job = gw; job < 2 * 16 + 2 * 48; job += NGW) {
        int t, c; if (job < 32) { t = job >> 4; c = job & 15; } else { t = 2 + (job - 32) / 48; c = (job - 32) % 48; }
        const int l = t & 1; const float *g, *b; const float* W = nullptr; size_t pitch = 0;
        if (t < 2) { g = l ? INP(17) : INP(1); b = l ? INP(18) : INP(2); if (c < 8) { W = INP(3) + (size_t)l * DM * W_IN_COLS + 3072 + c; pitch = W_IN_COLS; } }
        else { g = INP(8) + l * DM; b = INP(9) + l * DM; if (c < 4) { W = INP(10) + (size_t)l * DM * 4 + c; pitch = 4; } else if (c < 36) { W = INP(12) + (size_t)l * DM * 32 + (c - 4); pitch = 32; } }
        bf16_t* hi = (bf16_t*)(F.ws + WS_SKW + (t < 2 ? (size_t)t * SKW_FGT_BYTES : 2 * SKW_FGT_BYTES + (size_t)(t - 2) * SKW_RTR_BYTES)); const int ncol = t < 2 ? 16 : 48; bf16_t* lo = hi + ncol * 2048;
        float s1 = 0.f, s2 = 0.f;
        for (int k = lane; k < DM; k += 64) { const float w = W ? W[(size_t)k * pitch] : 0.f; const float gw_ = g[k] * w; const unsigned h16 = f2bf(gw_); const float hf_ = __builtin_bit_cast(float, h16 << 16); const unsigned l16 = f2bf(gw_ - hf_);
            hi[c * 2048 + k] = (bf16_t)h16; lo[c * 2048 + k] = (bf16_t)l16; s1 += hf_ + __builtin_bit_cast(float, l16 << 16); s2 += b[k] * w; }
        s1 = wave_sum(s1); s2 = wave_sum(s2);
        if (lane == 0) { float* S = (float*)(F.ws + WS_SKS + (size_t)t * 512); S[c] = s1; S[64 + c] = s2; }
    }
}
struct LnArgs {
    const float* zin;
    float* hf; bf16_t* hb;
    const float* g; const float* b;
    const bf16_t* whi; const bf16_t* wlo; const float* S12;
    const bf16_t* ffo; const int* route;
    const LAS int* tab;
    const float* bfor; float* logf;
    const float* brg; const float* bre; int* route_out; int* list; float* wlist; unsigned* cnt;
};
template <int MODE, int NCG, bool PROJ>
__device__ __forceinline__ void ln_pass(Frame& F, const LnArgs& a) {
    const int lane = F.lane, w = F.wave, r = lane & 15, q = lane >> 4, tid = F.tid;
    LAS float* red = (LAS float*)(F.lds + LNS_OFF);
    LAS float* part = (LAS float*)(F.lds + LNS_OFF + 1024);
    LAS float* lg = (LAS float*)(F.lds + LNS_OFF + 1024 + 24576);
    LAS unsigned char* stash = F.lds + w * 16384;
#define LN_ISSUE(g_) do { const int row_ = (g_) * 16 + r; const int kb_ = 256 * w + 8 * q; \
        if (MODE == 2) { const int4 rt = *(const int4*)(a.route + row_ * 4); \
            const size_t sa = (size_t)(a.tab[32 + rt.x] + rt.y), sb = (size_t)(a.tab[32 + rt.z] + rt.w); \
            const bf16_t* pa = a.ffo + sa * DM + kb_; const bf16_t* pb = a.ffo + sb * DM + kb_; \
            _Pragma("unroll") for (int s = 0; s < 8; ++s) { __builtin_amdgcn_global_load_lds((const unsigned*)(pa + 32 * s), (LAS unsigned*)(stash + (2 * s) * 1024), 16, 0, 0); \
                __builtin_amdgcn_global_load_lds((const unsigned*)(pb + 32 * s), (LAS unsigned*)(stash + (2 * s + 1) * 1024), 16, 0, 0); } } \
        else { const float* zp_ = a.zin + (size_t)row_ * DM + kb_; \
            _Pragma("unroll") for (int s = 0; s < 8; ++s) { __builtin_amdgcn_global_load_lds((const unsigned*)(zp_ + 32 * s), (LAS unsigned*)(stash + (2 * s) * 1024), 16, 0, 0); \
                __builtin_amdgcn_global_load_lds((const unsigned*)(zp_ + 32 * s + 4), (LAS unsigned*)(stash + (2 * s + 1) * 1024), 16, 0, 0); } } } while (0)
    const int kb = 256 * w + 8 * q;
    unsigned gq[8][2][4];
#define LN_GLOAD() do { _Pragma("unroll") for (int s = 0; s < 8; ++s) _Pragma("unroll") for (int hh = 0; hh < 2; ++hh) { \
            const f32x4 gv = *(const f32x4*)(a.g + kb + 32 * s + 4 * hh), bv = *(const f32x4*)(a.b + kb + 32 * s + 4 * hh); \
            gq[s][hh][0] = __builtin_bit_cast(unsigned, __builtin_amdgcn_cvt_pkrtz(gv[0] - 1.f, gv[1] - 1.f)); gq[s][hh][1] = __builtin_bit_cast(unsigned, __builtin_amdgcn_cvt_pkrtz(gv[2] - 1.f, gv[3] - 1.f)); \
            gq[s][hh][2] = __builtin_bit_cast(unsigned, __builtin_amdgcn_cvt_pkrtz(bv[0], bv[1])); gq[s][hh][3] = __builtin_bit_cast(unsigned, __builtin_amdgcn_cvt_pkrtz(bv[2], bv[3])); } } while (0)
    constexpr bool GRES = (MODE != 1);
    if (GRES) LN_GLOAD();
    typedef _Float16 h16x2 __attribute__((ext_vector_type(2)));
#define LN_UNPK(dst, s_, hh_, i_) do { unsigned u0_ = gq[s_][hh_][i_], u1_ = gq[s_][hh_][(i_) + 1]; asm volatile("" : "+v"(u0_), "+v"(u1_)); const h16x2 h0_ = __builtin_bit_cast(h16x2, u0_), h1_ = __builtin_bit_cast(h16x2, u1_); \
        dst = (f32x4){(float)h0_[0], (float)h0_[1], (float)h1_[0], (float)h1_[1]}; } while (0)
    LAS float* tb = (LAS float*)(F.lds + LNS_OFF + 1024 + 24576 + 3072);
    float s1a = 0.f, s2a = 0.f, s1b = 0.f, s2b = 0.f;
    if (PROJ) {
        if (MODE != 1) { if (tid < 8) tb[tid] = a.bfor[tid]; } else { if (tid < 4) tb[16 + tid] = a.brg[tid]; if (tid >= 32 && tid < 64) tb[tid] = a.bre[tid - 32]; }
        if (tid < 16 * 16 * NCG) { const int cc = tid % (16 * NCG); s1a = a.S12[cc]; s2a = a.S12[64 + cc]; }
        if (tid + NWAVES * 64 < 16 * 16 * NCG) { const int cc = (tid + NWAVES * 64) % (16 * NCG); s1b = a.S12[cc]; s2b = a.S12[64 + cc]; }
    }
    asm volatile("s_waitcnt vmcnt(0)" ::: "memory");
    if (F.bx < NTOK / 16) LN_ISSUE(F.bx);
    for (int gi = F.bx; gi < NTOK / 16; gi += F.G) {
        const int row = gi * 16 + r;
        f32x4 z[8][2];
        if (MODE == 2) {
            f32x4 rh[8][2];
            { const float* zp_ = a.zin + (size_t)row * DM + kb;
#pragma unroll
              for (int s = 0; s < 8; ++s) { rh[s][0] = *(const f32x4*)(zp_ + 32 * s); rh[s][1] = *(const f32x4*)(zp_ + 32 * s + 4); } }
            asm volatile("s_waitcnt vmcnt(0)" ::: "memory");
#pragma unroll
            for (int s = 0; s < 8; ++s) { const u32x4 ua = *(const LAS u32x4*)(stash + (2 * s) * 1024 + lane * 16), ub = *(const LAS u32x4*)(stash + (2 * s + 1) * 1024 + lane * 16);
                z[s][0] = rh[s][0] * ALPHA + ((f32x4){bflo(ua.x), bfhi(ua.x), bflo(ua.y), bfhi(ua.y)} + (f32x4){bflo(ub.x), bfhi(ub.x), bflo(ub.y), bfhi(ub.y)});
                z[s][1] = rh[s][1] * ALPHA + ((f32x4){bflo(ua.z), bfhi(ua.z), bflo(ua.w), bfhi(ua.w)} + (f32x4){bflo(ub.z), bfhi(ub.z), bflo(ub.w), bfhi(ub.w)}); }
        } else {
            asm volatile("s_waitcnt vmcnt(0)" ::: "memory");
#pragma unroll
            for (int s = 0; s < 8; ++s) { z[s][0] = *(const LAS f32x4*)(stash + (2 * s) * 1024 + lane * 16); z[s][1] = *(const LAS f32x4*)(stash + (2 * s + 1) * 1024 + lane * 16); }
        }
        LDS_WAIT();
        float sm = 0.f, sq = 0.f;
#pragma unroll
        for (int s = 0; s < 8; ++s)
#pragma unroll
            for (int hh = 0; hh < 2; ++hh)
#pragma unroll
                for (int j = 0; j < 4; ++j) { const float v = z[s][hh][j]; sm += v; sq += v * v; }
        sm += __shfl_xor(sm, 16); sm += __shfl_xor(sm, 32); sq += __shfl_xor(sq, 16); sq += __shfl_xor(sq, 32);
        if (q == 0) { red[(w * 16 + r) * 2] = sm; red[(w * 16 + r) * 2 + 1] = sq; }
        if (PROJ) {
            f32x4 acc[NCG];
#pragma unroll
            for (int cg = 0; cg < NCG; ++cg) acc[cg] = (f32x4){0.f, 0.f, 0.f, 0.f};
            bf16x8 bh[2], bl[2];
            unsigned wof[NCG];
#pragma unroll
            for (int cg = 0; cg < NCG; ++cg) { wof[cg] = (unsigned)((16 * cg + r) * DM + kb) * 2u; asm volatile("" : "+v"(wof[cg])); }
#define LN_WLOAD(i_, bf_) do { const int cg_ = (i_) % NCG, s_ = (i_) / NCG; bh[bf_] = *(const bf16x8*)((const char*)a.whi + wof[cg_] + 64 * s_); bl[bf_] = *(const bf16x8*)((const char*)a.wlo + wof[cg_] + 64 * s_); } while (0)
            LN_WLOAD(0, 0);
#pragma unroll
            for (int i = 0; i < 8 * NCG; ++i) { const int cg = i % NCG, s = i / NCG;
                asm volatile("" ::: "memory");
                if (i + 1 < 8 * NCG) LN_WLOAD(i + 1, (i + 1) & 1);
                asm volatile("" ::: "memory");
                u32x4 hi, lo;
                { const f32x4 v0 = z[s][0], v1 = z[s][1];
                  hi.x = cvt_pk_bf16(v0[0], v0[1]); hi.y = cvt_pk_bf16(v0[2], v0[3]); hi.z = cvt_pk_bf16(v1[0], v1[1]); hi.w = cvt_pk_bf16(v1[2], v1[3]);
                  lo.x = cvt_pk_bf16(v0[0] - bflo(hi.x), v0[1] - bfhi(hi.x)); lo.y = cvt_pk_bf16(v0[2] - bflo(hi.y), v0[3] - bfhi(hi.y));
                  lo.z = cvt_pk_bf16(v1[0] - bflo(hi.z), v1[1] - bfhi(hi.z)); lo.w = cvt_pk_bf16(v1[2] - bflo(hi.w), v1[3] - bfhi(hi.w)); }
                const bf16x8 ahi = __builtin_bit_cast(bf16x8, hi), alo = __builtin_bit_cast(bf16x8, lo);
                const bf16x8 wh = bh[i & 1], wl_ = bl[i & 1];
                acc[cg] = __builtin_amdgcn_mfma_f32_16x16x32_bf16(ahi, wh, acc[cg], 0, 0, 0);
                acc[cg] = __builtin_amdgcn_mfma_f32_16x16x32_bf16(alo, wh, acc[cg], 0, 0, 0);
                acc[cg] = __builtin_amdgcn_mfma_f32_16x16x32_bf16(ahi, wl_, acc[cg], 0, 0, 0);
            }
#undef LN_WLOAD
#pragma unroll
            for (int cg = 0; cg < NCG; ++cg)
#pragma unroll
                for (int j = 0; j < 4; ++j) part[(w * 16 + 4 * q + j) * 48 + 16 * cg + r] = acc[cg][j];
        }
        asm volatile("" ::: "memory");
        if (!GRES) { LN_GLOAD(); asm volatile("" ::: "memory"); }
        if (gi + F.G < NTOK / 16) LN_ISSUE(gi + F.G);
        asm volatile("" ::: "memory");
        LDS_WAIT(); __syncthreads();
        float mean, rstd;
        { float ts = 0.f, tq = 0.f;
#pragma unroll
          for (int ww = 0; ww < 8; ++ww) { ts += red[(ww * 16 + r) * 2]; tq += red[(ww * 16 + r) * 2 + 1]; }
          mean = ts * (1.0f / DM); const float var = tq * (1.0f / DM) - mean * mean; rstd = 1.0f / sqrtf(fmaxf(var, 0.f) + LN_EPS); }
        { float* op = a.hf + (size_t)row * DM + kb; bf16_t* ob = a.hb ? a.hb + (size_t)row * DM + kb : nullptr;
#pragma unroll
          for (int s = 0; s < 8; ++s) {
              f32x4 dg0, dg1, bb0, bb1; LN_UNPK(dg0, s, 0, 0); LN_UNPK(dg1, s, 1, 0); LN_UNPK(bb0, s, 0, 2); LN_UNPK(bb1, s, 1, 2);
              const f32x4 n0 = (z[s][0] - mean) * rstd, n1 = (z[s][1] - mean) * rstd; const f32x4 y0 = n0 + n0 * dg0 + bb0, y1 = n1 + n1 * dg1 + bb1;
              *(f32x4*)(op + 32 * s) = y0; *(f32x4*)(op + 32 * s + 4) = y1;
              if (ob) { u32x4 o; o.x = cvt_pk_bf16(y0[0], y0[1]); o.y = cvt_pk_bf16(y0[2], y0[3]); o.z = cvt_pk_bf16(y1[0], y1[1]); o.w = cvt_pk_bf16(y1[2], y1[3]); *(u32x4*)(ob + 32 * s) = o; } } }
        if (PROJ) {
#define LN_LOGIT(t_, s1_, s2_) do { const int t = (t_); if (t < 16 * 16 * NCG) { const int rr = t / (16 * NCG), cc = t % (16 * NCG); float ts = 0.f, tq = 0.f, ps = 0.f; \
                _Pragma("unroll") for (int ww = 0; ww < 8; ++ww) { ts += red[(ww * 16 + rr) * 2]; tq += red[(ww * 16 + rr) * 2 + 1]; ps += part[(ww * 16 + rr) * 48 + cc]; } \
                const float mr = ts * (1.0f / DM), vr = tq * (1.0f / DM) - mr * mr, rs = 1.0f / sqrtf(fmaxf(vr, 0.f) + LN_EPS); \
                lg[rr * 48 + cc] = rs * (ps - mr * (s1_)) + (s2_); } } while (0)
            LN_LOGIT(tid, s1a, s2a); if (16 * 16 * NCG > NWAVES * 64) LN_LOGIT(tid + NWAVES * 64, s1b, s2b);
#undef LN_LOGIT
            LDS_WAIT(); __syncthreads();
            if (tid < 16) {
                const int tok = gi * 16 + tid; const LAS float* L = lg + tid * 48;
                if (MODE != 1) {
                    const int bb = tok / SEQ, ss = tok % SEQ;
#pragma unroll
                    for (int hh = 0; hh < 8; ++hh) { const float xv = L[hh] + tb[hh]; const float lsg = fminf(xv, 0.f) - log1pf(expf(-fabsf(xv))); a.logf[((size_t)bb * 8 + hh) * SEQ + ss] = lsg; }
                } else {
                    float gl[4]; float gmax = -3.0e38f; int gi_ = 0;
#pragma unroll
                    for (int j = 0; j < 4; ++j) { gl[j] = L[j] + tb[16 + j]; if (gl[j] > gmax) { gmax = gl[j]; gi_ = j; } }
                    float den = 0.f;
#pragma unroll
                    for (int j = 0; j < 4; ++j) den += expf(gl[j] - gmax);
                    const float grp_w = 1.0f / den;
                    float e1 = -3.0e38f, e2 = -3.0e38f; int i1 = 0, i2 = 0;
#pragma unroll
                    for (int j = 0; j < 8; ++j) { const float v = L[4 + 8 * gi_ + j] + tb[32 + 8 * gi_ + j];
                        if (v > e1) { e2 = e1; i2 = i1; e1 = v; i1 = j; } else if (v > e2) { e2 = v; i2 = j; } }
                    const float t2 = expf(e2 - e1), w1 = grp_w / (1.0f + t2), w2 = grp_w * t2 / (1.0f + t2);
                    const int x1 = 8 * gi_ + i1, x2 = 8 * gi_ + i2;
                    const int p1 = (int)__hip_atomic_fetch_add(a.cnt + 64 * x1, 1u, RLX_AGENT), p2 = (int)__hip_atomic_fetch_add(a.cnt + 64 * x2, 1u, RLX_AGENT);
                    a.list[x1 * 16384 + p1] = tok; a.wlist[x1 * 16384 + p1] = w1; a.list[x2 * 16384 + p2] = tok; a.wlist[x2 * 16384 + p2] = w2;
                    *(int4*)(a.route_out + tok * 4) = make_int4(x1, p1, x2, p2);
                }
            }
        }
        __syncthreads();
    }
#undef LN_ISSUE
#undef LN_UNPK
#undef LN_GLOAD
}
namespace fox {
constexpr int D = 128, NW = 8, QBLK = 32, KVBLK = 64, QB = NW * QBLK;
constexpr int SHM_V = KVBLK * D * 2, SHM_K = KVBLK * D * 2;
constexpr int OFF_WS = 2 * SHM_V + 2 * SHM_K, OFF_BIAS = OFF_WS + NW * 64 * 4, LDS_BYTES = OFF_BIAS + SEQ * 4;
constexpr float THR = 8.f, LN2 = 0.6931471805599453f;
#define KSWZ(row, colB) ((row) * 256 + ((colB) ^ (((row) & 7) << 4)))
__device__ __forceinline__ int v_st(int k, int c) { const int kk = (k & ~0xC) | ((k & 4) << 1) | ((k & 8) >> 1); return ((kk >> 3) * 4 + (c >> 5)) * 512 + ((kk & 7) * 32 + (c & 31)) * 2; }
__device__ __forceinline__ int v_rd_base(int lane) { return ((lane & 3) << 3) | (((lane >> 2) & 3) << 6) | (((lane >> 4) & 1) << 5) | (((lane >> 5) & 1) << 8); }
constexpr int v_rd_off(int d0, int ks, int half) { return d0 * 512 + ks * 4096 + half * 2048; }
__device__ __forceinline__ int crow(int r, int hi) { return (r & 3) + 8 * (r >> 2) + 4 * hi; }
__device__ __forceinline__ void mask_tile(f32x16& p0, f32x16& p1, int dq) {
    const float NEG = -__builtin_inff();
#pragma unroll
    for (int r = 0; r < 16; ++r) { const int c = (r & 3) + 8 * (r >> 2); if (dq - c < 0) p0[r] = NEG; if (dq - c - 32 < 0) p1[r] = NEG; }
}
__device__ __forceinline__ void partialSM(f32x16& p0, f32x16& p1, float& m_reg, float& mn, float& alpha) {
    float pmax = p0[0];
#pragma unroll
    for (int r = 1; r < 16; ++r) pmax = fmaxf(pmax, p0[r]);
#pragma unroll
    for (int r = 0; r < 16; ++r) pmax = fmaxf(pmax, p1[r]);
    { auto rr = __builtin_amdgcn_permlane32_swap(__float_as_uint(pmax), __float_as_uint(pmax), false, false); pmax = fmaxf(__uint_as_float(rr[0]), __uint_as_float(rr[1])); }
    if (__builtin_expect(__all((pmax - m_reg) * LN2 <= THR), 1)) { mn = m_reg; alpha = 1.f; }
    else { mn = fmaxf(m_reg, pmax); alpha = __builtin_amdgcn_exp2f(m_reg - mn); m_reg = mn; }
#pragma unroll
    for (int r = 0; r < 16; ++r) p0[r] = p0[r] - mn;
#pragma unroll
    for (int r = 0; r < 16; ++r) p1[r] = p1[r] - mn;
#pragma unroll
    for (int r = 0; r < 16; ++r) p0[r] = __builtin_amdgcn_exp2f(p0[r]);
}
__device__ __forceinline__ void finishSM(f32x16& p0, f32x16& p1, float alpha, float& l_reg, bf16x8& pa0, bf16x8& pa1, bf16x8& pa2, bf16x8& pa3) {
#pragma unroll
    for (int r = 0; r < 16; ++r) p1[r] = __builtin_amdgcn_exp2f(p1[r]);
    float ps = 0;
#pragma unroll
    for (int r = 0; r < 16; ++r) ps += p0[r];
#pragma unroll
    for (int r = 0; r < 16; ++r) ps += p1[r];
    { auto rr = __builtin_amdgcn_permlane32_swap(__float_as_uint(ps), __float_as_uint(ps), false, false); ps = __uint_as_float(rr[0]) + __uint_as_float(rr[1]); }
    l_reg = l_reg * alpha + ps;
#define PK4(P, B_, OUT) do { unsigned a0 = cvt_pk_bf16(P[B_+0], P[B_+1]), a1 = cvt_pk_bf16(P[B_+2], P[B_+3]);                          \
        unsigned b0 = cvt_pk_bf16(P[B_+4], P[B_+5]), b1 = cvt_pk_bf16(P[B_+6], P[B_+7]);                                             \
        auto r0 = __builtin_amdgcn_permlane32_swap(a0, b0, false, false); auto r1 = __builtin_amdgcn_permlane32_swap(a1, b1, false, false); \
        u32x4 w = {r0[0], r1[0], r0[1], r1[1]}; OUT = __builtin_bit_cast(bf16x8, w); } while (0)
    PK4(p0, 0, pa0); PK4(p0, 8, pa1); PK4(p1, 0, pa2); PK4(p1, 8, pa3);
#undef PK4
}
template <int KB>
__device__ __forceinline__ void qkt(f32x16& p0, f32x16& p1, const LAS char* K_lds, int r32, int hi, const bf16x8* qr, const LAS float* bl) {
#pragma unroll
    for (int g = 0; g < 4; ++g) { const f32x4 b0 = *(const LAS f32x4*)(bl + 8 * g), b1 = *(const LAS f32x4*)(bl + 32 + 8 * g);
        p0[4 * g] = b0[0]; p0[4 * g + 1] = b0[1]; p0[4 * g + 2] = b0[2]; p0[4 * g + 3] = b0[3]; p1[4 * g] = b1[0]; p1[4 * g + 1] = b1[1]; p1[4 * g + 2] = b1[2]; p1[4 * g + 3] = b1[3]; }
    const LAS char* kb[4];
#pragma unroll
    for (int dd = 0; dd < 4; ++dd) kb[dd] = K_lds + KB * SHM_K + KSWZ(r32, (dd * 16 + hi * 8) * 2);
#pragma unroll
    for (int d0 = 0; d0 < 8; ++d0) { const LAS char* a = kb[d0 & 3] + (d0 >> 2) * 128;
        bf16x8 b0 = *(const LAS bf16x8*)(a);
        bf16x8 b1 = *(const LAS bf16x8*)(a + 32 * 256);
        p0 = __builtin_amdgcn_mfma_f32_32x32x16_bf16(b0, qr[d0], p0, 0, 0, 0);
        p1 = __builtin_amdgcn_mfma_f32_32x32x16_bf16(b1, qr[d0], p1, 0, 0, 0); }
}
template <int VB>
__device__ __forceinline__ void pv_tile(f32x16* o, int vb0, bf16x8 pa0, bf16x8 pa1, bf16x8 pa2, bf16x8 pa3) {
#define TRRD(dst, off) asm volatile("ds_read_b64_tr_b16 %0, %1 offset:%2" : "=&v"(dst) : "v"(vb0), "i"(off) : "memory")
#define PV_D0(d0) do { s16x4 l0, l1, l2, l3, h0, h1, h2, h3; constexpr int b_ = VB * SHM_V + v_rd_off(d0, 0, 0); \
        TRRD(l0, b_); TRRD(h0, b_ + 2048); TRRD(l1, b_ + 4096); TRRD(h1, b_ + 6144); TRRD(l2, b_ + 8192); TRRD(h2, b_ + 10240); TRRD(l3, b_ + 12288); TRRD(h3, b_ + 14336); \
        asm volatile("s_waitcnt lgkmcnt(0)" ::: "memory"); SBAR();   \
        o[d0] = __builtin_amdgcn_mfma_f32_32x32x16_bf16(pa0, (bf16x8){l0[0], l0[1], l0[2], l0[3], h0[0], h0[1], h0[2], h0[3]}, o[d0], 0, 0, 0);   \
        o[d0] = __builtin_amdgcn_mfma_f32_32x32x16_bf16(pa1, (bf16x8){l1[0], l1[1], l1[2], l1[3], h1[0], h1[1], h1[2], h1[3]}, o[d0], 0, 0, 0);   \
        o[d0] = __builtin_amdgcn_mfma_f32_32x32x16_bf16(pa2, (bf16x8){l2[0], l2[1], l2[2], l2[3], h2[0], h2[1], h2[2], h2[3]}, o[d0], 0, 0, 0);   \
        o[d0] = __builtin_amdgcn_mfma_f32_32x32x16_bf16(pa3, (bf16x8){l3[0], l3[1], l3[2], l3[3], h3[0], h3[1], h3[2], h3[3]}, o[d0], 0, 0, 0); } while (0)
    PV_D0(0); PV_D0(1); PV_D0(2); PV_D0(3);
#undef PV_D0
#undef TRRD
}
struct BlockRef { const bf16_t* Q; const bf16_t* K; const bf16_t* V; bf16_t* O; int P0; };
struct Seam { bf16x8 qr[8]; bf16x8 st_v0, st_v1, st_k0, st_k1; };
#define VMW() asm volatile("s_waitcnt vmcnt(0)" ::: "memory")
#define VMWN(n) asm volatile("s_waitcnt vmcnt(%0)" :: "i"(n) : "memory")
#define SLOAD_H(Kp, Vp, k0) do { const char* vb_ = (const char*)(Vp) + (size_t)(k0) * (ld * 2); const char* kb_ = (const char*)(Kp) + (size_t)(k0) * (ld * 2); \
        S.st_v0 = *(const bf16x8*)(vb_ + soff); S.st_v1 = *(const bf16x8*)(vb_ + 32 * ld * 2 + soff); S.st_k0 = *(const bf16x8*)(kb_ + soff); S.st_k1 = *(const bf16x8*)(kb_ + 32 * ld * 2 + soff); } while (0)
#define SWRITE_HK(bf) do { *(LAS bf16x8*)(K_lds + (bf) * SHM_K + kws) = S.st_k0; *(LAS bf16x8*)(K_lds + (bf) * SHM_K + kws + 32 * 256) = S.st_k1; } while (0)
#define SWRITE_HV(bf) do { *(LAS bf16x8*)(V_lds + (bf) * SHM_V + vst0) = S.st_v0; *(LAS bf16x8*)(V_lds + (bf) * SHM_V + vst1) = S.st_v1; } while (0)
#define SWRITE_H(bf) do { SWRITE_HV(bf); SWRITE_HK(bf); } while (0)
template <int ld> __device__ __forceinline__ void prime(const BlockRef& cur, LAS char* lds, Seam& S) {
    const int tid = opaque_tid(), wid = __builtin_amdgcn_readfirstlane(tid >> 6), lane = tid & 63, r32 = lane & 31, hi = lane >> 5;
    const int sr = tid >> 4, sc = (tid & 15) * 8, kws = KSWZ(sr, sc * 2); LAS char* K_lds = lds + 2 * SHM_V;
    const unsigned soff = (unsigned)(sr * ld + sc) * 2u, qoff = (unsigned)((wid * QBLK + r32) * ld + hi * 8) * 2u;
#pragma unroll
    for (int d0 = 0; d0 < 8; ++d0) S.qr[d0] = *(const bf16x8*)((const char*)cur.Q + qoff + d0 * 32);
    SLOAD_H(cur.K, cur.V, 0); VMW(); SWRITE_HK(0);
    __syncthreads();
}
template <int ld, int ldo> __device__ __forceinline__ void block(const BlockRef& cur, const BlockRef& nxt, LAS char* lds, Seam& S) {
    const int tid = opaque_tid(), wid = __builtin_amdgcn_readfirstlane(tid >> 6), lane = tid & 63, r32 = lane & 31, hi = lane >> 5;
    const int NT = (cur.P0 + QB - 1) / KVBLK + 1;
    const int qlo = cur.P0 + wid * QBLK, qm = qlo + r32 - 4 * hi;
    LAS char* V_lds = lds; LAS char* K_lds = lds + 2 * SHM_V;
    LAS float* ws = (LAS float*)(lds + OFF_WS) + wid * 64; LAS float* li_l = ws; LAS float* al_l = ws + 32;
    const LAS float* bias = (const LAS float*)(lds + OFF_BIAS) + 4 * hi;
    float m_reg = -1e30f, l_reg = 0; f32x16 o[4] = {};
    const int sr = tid >> 4, sc = (tid & 15) * 8, vst0 = v_st(sr, sc), vst1 = v_st(32 + sr, sc), kws = KSWZ(sr, sc * 2);
    const unsigned soff = (unsigned)(sr * ld + sc) * 2u;
    const int vb0 = (int)(uintptr_t)V_lds + v_rd_base(lane);
    const bf16_t* Kh = cur.K; const bf16_t* Vh = cur.V;
#define RESC(a) do { if (__any((a) < 1.f)) { if (hi == 0) al_l[r32] = (a); asm volatile("s_waitcnt lgkmcnt(0)" ::: "memory");              \
                     for (int d_ = 0; d_ < 4; ++d_) for (int r = 0; r < 16; ++r) o[d_][r] *= al_l[crow(r, hi)]; } } while (0)
#define KBASE(t) ((t) * KVBLK)
#define MASKT(P0_, P1_, t) do { const int kb_ = KBASE(t); if (kb_ + KVBLK - 1 > qlo) mask_tile(P0_, P1_, qm - kb_); } while (0)
    constexpr int NQL = 8;
#define SEAM_K0() do { VMWN(NQL); SWRITE_HK(0); SBAR(); } while (0)
    f32x16 pA0, pA1, pB0, pB1; float mnA, mnB, alA, alB; bf16x8 pa0, pa1, pa2, pa3;
    SWRITE_HV(0); SBAR();
    if (NT > 1) { SLOAD_H(Kh, Vh, KBASE(1)); }
    SBAR(); qkt<0>(pA0, pA1, K_lds, r32, hi, S.qr, bias + KBASE(0));
    MASKT(pA0, pA1, 0); partialSM(pA0, pA1, m_reg, mnA, alA);
    if (NT > 1) { VMW(); SWRITE_H(1); }
    __syncthreads();
#define HALF_STEP(PX0, PX1, mnX, alX, PY0, PY1, alY, t, KB, VB, SB) do {                                                      \
        SBAR(); qkt<KB>(PX0, PX1, K_lds, r32, hi, S.qr, bias + KBASE(t));                                             \
        finishSM(PY0, PY1, alY, l_reg, pa0, pa1, pa2, pa3); SBAR();                                                           \
        if ((t) + 1 < NT) { SLOAD_H(Kh, Vh, KBASE((t) + 1)); SBAR(); }                                               \
        pv_tile<VB>(o, vb0, pa0, pa1, pa2, pa3); MASKT(PX0, PX1, (t)); partialSM(PX0, PX1, m_reg, mnX, alX);                                        \
        __syncthreads();                                                                                                      \
        if ((t) + 1 < NT) { VMW(); SWRITE_H(SB); }                                                                          \
        RESC(alX); __syncthreads(); } while (0)
    for (int t = 1; t + 1 < NT; t += 2) {
        HALF_STEP(pB0, pB1, mnB, alB, pA0, pA1, alA, t, 1, 0, 0);
        HALF_STEP(pA0, pA1, mnA, alA, pB0, pB1, alB, t + 1, 0, 1, 1);
    }
    const bool even = (NT & 1) == 0;
    if (even) { SBAR(); qkt<1>(pB0, pB1, K_lds, r32, hi, S.qr, bias + KBASE(NT - 1)); SBAR(); }
    int tid2 = tid; asm volatile("" : "+v"(tid2));
    const int r32b = tid2 & 31, hib = (tid2 >> 5) & 1;
    SBAR();
    finishSM(pA0, pA1, alA, l_reg, pa0, pa1, pa2, pa3); SBAR();
    pv_tile<0>(o, vb0, pa0, pa1, pa2, pa3);
    if (even) { MASKT(pB0, pB1, NT - 1); partialSM(pB0, pB1, m_reg, mnB, alB); __syncthreads(); RESC(alB);
        finishSM(pB0, pB1, alB, l_reg, pa0, pa1, pa2, pa3); SBAR(); pv_tile<1>(o, vb0, pa0, pa1, pa2, pa3); }
    SBAR();
    if (hi == 0) li_l[r32] = l_reg; asm volatile("s_waitcnt lgkmcnt(0)" ::: "memory");
    float rli[16];
#pragma unroll
    for (int r = 0; r < 16; ++r) rli[r] = __builtin_amdgcn_rcpf(li_l[crow(r, hi)]);
    char* Ow = (char*)cur.O + (size_t)(wid * QBLK) * (ldo * 2); const unsigned ooff = (unsigned)(4 * hib * ldo + r32b) * 2u;
#pragma unroll
    for (int r = 0; r < 16; ++r) { const int orow0 = (r & 3) + 8 * (r >> 2);
#pragma unroll
        for (int d0 = 0; d0 < 4; ++d0) { const float v = o[d0][r] * rli[r]; const float vn = __shfl_xor(v, 1);
            if ((r32b & 1) == 0) *(unsigned*)(Ow + (size_t)(orow0 * ldo + d0 * 32) * 2 + ooff) = cvt_pk_bf16(v, vn); } }
    __syncthreads();
#undef RESC
#undef KBASE
#undef MASKT
#undef SEAM_K0
#undef HALF_STEP
}
#undef ROW
#undef VMW
#undef VMWN
#undef SLOAD_H
#undef SWRITE_HK
#undef SWRITE_HV
#undef SWRITE_H
#undef KSWZ
}
namespace ret {
constexpr int QS = 288, VS = 544, SS = 144;
constexpr int OFF_Q = 0, OFF_K = 64 * QS, OFF_V = 2 * 64 * QS, OFF_S = OFF_V + 64 * VS, OFF_QD = OFF_S + 64 * SS, OFF_RP = OFF_QD + 256, LDS_BYTES = OFF_RP + 8 * 64 * 4;
#define TRRD(dst, base, off) asm volatile("ds_read_b64_tr_b16 %0, %1 offset:%2" : "=&v"(dst) : "v"(base), "i"(off) : "memory")
__device__ __forceinline__ bf16x8 cat8(s16x4 a, s16x4 b) { return (bf16x8){a[0], a[1], a[2], a[3], b[0], b[1], b[2], b[3]}; }
__device__ __forceinline__ u32x4 scale8(u32x4 v, float s) {
    u32x4 o; o.x = cvt_pk_bf16(bflo(v.x) * s, bfhi(v.x) * s); o.y = cvt_pk_bf16(bflo(v.y) * s, bfhi(v.y) * s); o.z = cvt_pk_bf16(bflo(v.z) * s, bfhi(v.z) * s); o.w = cvt_pk_bf16(bflo(v.w) * s, bfhi(v.w) * s); return o;
}
__device__ __forceinline__ void item(const bf16_t* proj, bf16_t* yret, int b, int h, LAS unsigned char* lds) {
    const int tid = opaque_tid(), w = __builtin_amdgcn_readfirstlane(tid >> 6), lane = tid & 63, c = lane & 15, q = lane >> 4, qq = c >> 2, p = c & 3;
    const float gam = 1.0f - __builtin_amdgcn_exp2f(-5.0f - (float)h);
    const float lg = log2f(gam);
    const float cd = __builtin_amdgcn_exp2f(lg * 64.0f);
    const int srow = tid >> 3, sseg = tid & 7;
    const float kd = __builtin_amdgcn_exp2f(lg * (float)(63 - srow));
    if (tid < 64) ((LAS float*)(lds + OFF_QD))[tid] = __builtin_amdgcn_exp2f(lg * (float)(tid + 1));
    const size_t tok0 = (size_t)b * SEQ;
    const bf16_t* gq = proj + (tok0 + srow) * NPROJ + C_RQ + h * 128 + 16 * sseg;
    const bf16_t* gk = proj + (tok0 + srow) * NPROJ + C_RK + h * 128 + 16 * sseg;
    const bf16_t* gv = proj + (tok0 + srow) * NPROJ + C_RV + h * 256 + 32 * sseg;
    LAS unsigned char* wq = lds + OFF_Q + srow * QS + sseg * 32; LAS unsigned char* wk = lds + OFF_K + srow * QS + sseg * 32; LAS unsigned char* wv = lds + OFF_V + srow * VS + sseg * 64;
    u32x4 pq0, pq1, pk0, pk1, pv0, pv1, pv2, pv3;
#define RET_LOAD(ch) do { const size_t o_ = (size_t)(ch) * 64 * NPROJ; pq0 = *(const u32x4*)(gq + o_); pq1 = *(const u32x4*)(gq + o_ + 8); pk0 = *(const u32x4*)(gk + o_); pk1 = *(const u32x4*)(gk + o_ + 8); \
        pv0 = *(const u32x4*)(gv + o_); pv1 = *(const u32x4*)(gv + o_ + 8); pv2 = *(const u32x4*)(gv + o_ + 16); pv3 = *(const u32x4*)(gv + o_ + 24); } while (0)
#define RET_WRITE() do { *(LAS u32x4*)(wq) = pq0; *(LAS u32x4*)(wq + 16) = pq1; *(LAS u32x4*)(wk) = scale8(pk0, kd); *(LAS u32x4*)(wk + 16) = scale8(pk1, kd); \
        *(LAS u32x4*)(wv) = pv0; *(LAS u32x4*)(wv + 16) = pv1; *(LAS u32x4*)(wv + 32) = pv2; *(LAS u32x4*)(wv + 48) = pv3; } while (0)
    f32x4 st[8][2];
#pragma unroll
    for (int dt = 0; dt < 8; ++dt) { st[dt][0] = (f32x4){0.f, 0.f, 0.f, 0.f}; st[dt][1] = (f32x4){0.f, 0.f, 0.f, 0.f}; }
    RET_LOAD(0); RET_WRITE();
    LDS_WAIT(); __syncthreads();
    const int mt = w & 3, nt0 = 2 * (w >> 2);
    const unsigned vbase = (unsigned)(uintptr_t)(lds + OFF_V) + (unsigned)((4 * q + qq) * VS + (32 * w + 4 * p) * 2);
    const unsigned kbase = (unsigned)(uintptr_t)(lds + OFF_K) + (unsigned)((4 * q + qq) * QS + (4 * p) * 2);
    const LAS unsigned char* qperm = lds + OFF_Q + c * QS + (4 * q) * 2;
    const LAS unsigned char* sperm = lds + OFF_S + c * SS + (4 * q) * 2;
    const LAS float* qd = (const LAS float*)(lds + OFF_QD); LAS float* rp = (LAS float*)(lds + OFF_RP);
    for (int ch = 0; ch < SEQ / 64; ++ch) {
        if (ch + 1 < SEQ / 64) RET_LOAD(ch + 1);
        {
            f32x4 s0 = (f32x4){0.f, 0.f, 0.f, 0.f}, s1 = (f32x4){0.f, 0.f, 0.f, 0.f};
#pragma unroll
            for (int ks = 0; ks < 4; ++ks) { const bf16x8 ak = *(const LAS bf16x8*)(lds + OFF_K + (16 * mt + c) * QS + (32 * ks + 8 * q) * 2);
                const bf16x8 b0 = *(const LAS bf16x8*)(lds + OFF_Q + (16 * nt0 + c) * QS + (32 * ks + 8 * q) * 2), b1 = *(const LAS bf16x8*)(lds + OFF_Q + (16 * nt0 + 16 + c) * QS + (32 * ks + 8 * q) * 2);
                s0 = __builtin_amdgcn_mfma_f32_16x16x32_bf16(ak, b0, s0, 0, 0, 0); s1 = __builtin_amdgcn_mfma_f32_16x16x32_bf16(ak, b1, s1, 0, 0, 0); }
#pragma unroll
            for (int t = 0; t < 2; ++t) { const int n = 16 * (nt0 + t) + c; f32x4 sv = t ? s1 : s0;
#pragma unroll
                for (int j = 0; j < 4; ++j) { const int m = 16 * mt + 4 * q + j; const int d = n > m ? n - m : m - n; sv[j] *= __builtin_amdgcn_exp2f(lg * (float)(d + m - 63)); }
                u32x2 o; o.x = cvt_pk_bf16(sv[0], sv[1]); o.y = cvt_pk_bf16(sv[2], sv[3]); *(LAS u32x2*)(lds + OFF_S + n * SS + (16 * mt + 4 * q) * 2) = o; }
        }
        LDS_WAIT(); __syncthreads();
        f32x4 acc[2][4];
#pragma unroll
        for (int ct = 0; ct < 2; ++ct)
#pragma unroll
            for (int nt = 0; nt < 4; ++nt) acc[ct][nt] = (f32x4){0.f, 0.f, 0.f, 0.f};
#pragma unroll
        for (int ks = 0; ks < 4; ++ks) {
            bf16x8 as[2];
#pragma unroll
            for (int ct = 0; ct < 2; ++ct) { const f32x4 x0 = st[2 * ks][ct], x1 = st[2 * ks + 1][ct]; u32x4 u; u.x = cvt_pk_bf16(x0[0], x0[1]); u.y = cvt_pk_bf16(x0[2], x0[3]); u.z = cvt_pk_bf16(x1[0], x1[1]); u.w = cvt_pk_bf16(x1[2], x1[3]); as[ct] = __builtin_bit_cast(bf16x8, u); }
#pragma unroll
            for (int nt = 0; nt < 4; ++nt) { const u32x2 lo = *(const LAS u32x2*)(qperm + nt * 16 * QS + ks * 64), hi = *(const LAS u32x2*)(qperm + nt * 16 * QS + ks * 64 + 32);
                const u32x4 bu = {lo.x, lo.y, hi.x, hi.y}; const bf16x8 bq = __builtin_bit_cast(bf16x8, bu);
                acc[0][nt] = __builtin_amdgcn_mfma_f32_16x16x32_bf16(as[0], bq, acc[0][nt], 0, 0, 0); acc[1][nt] = __builtin_amdgcn_mfma_f32_16x16x32_bf16(as[1], bq, acc[1][nt], 0, 0, 0); }
        }
#pragma unroll
        for (int nt = 0; nt < 4; ++nt) { const float f = qd[16 * nt + c]; acc[0][nt] = acc[0][nt] * f; acc[1][nt] = acc[1][nt] * f; }
        bf16x8 vt[2][2];
        { s16x4 a0, a1, a2, a3, a4, a5, a6, a7;
          TRRD(a0, vbase, 0); TRRD(a1, vbase, 16 * VS); TRRD(a2, vbase, 32); TRRD(a3, vbase, 16 * VS + 32);
          TRRD(a4, vbase, 32 * VS); TRRD(a5, vbase, 48 * VS); TRRD(a6, vbase, 32 * VS + 32); TRRD(a7, vbase, 48 * VS + 32);
          asm volatile("s_waitcnt lgkmcnt(0)" ::: "memory"); SBAR();
          vt[0][0] = cat8(a0, a1); vt[0][1] = cat8(a2, a3); vt[1][0] = cat8(a4, a5); vt[1][1] = cat8(a6, a7); }
#pragma unroll
        for (int ks2 = 0; ks2 < 2; ++ks2)
#pragma unroll
            for (int nt = 0; nt < 4; ++nt) { const u32x2 lo = *(const LAS u32x2*)(sperm + nt * 16 * SS + ks2 * 64), hi = *(const LAS u32x2*)(sperm + nt * 16 * SS + ks2 * 64 + 32);
                const u32x4 bu = {lo.x, lo.y, hi.x, hi.y}; const bf16x8 bs = __builtin_bit_cast(bf16x8, bu);
                acc[0][nt] = __builtin_amdgcn_mfma_f32_16x16x32_bf16(vt[ks2][0], bs, acc[0][nt], 0, 0, 0); acc[1][nt] = __builtin_amdgcn_mfma_f32_16x16x32_bf16(vt[ks2][1], bs, acc[1][nt], 0, 0, 0); }
#pragma unroll
        for (int dt = 0; dt < 8; ++dt) { s16x4 k0, k1, k2, k3;
            TRRD(k0, kbase, dt * 32); TRRD(k1, kbase, 16 * QS + dt * 32); TRRD(k2, kbase, 32 * QS + dt * 32); TRRD(k3, kbase, 48 * QS + dt * 32);
            asm volatile("s_waitcnt lgkmcnt(0)" ::: "memory"); SBAR();
            const bf16x8 ka = cat8(k0, k1), kb = cat8(k2, k3);
#pragma unroll
            for (int ct = 0; ct < 2; ++ct) { f32x4 s = st[dt][ct] * cd; s = __builtin_amdgcn_mfma_f32_16x16x32_bf16(ka, vt[0][ct], s, 0, 0, 0); s = __builtin_amdgcn_mfma_f32_16x16x32_bf16(kb, vt[1][ct], s, 0, 0, 0); st[dt][ct] = s; } }
#pragma unroll
        for (int nt = 0; nt < 4; ++nt) { float ss = 0.f;
#pragma unroll
            for (int ct = 0; ct < 2; ++ct)
#pragma unroll
                for (int j = 0; j < 4; ++j) ss += acc[ct][nt][j] * acc[ct][nt][j];
            ss += __shfl_xor(ss, 16); ss += __shfl_xor(ss, 32);
            if (q == 0) rp[w * 64 + 16 * nt + c] = ss; }
        LDS_WAIT(); __syncthreads();
        const size_t trow = tok0 + (size_t)ch * 64;
#pragma unroll
        for (int nt = 0; nt < 4; ++nt) { float tot = 0.f;
#pragma unroll
            for (int ww = 0; ww < 8; ++ww) tot += rp[ww * 64 + 16 * nt + c];
            const float rstd = 1.0f / sqrtf(tot * (1.0f / 256.0f) + RMS_EPS); const size_t tk = trow + 16 * nt + c;
#pragma unroll
            for (int ct = 0; ct < 2; ++ct) { const int col = h * 256 + 32 * w + 16 * ct + 4 * q;
                const u32x2 g = *(const u32x2*)(proj + tk * NPROJ + C_RG + col); const f32x4 a = acc[ct][nt] * rstd;
                u32x2 o; o.x = cvt_pk_bf16(a[0] * bflo(g.x), a[1] * bfhi(g.x)); o.y = cvt_pk_bf16(a[2] * bflo(g.y), a[3] * bfhi(g.y));
                *(u32x2*)(yret + tk * DM + col) = o; } }
        if (ch + 1 < SEQ / 64) { RET_WRITE(); }
        LDS_WAIT(); __syncthreads();
    }
#undef RET_LOAD
#undef RET_WRITE
}
#undef TRRD
}
constexpr int N_PHASES = 2 + 8 * NLAYER;
struct Args { const float* in[19]; float* out; unsigned char* ws; int ph_lo, ph_hi; };

__device__ __forceinline__ void moe_tables(Frame& F, int l) {
    LAS int* tab = (LAS int*)(F.lds + MOE_OFF);
    __syncthreads();
    if (F.tid < 32) tab[F.tid] = (int)__hip_atomic_load(F.ctl + CW_CNT + l * 2048 + 64 * F.tid, RLX_AGENT);
    LDS_WAIT(); __syncthreads();
    if (F.tid == 0) { int sa = 0, ta = 0; for (int e = 0; e < 32; ++e) { const int t = (tab[e] + 255) >> 8; tab[32 + e] = sa; tab[64 + e] = ta; sa += t * 256; ta += t; } tab[96] = ta; }
    LDS_WAIT(); __syncthreads();
}

__device__ __forceinline__ void mixer_phase(int l, int mode = 0) {
    for (;;) {
        GAS unsigned char* wsg_ = (GAS unsigned char*)KWS(); asm volatile("" : "+s"(wsg_)); unsigned char* ws = (unsigned char*)wsg_;
        LAS unsigned char* ldsb = (LAS unsigned char*)0; volatile LAS unsigned* MISC = (volatile LAS unsigned*)(ldsb + MISC_OFF);
        const int tid = opaque_tid(), lane = tid & 63, wave = __builtin_amdgcn_readfirstlane(tid >> 6);
        __syncthreads();
        if (tid == 0) MISC[16] = __hip_atomic_fetch_add((gu32*)(ws + WS_CTL) + CW_QUEUE + 64 * l, 1u, RLX_AGENT);
        LDS_WAIT(); __syncthreads();
        const int it = __builtin_amdgcn_readfirstlane((int)MISC[16]);
        if (it >= 576) break;
        if ((mode == 1 && it >= 64) || (mode == 2 && it < 64)) continue;
        const bf16_t* proj = (const bf16_t*)(ws + WS_PROJ);
#ifndef NO_RET
        if (it < 64) { ret::item(proj, (bf16_t*)(ws + WS_YR), it >> 3, it & 7, ldsb); continue; }
#endif
#ifndef NO_FOX
        const int j = it - 64, x = 7 - (j >> 6), bh = j & 63, b = bh >> 3, h = bh & 7;
        { const int n = 256 * (x + 1); LAS float* bias = (LAS float*)(ldsb + fox::OFF_BIAS); LAS float* wt = (LAS float*)(ldsb + fox::OFF_WS);
          const float* logf = (const float*)(ws + WS_LOGF);
          f32x4 v = (f32x4){0.f, 0.f, 0.f, 0.f}; if (4 * tid < n) v = *(const f32x4*)(logf + (size_t)(b * 8 + h) * SEQ + 4 * tid);
          v[1] += v[0]; v[2] += v[1]; v[3] += v[2];
          float run = v[3];
#pragma unroll
          for (int o = 1; o < 64; o <<= 1) { const float t = __shfl_up(run, o); if (lane >= o) run += t; }
          if (lane == 63) wt[wave] = run;
          LDS_WAIT(); __syncthreads();
          float base = run - v[3];
          for (int ww = 0; ww < wave; ++ww) base += wt[ww];
          *(LAS f32x4*)(bias + 4 * tid) = (f32x4){-(v[0] + base) * LOG2E, -(v[1] + base) * LOG2E, -(v[2] + base) * LOG2E, -(v[3] + base) * LOG2E};
          LDS_WAIT(); __syncthreads(); }
        const size_t tok0 = (size_t)b * SEQ;
        fox::BlockRef cur;
        cur.Q = proj + (tok0 + 256 * x) * NPROJ + C_FQ + h * 128; cur.K = proj + tok0 * NPROJ + C_FK + h * 128; cur.V = proj + tok0 * NPROJ + C_FV + h * 128;
        cur.O = (bf16_t*)(ws + WS_YF) + (tok0 + 256 * x) * 1024 + h * 128; cur.P0 = 256 * x;
        fox::Seam S;
        fox::prime<NPROJ>(cur, (LAS char*)ldsb, S);
        fox::block<NPROJ, 1024>(cur, cur, (LAS char*)ldsb, S);
#endif
    }
}

__global__ void __launch_bounds__(NWAVES * 64, 2) hybrid_fwd(Args args) {
    extern __shared__ __attribute__((aligned(16))) unsigned char lds_raw[];
    { LAS unsigned char* l0 = (LAS unsigned char*)lds_raw;
      for (int u = threadIdx.x; u < (LDS_BYTES - LDSCTL_OFF) / 4; u += NWAVES * 64) ((LAS unsigned*)(l0 + LDSCTL_OFF))[u] = 0u;
      __syncthreads(); }
#if MK_N_LAUNCHES == 1
    { GAS unsigned char* wsg_ = (GAS unsigned char*)args.ws; asm volatile("" : "+s"(wsg_)); unsigned char* ws = (unsigned char*)wsg_; (void)xcd_barrier_post((unsigned*)((gu32*)(ws + WS_CTL) + CW_BAR), (volatile LAS unsigned*)((LAS unsigned char*)lds_raw + MISC_OFF) + 8); }
#define GRID_BAR() do { GAS unsigned char* wsg_ = (GAS unsigned char*)args.ws; asm volatile("" : "+s"(wsg_)); unsigned char* ws_ = (unsigned char*)wsg_; XcdBarrier bar_; bar_.bar = (unsigned*)((gu32*)(ws_ + WS_CTL) + CW_BAR); bar_.x = xb_xcc_id(); \
        bar_.st = (volatile LAS unsigned*)((LAS unsigned char*)lds_raw + MISC_OFF) + 8; xcd_barrier(bar_); } while (0)
#else
#define GRID_BAR() do {} while (0)
#endif
    const int lo = args.ph_lo, hi = args.ph_hi;
#define IN(k) (lo <= (k) && (k) < hi)
#define SEAM(k) do { if (IN(k) && IN((k) + 1)) GRID_BAR(); } while (0)
#define PHASE_PTRS() GAS unsigned char* wsg_ = (GAS unsigned char*)args.ws; asm volatile("" : "+s"(wsg_)); unsigned char* ws = (unsigned char*)wsg_; Frame F; F.lds = (LAS unsigned char*)lds_raw; F.MISC = (volatile LAS unsigned*)(F.lds + MISC_OFF); \
    F.tid = opaque_tid(); F.lane = F.tid & 63; F.wave = __builtin_amdgcn_readfirstlane(F.tid >> 6); F.G = gridDim.x; F.bx = blockIdx.x; F.ws = ws; F.ctl = (gu32*)(ws + WS_CTL); F.out = (float*)(GAS float*)args.out; \
    float* hf = (float*)(ws + WS_HF); bf16_t* hb = (bf16_t*)(ws + WS_HB); bf16_t* proj = (bf16_t*)(ws + WS_PROJ); \
    bf16_t* yfox = (bf16_t*)(ws + WS_YF); bf16_t* yret = (bf16_t*)(ws + WS_YR); bf16_t* mg = (bf16_t*)(ws + WS_MG); \
    float* z1 = (float*)(ws + WS_Z1); bf16_t* hid = (bf16_t*)(ws + WS_HID); bf16_t* ffo = (bf16_t*)(ws + WS_FFO); \
    float* logf = (float*)(ws + WS_LOGF); int* route = (int*)(ws + WS_ROUTE); int* list = (int*)(ws + WS_LIST); float* wlist = (float*)(ws + WS_WLIST); \
    const float* cosT = (const float*)(ws + WS_ROPE); const float* sinT = cosT + SEQ * 64; \
    const LAS int* tab = (const LAS int*)(F.lds + MOE_OFF); unsigned char* wl = ws + WS_W; \
    (void)hf; (void)hb; (void)proj; (void)yfox; (void)yret; (void)mg; (void)z1; (void)hid; (void)ffo; (void)logf; (void)route; (void)list; (void)wlist; (void)cosT; (void)sinT; (void)tab; (void)wl
#ifndef PH_MASK
#define PH_MASK 0xFFFF
#endif
#define PHON(k) ((PH_MASK >> (k)) & 1)
#ifndef DUP_MASK
#define DUP_MASK 0
#endif
#define REPS(k) (((DUP_MASK >> (k)) & 1) ? 2 : 1)
    if (PHON(0) && IN(0)) { const int l = 0; PHASE_PTRS(); for (int rep_ = 0; rep_ < REPS(0); ++rep_) p0_weights(F, 0); p0_tables(F); } SEAM(0);
    if (PHON(1) && IN(1)) { const int l = 0; PHASE_PTRS();
        LnArgs a{}; a.zin = INP(0); a.hf = hf; a.hb = hb; a.g = INP(1); a.b = INP(2);
        a.whi = (const bf16_t*)(ws + WS_SKW); a.wlo = a.whi + 16 * 2048; a.S12 = (const float*)(ws + WS_SKS); a.bfor = INP(4); a.logf = logf;
        for (int rep_ = 0; rep_ < REPS(1); ++rep_) ln_pass<0, 1, true>(F, a);
    } SEAM(1);
    { constexpr int l = 0;
        const int pb = 2 + 8 * l;
        if (PHON(2) && IN(pb + 0)) { PHASE_PTRS();
            gm::SchedDense S{(const char*)hb, (const char*)(wl + WL_WIN), 2048 * 2, 2048 * 2, 32, 64, 52, F.G, F.bx};
            gm::EpiProj E{proj, cosT, sinT};
            for (int rep_ = 0; rep_ < REPS(2); ++rep_) gm::gemm_phase<true>(F.lds, S, E);
        } SEAM(pb + 0);
        if (PHON(3) && IN(pb + 1)) { for (int rep_ = 0; rep_ < REPS(3); ++rep_) mixer_phase(l + 2 * rep_, rep_ ? ((DUP_MASK >> 10) & 3) : 0); } SEAM(pb + 1);
        if (PHON(4) && IN(pb + 2)) { PHASE_PTRS();
            gm::SchedMerge S{(const char*)yfox, (const char*)(wl + WL_WBF), (const char*)yret, (const char*)(wl + WL_WBR), 64, 8, F.G, F.bx};
            gm::EpiMerge E{proj, mg};
            for (int rep_ = 0; rep_ < REPS(4); ++rep_) gm::gemm_phase<true>(F.lds, S, E);
        } SEAM(pb + 2);
        if (PHON(5) && IN(pb + 3)) { PHASE_PTRS();
            gm::SchedDense S{(const char*)mg, (const char*)(wl + WL_WOUT), 2048 * 2, 2048 * 2, 32, 64, 8, F.G, F.bx};
            gm::EpiOut E{hf, z1};
            for (int rep_ = 0; rep_ < REPS(5); ++rep_) gm::gemm_phase<false>(F.lds, S, E);
        } SEAM(pb + 3);
        if (PHON(6) && IN(pb + 4)) { PHASE_PTRS();
            LnArgs a{}; a.zin = z1; a.hf = z1; a.hb = hb; a.g = INP(8) + l * DM; a.b = INP(9) + l * DM;
            a.whi = (const bf16_t*)(ws + WS_SKW + 2 * SKW_FGT_BYTES + (size_t)l * SKW_RTR_BYTES); a.wlo = a.whi + 48 * 2048; a.S12 = (const float*)(ws + WS_SKS + (size_t)(2 + l) * 512);
            a.brg = INP(11) + l * 4; a.bre = INP(13) + l * 32; a.route_out = route; a.list = list; a.wlist = wlist; a.cnt = (unsigned*)(F.ctl + CW_CNT + l * 2048);
            if (REPS(6) == 2) { LnArgs d = a; d.hf = hf; d.hb = mg; d.route_out = (int*)ffo; d.list = (int*)ffo + (1 << 20); d.wlist = (float*)ffo + (2 << 20); d.cnt = (unsigned*)(F.ctl + CW_CNT + 4096 + l * 2048);
                ln_pass<1, 3, true>(F, d); }
            ln_pass<1, 3, true>(F, a);
        } SEAM(pb + 4);
        if (PHON(7) && IN(pb + 5)) { PHASE_PTRS();
            moe_tables(F, l);
            gm::SchedMoe<true> S{tab, (const char*)hb, (const char*)(wl + WL_WGU), list, 4, F.G, F.bx};
            gm::EpiMoe1 E{hid, wlist, tab};
            for (int rep_ = 0; rep_ < REPS(7); ++rep_) gm::gemm_phase<true>(F.lds, S, E);
        } SEAM(pb + 5);
        if (PHON(8) && IN(pb + 6)) { PHASE_PTRS();
            moe_tables(F, l);
            gm::SchedMoe<false> S{tab, (const char*)hid, (const char*)(wl + WL_WD), list, 8, F.G, F.bx};
            gm::EpiMoe2 E{ffo};
            for (int rep_ = 0; rep_ < REPS(8); ++rep_) gm::gemm_phase<true>(F.lds, S, E);
        } SEAM(pb + 6);
        if (PHON(9) && IN(pb + 7)) { PHASE_PTRS();
            if (l + 1 < NLAYER) for (int rep_ = 0; rep_ < REPS(0); ++rep_) p0_weights(F, l + 1);
            moe_tables(F, l);
            LnArgs a{}; a.zin = z1; a.ffo = ffo; a.route = route; a.tab = tab; a.g = INP(17) + l * DM; a.b = INP(18) + l * DM;
            if (l + 1 < NLAYER) { a.hf = hf; a.hb = hb; a.whi = (const bf16_t*)(ws + WS_SKW + (size_t)(l + 1) * SKW_FGT_BYTES); a.wlo = a.whi + 16 * 2048; a.S12 = (const float*)(ws + WS_SKS + (size_t)(l + 1) * 512);
                a.bfor = INP(4) + (l + 1) * 8; a.logf = logf; for (int rep_ = 0; rep_ < REPS(9); ++rep_) ln_pass<2, 1, true>(F, a); }
            else { a.hf = F.out; a.hb = nullptr; ln_pass<2, 1, false>(F, a); }
        } SEAM(pb + 7);
    }
    { constexpr int l = 1;
        const int pb = 2 + 8 * l;
        if (PHON(2) && IN(pb + 0)) { PHASE_PTRS();
            gm::SchedDense S{(const char*)hb, (const char*)(wl + WL_WIN), 2048 * 2, 2048 * 2, 32, 64, 52, F.G, F.bx};
            gm::EpiProj E{proj, cosT, sinT};
            for (int rep_ = 0; rep_ < REPS(2); ++rep_) gm::gemm_phase<true>(F.lds, S, E);
        } SEAM(pb + 0);
        if (PHON(3) && IN(pb + 1)) { for (int rep_ = 0; rep_ < REPS(3); ++rep_) mixer_phase(l + 2 * rep_, rep_ ? ((DUP_MASK >> 10) & 3) : 0); } SEAM(pb + 1);
        if (PHON(4) && IN(pb + 2)) { PHASE_PTRS();
            gm::SchedMerge S{(const char*)yfox, (const char*)(wl + WL_WBF), (const char*)yret, (const char*)(wl + WL_WBR), 64, 8, F.G, F.bx};
            gm::EpiMerge E{proj, mg};
            for (int rep_ = 0; rep_ < REPS(4); ++rep_) gm::gemm_phase<true>(F.lds, S, E);
        } SEAM(pb + 2);
        if (PHON(5) && IN(pb + 3)) { PHASE_PTRS();
            gm::SchedDense S{(const char*)mg, (const char*)(wl + WL_WOUT), 2048 * 2, 2048 * 2, 32, 64, 8, F.G, F.bx};
            gm::EpiOut E{hf, z1};
            for (int rep_ = 0; rep_ < REPS(5); ++rep_) gm::gemm_phase<false>(F.lds, S, E);
        } SEAM(pb + 3);
        if (PHON(6) && IN(pb + 4)) { PHASE_PTRS();
            LnArgs a{}; a.zin = z1; a.hf = z1; a.hb = hb; a.g = INP(8) + l * DM; a.b = INP(9) + l * DM;
            a.whi = (const bf16_t*)(ws + WS_SKW + 2 * SKW_FGT_BYTES + (size_t)l * SKW_RTR_BYTES); a.wlo = a.whi + 48 * 2048; a.S12 = (const float*)(ws + WS_SKS + (size_t)(2 + l) * 512);
            a.brg = INP(11) + l * 4; a.bre = INP(13) + l * 32; a.route_out = route; a.list = list; a.wlist = wlist; a.cnt = (unsigned*)(F.ctl + CW_CNT + l * 2048);
            if (REPS(6) == 2) { LnArgs d = a; d.hf = hf; d.hb = mg; d.route_out = (int*)ffo; d.list = (int*)ffo + (1 << 20); d.wlist = (float*)ffo + (2 << 20); d.cnt = (unsigned*)(F.ctl + CW_CNT + 4096 + l * 2048);
                ln_pass<1, 3, true>(F, d); }
            ln_pass<1, 3, true>(F, a);
        } SEAM(pb + 4);
        if (PHON(7) && IN(pb + 5)) { PHASE_PTRS();
            moe_tables(F, l);
            gm::SchedMoe<true> S{tab, (const char*)hb, (const char*)(wl + WL_WGU), list, 4, F.G, F.bx};
            gm::EpiMoe1 E{hid, wlist, tab};
            for (int rep_ = 0; rep_ < REPS(7); ++rep_) gm::gemm_phase<true>(F.lds, S, E);
        } SEAM(pb + 5);
        if (PHON(8) && IN(pb + 6)) { PHASE_PTRS();
            moe_tables(F, l);
            gm::SchedMoe<false> S{tab, (const char*)hid, (const char*)(wl + WL_WD), list, 8, F.G, F.bx};
            gm::EpiMoe2 E{ffo};
            for (int rep_ = 0; rep_ < REPS(8); ++rep_) gm::gemm_phase<true>(F.lds, S, E);
        } SEAM(pb + 6);
        if (PHON(9) && IN(pb + 7)) { PHASE_PTRS();
            if (l + 1 < NLAYER) for (int rep_ = 0; rep_ < REPS(0); ++rep_) p0_weights(F, l + 1);
            moe_tables(F, l);
            LnArgs a{}; a.zin = z1; a.ffo = ffo; a.route = route; a.tab = tab; a.g = INP(17) + l * DM; a.b = INP(18) + l * DM;
            if (l + 1 < NLAYER) { a.hf = hf; a.hb = hb; a.whi = (const bf16_t*)(ws + WS_SKW + (size_t)(l + 1) * SKW_FGT_BYTES); a.wlo = a.whi + 16 * 2048; a.S12 = (const float*)(ws + WS_SKS + (size_t)(l + 1) * 512);
                a.bfor = INP(4) + (l + 1) * 8; a.logf = logf; for (int rep_ = 0; rep_ < REPS(9); ++rep_) ln_pass<2, 1, true>(F, a); }
            else { a.hf = F.out; a.hb = nullptr; ln_pass<2, 1, false>(F, a); }
        } SEAM(pb + 7);
    }
#undef IN
#undef SEAM
#undef GRID_BAR
}

extern "C" void kernel_launch(void* const* d_in, const int* in_sizes, int n_in, void* d_out, int out_size, void* d_ws, size_t ws_size, hipStream_t stream) {
    static int grid = 0;
    if (grid == 0) {
        if (n_in != 19 || out_size != NTOK * DM || ws_size < WS_END) { fprintf(stderr, "kernel_launch: unexpected problem (n_in %d, out %d, ws %zu)\n", n_in, out_size, ws_size); grid = -1; }
        int dev = 0, cus = 0;
        if (grid == 0 && (hipGetDevice(&dev) != hipSuccess || hipDeviceGetAttribute(&cus, hipDeviceAttributeMultiprocessorCount, dev) != hipSuccess)) grid = -1;
        if (grid == 0 && hipFuncSetAttribute((const void*)hybrid_fwd, hipFuncAttributeMaxDynamicSharedMemorySize, LDS_BYTES) != hipSuccess) { fprintf(stderr, "kernel_launch: hipFuncSetAttribute failed\n"); grid = -1; }
        (void)hipGetLastError();
        if (grid == 0) grid = cus;
    }
    if (grid < 0) { (void)hipMemsetAsync(d_out, 0xFF, (size_t)out_size * 4, stream); return; }
    if (hipMemsetAsync((char*)d_ws + WS_CTL, 0, CTL_ZERO_BYTES, stream) != hipSuccess) return;
    Args a{};
    for (int i = 0; i < 19; ++i) a.in[i] = (const float*)d_in[i];
    a.out = (float*)d_out; a.ws = (unsigned char*)d_ws;
#if MK_N_LAUNCHES == 1
    a.ph_lo = 0; a.ph_hi = N_PHASES;
    hipLaunchKernelGGL(hybrid_fwd, dim3(grid), dim3(NWAVES * 64), LDS_BYTES, stream, a);
#else
    for (int ph = 0; ph < N_PHASES; ++ph) { a.ph_lo = ph; a.ph_hi = ph + 1; hipLaunchKernelGGL(hybrid_fwd, dim3(grid), dim3(NWAVES * 64), LDS_BYTES, stream, a); }
#endif
}
```

```cpp
#include <hip/hip_runtime.h>
#include <cstdio>
#include <cstdint>

#ifndef MK_N_LAUNCHES
#define MK_N_LAUNCHES 1
#endif

#define LAS __attribute__((address_space(3)))
#define GAS __attribute__((address_space(1)))
typedef unsigned short bf16_t;
typedef short bf16x8 __attribute__((ext_vector_type(8)));
typedef short s16x4 __attribute__((ext_vector_type(4)));
typedef float f32x4 __attribute__((ext_vector_type(4)));
typedef float f32x2 __attribute__((ext_vector_type(2)));
typedef float f32x16 __attribute__((ext_vector_type(16)));
typedef unsigned u32x4 __attribute__((ext_vector_type(4)));
typedef unsigned u32x2 __attribute__((ext_vector_type(2)));
typedef GAS unsigned gu32;
#define RLX_AGENT __ATOMIC_RELAXED, __HIP_MEMORY_SCOPE_AGENT
#define LDS_WAIT() asm volatile("s_waitcnt lgkmcnt(0)" ::: "memory")
#define VM_WAIT() asm volatile("s_waitcnt vmcnt(0)" ::: "memory")
#define SBAR() __builtin_amdgcn_sched_barrier(0)

constexpr int NTOK = 16384, DM = 2048, SEQ = 2048, NBATCH = 8, NLAYER = 2;
constexpr int NPROJ = 13312;
constexpr int C_FQ = 0, C_FK = 1024, C_FV = 2048, C_RQ = 3072, C_RK = 4096, C_RV = 5120, C_RG = 7168, C_GF = 9216, C_GR = 11264;
constexpr int W_IN_COLS = 13320;
constexpr int NEXP = 32, DEXP = 512;
constexpr int HID_ROWS = 40960;
constexpr float ALPHA = 1.4142135623730951f;
constexpr float LN_EPS = 1e-5f, RMS_EPS = 1e-6f;
constexpr float LOG2E = 1.4426950408889634f;
constexpr float QSCALE = 0.08838834764831845f * LOG2E;
constexpr float KSCALE = 0.08838834764831845f;

constexpr size_t MiB = 1u << 20;
constexpr size_t WS_CTL = 0, CTL_ZERO_BYTES = 1 * MiB;
constexpr size_t WS_ROPE = 1 * MiB;
constexpr size_t WS_SKW = 2 * MiB;
constexpr size_t SKW_FGT_BYTES = 16 * 2048 * 2 * 2, SKW_RTR_BYTES = 48 * 2048 * 2 * 2;
constexpr size_t WS_SKS = 3 * MiB;
constexpr size_t WS_LOGF = 3 * MiB + 512 * 1024;
constexpr size_t WS_ROUTE = 4 * MiB;
constexpr size_t WS_LIST = 5 * MiB;
constexpr size_t WS_WLIST = 7 * MiB;
constexpr size_t WS_W = 16 * MiB;
constexpr size_t WL_WIN = 0, WL_WBF = 52 * MiB, WL_WBR = 56 * MiB, WL_WOUT = 64 * MiB, WL_WGU = 72 * MiB, WL_WD = 200 * MiB, WL_BYTES = 264 * MiB;
constexpr size_t WS_HF = 280 * MiB;
constexpr size_t WS_HB = 408 * MiB;
constexpr size_t WS_YF = 472 * MiB, WS_YR = 504 * MiB, WS_MG = 568 * MiB;
constexpr size_t WS_PROJ = 632 * MiB;
constexpr size_t WS_Z1 = WS_PROJ, WS_HID = WS_PROJ + 128 * MiB, WS_FFO = WS_PROJ + 168 * MiB;
constexpr size_t WS_END = 1048 * MiB;
static_assert(WS_FFO + (size_t)HID_ROWS * 2048 * 2 <= WS_END && WS_HID + (size_t)HID_ROWS * 512 * 2 <= WS_FFO, "overlay map");
constexpr int CW_TMO = 0;
constexpr int CW_BAR = 4096;
constexpr int CW_QUEUE = 8192;
constexpr int CW_CNT = 9216;

constexpr int RING_BYTES = 131072;
constexpr int LDSCTL_OFF = RING_BYTES;
constexpr int MISC_OFF = LDSCTL_OFF;
constexpr int MOE_OFF = LDSCTL_OFF + 256;
constexpr int LNS_OFF = LDSCTL_OFF + 1024;
constexpr int LDS_BYTES = 163840;

__device__ __forceinline__ unsigned cvt_pk_bf16(float lo, float hi) { unsigned r; asm volatile("v_cvt_pk_bf16_f32 %0, %1, %2" : "=v"(r) : "v"(lo), "v"(hi)); return r; }
__device__ __forceinline__ unsigned f2bf(float f) { unsigned u = __builtin_bit_cast(unsigned, f); return (u + 0x7fffu + ((u >> 16) & 1u)) >> 16; }
__device__ __forceinline__ unsigned pk2(float lo, float hi) { return f2bf(lo) | (f2bf(hi) << 16); }
__device__ __forceinline__ float bf2f(unsigned short b) { return __builtin_bit_cast(float, ((unsigned)b) << 16); }
__device__ __forceinline__ float bflo(unsigned w) { return __builtin_bit_cast(float, w << 16); }
__device__ __forceinline__ float bfhi(unsigned w) { return __builtin_bit_cast(float, w & 0xffff0000u); }
__device__ __forceinline__ float fast_sigmoid(float x) { return __builtin_amdgcn_rcpf(1.0f + __builtin_amdgcn_exp2f(-x * LOG2E)); }
__device__ __forceinline__ int opaque_tid() { int t = threadIdx.x; asm volatile("" : "+v"(t)); return t; }
typedef int v4i_t __attribute__((ext_vector_type(4)));
typedef int v8i_t __attribute__((ext_vector_type(8)));
__device__ __forceinline__ unsigned pk4_fp8(float a, float b, float c_, float d) { int w = __builtin_amdgcn_cvt_pk_fp8_f32(a, b, 0, false); w = __builtin_amdgcn_cvt_pk_fp8_f32(c_, d, w, true); return (unsigned)w; }
constexpr float W8_SCALE = 32.f;
constexpr int N_BF16_TILES = 36, N_FP8_TILES = 16;
constexpr size_t WL_WIN8 = WL_WIN + (size_t)N_BF16_TILES * 256 * 2048 * 2;
constexpr size_t WS_HB8 = WS_MG;
namespace gm {
constexpr int BM = 256, BK = 64, HALF = 128, HTB = HALF * BK * 2, STAGE_BYTES = 8 * HTB, NXCD = 8, WGM = 8;
__host__ __device__ __forceinline__ int lds_byte(int r, int c) { const int st = (r >> 4) * 2 + (c >> 5), rr = r & 15, cc = c & 31, ob = rr * 64 + cc * 2; return st * 1024 + (ob ^ (((ob >> 9) & 1) << 5)); }
__host__ __device__ __forceinline__ void stage_rc(int b, int& R, int& C) { const int st = b / 1024, sb = b % 1024, swz = sb ^ (((sb >> 9) & 1) << 5); R = (st >> 1) * 16 + swz / 64; C = (st & 1) * 32 + (swz % 64) / 2; }
__host__ __device__ __forceinline__ int perm32(int rho) { const int n = rho >> 4, i = rho & 15; return 8 * (i >> 2) + 4 * n + (i & 3); }

struct Unit {
    const char* A;
    const char* B;
    unsigned lda, ldb;
    int nt;
    int pm, pn;
    int kind;
    int e, rows;
    int keep;
};
__device__ __forceinline__ bool static_tile(int L, int nM, int nN, int& pm, int& pn) {
    const int nwg = nM * nN; if (L >= nwg) return false;
    int wgid = L; { const int q = nwg / NXCD, r = nwg % NXCD, xcd = wgid % NXCD, off = wgid / NXCD; wgid = (xcd < r ? xcd * (q + 1) : r * (q + 1) + (xcd - r) * q) + off; }
    const int nig = WGM * nN, gid = wgid / nig, fm = gid * WGM, gsz = (nM - fm) < WGM ? (nM - fm) : WGM;
    pm = fm + ((wgid % nig) % gsz); pn = (wgid % nig) / gsz; return true;
}

template <bool PERM, bool FP8, class Sched, class Epi>
__device__ __forceinline__ void gemm_phase(LAS unsigned char* lds, const Sched& S, const Epi& E) {
    const int tid = opaque_tid(), wid = __builtin_amdgcn_readfirstlane(tid >> 6), lane = tid & 63, wr = wid >> 2, wc = wid & 3, fr = lane & 15, fq = lane >> 4;
    int Rr[2], Cc[2], Rb[2];
#pragma unroll
    for (int i = 0; i < 2; ++i) { int R, C; stage_rc(tid * 16 + i * 8192, R, C); Rr[i] = R; Cc[i] = C; Rb[i] = PERM ? ((R & ~31) + perm32(R & 31)) : R; }
    const unsigned ldsw = (unsigned)wid * 1024u;
    const int aoff = lds_byte(wr * 64 + fr, fq * 8), boff = lds_byte(wc * 32 + fr, fq * 8);
#define PG8_SA(b, h) (((b) * 2 + (h)) * HTB)
#define PG8_SB(b, h) ((4 + (b) * 2 + (h)) * HTB)
#define PG8_STAGE(bufoff, gbase, voff) do { _Pragma("unroll") for (int _i = 0; _i < 2; ++_i) \
        __builtin_amdgcn_global_load_lds((const unsigned*)((const char*)(gbase) + (voff)[_i]), (LAS unsigned*)(lds + (bufoff) + ldsw + _i * 8192), 16, 0, 0); } while (0)
#define PG8_LDA(dst, b, h) do { _Pragma("unroll") for (int m = 0; m < 4; ++m) _Pragma("unroll") for (int k = 0; k < 2; ++k) dst[m][k] = *(const LAS bf16x8*)(lds + PG8_SA(b, h) + aoff + m * 2048 + k * 1024); } while (0)
#define PG8_LDB(dst, b, h) do { _Pragma("unroll") for (int n = 0; n < 2; ++n) _Pragma("unroll") for (int k = 0; k < 2; ++k) dst[n][k] = *(const LAS bf16x8*)(lds + PG8_SB(b, h) + boff + n * 2048 + k * 1024); } while (0)
#define PG8_MMA(ai, bj, At, Bt) do { __builtin_amdgcn_s_setprio(1); _Pragma("unroll") for (int m = 0; m < 4; ++m) _Pragma("unroll") for (int n = 0; n < 2; ++n) { \
        if constexpr (FP8) { const v8i_t bb_ = __builtin_shufflevector(__builtin_bit_cast(v4i_t, Bt[n][0]), __builtin_bit_cast(v4i_t, Bt[n][1]), 0, 1, 2, 3, 4, 5, 6, 7); \
            const v8i_t aa_ = __builtin_shufflevector(__builtin_bit_cast(v4i_t, At[m][0]), __builtin_bit_cast(v4i_t, At[m][1]), 0, 1, 2, 3, 4, 5, 6, 7); \
            acc[ai][bj][m][n] = __builtin_amdgcn_mfma_scale_f32_16x16x128_f8f6f4(bb_, aa_, acc[ai][bj][m][n], 0, 0, 0, 0x7f7f7f7f, 0, 0x7f7f7f7f); } \
        else { _Pragma("unroll") for (int k = 0; k < 2; ++k) acc[ai][bj][m][n] = __builtin_amdgcn_mfma_f32_16x16x32_bf16(Bt[n][k], At[m][k], acc[ai][bj][m][n], 0, 0, 0); } } \
        __builtin_amdgcn_s_setprio(0); } while (0)
#define PG8_WAIT_V(n) asm volatile("s_waitcnt vmcnt(" #n ")" ::: "memory")
#define PG8_WAIT_L(n) asm volatile("s_waitcnt lgkmcnt(" #n ")" ::: "memory")
#define PG8_BAR __builtin_amdgcn_s_barrier()
#define PG8_SCHED __builtin_amdgcn_sched_barrier(0)
#define PG8_OFFS(u, tk) do { _Pragma("unroll") for (int _i = 0; _i < 2; ++_i) { \
        vA0[_i] = (Sched::GATHER ? (unsigned)tk[_i] : (unsigned)Rr[_i]) * (u).lda + (unsigned)Cc[_i] * 2u; vA1[_i] = (Sched::GATHER ? (unsigned)tk[2 + _i] : (unsigned)(HALF + Rr[_i])) * (u).lda + (unsigned)Cc[_i] * 2u; \
        vB[_i] = (unsigned)Rb[_i] * (u).ldb + (unsigned)Cc[_i] * 2u; } } while (0)
#define PG8_TOKS(u, tk) do { if (Sched::GATHER) { tk[0] = S.tok(u, Rr[0]); tk[1] = S.tok(u, Rr[1]); tk[2] = S.tok(u, HALF + Rr[0]); tk[3] = S.tok(u, HALF + Rr[1]); } } while (0)
    Unit cur, nxt; int ui = 0;
    if (!S.next(0, cur)) return;
    f32x4 acc[2][2][4][2];
#pragma unroll
    for (int a = 0; a < 2; ++a)
#pragma unroll
        for (int b = 0; b < 2; ++b)
#pragma unroll
            for (int m = 0; m < 4; ++m)
#pragma unroll
                for (int n = 0; n < 2; ++n) acc[a][b][m][n] = (f32x4){0.f, 0.f, 0.f, 0.f};
    bf16x8 At[4][2], B0[2][2], B1[2][2];
    unsigned vA0[2], vA1[2], vB[2];
    int tk[4] = {0, 0, 0, 0};
    PG8_TOKS(cur, tk); PG8_OFFS(cur, tk);
    const char* cA = cur.A; const char* cB = cur.B; size_t hB = (size_t)HALF * cur.ldb;
    const size_t kstep = (size_t)(BK * 2);
    PG8_STAGE(PG8_SB(0, 0), cB, vB); PG8_STAGE(PG8_SB(0, 1), cB + hB, vB); PG8_STAGE(PG8_SA(0, 0), cA, vA0); PG8_STAGE(PG8_SA(0, 1), cA, vA1);
    if (wr == 1) PG8_BAR;
    PG8_WAIT_V(2); PG8_BAR;
    PG8_STAGE(PG8_SB(1, 0), cB + kstep, vB); PG8_STAGE(PG8_SA(1, 0), cA + kstep, vA0); PG8_STAGE(PG8_SB(1, 1), cB + hB + kstep, vB);
    PG8_WAIT_V(6); PG8_BAR;
    for (;;) {
        bool has_next = false;
        const char* nAp = cA; const char* nBp = cB; size_t nhB = hB;
        const int nt = cur.nt;
        for (int t = 0; t < nt; t += 2) {
            const bool last = (t == nt - 2);
            if (last) { has_next = S.next(ui + 1, nxt); if (has_next) { nAp = nxt.A; nBp = nxt.B; nhB = (size_t)HALF * nxt.ldb; } }
            const char* a1 = cA + (size_t)(t + 1) * kstep;
            const char* a2 = last ? nAp : cA + (size_t)(t + 2) * kstep; const char* b2 = last ? nBp : cB + (size_t)(t + 2) * kstep;
            const char* a3 = a2 + kstep; const char* b3 = b2 + kstep;
            const size_t h2 = last ? nhB : hB;
            PG8_LDB(B0, 0, 0); PG8_LDB(B1, 0, 1); PG8_SCHED; PG8_LDA(At, 0, 0); PG8_STAGE(PG8_SA(1, 1), a1, vA1);
            if (last && has_next) { PG8_TOKS(nxt, tk); PG8_OFFS(nxt, tk); }
            PG8_WAIT_V(8); PG8_WAIT_L(0); PG8_BAR; PG8_MMA(0, 0, At, B0); PG8_MMA(0, 1, At, B1); PG8_BAR; PG8_SCHED;
            PG8_LDA(At, 0, 1); PG8_STAGE(PG8_SB(0, 0), b2, vB); PG8_STAGE(PG8_SB(0, 1), b2 + h2, vB); PG8_STAGE(PG8_SA(0, 0), a2, vA0);
            PG8_WAIT_V(8); PG8_WAIT_L(0); PG8_BAR; PG8_MMA(1, 0, At, B0); PG8_MMA(1, 1, At, B1); PG8_BAR; PG8_SCHED;
            PG8_LDB(B0, 1, 0); PG8_LDB(B1, 1, 1); PG8_SCHED; PG8_LDA(At, 1, 0); PG8_STAGE(PG8_SA(0, 1), a2, vA1);
            PG8_WAIT_V(8); PG8_WAIT_L(0); PG8_BAR; PG8_MMA(0, 0, At, B0); PG8_MMA(0, 1, At, B1); PG8_BAR; PG8_SCHED;
            PG8_LDA(At, 1, 1); PG8_STAGE(PG8_SB(1, 0), b3, vB); PG8_STAGE(PG8_SB(1, 1), b3 + h2, vB); PG8_STAGE(PG8_SA(1, 0), a3, vA0);
            PG8_WAIT_V(8); PG8_WAIT_L(0); PG8_BAR; PG8_MMA(1, 0, At, B0); PG8_MMA(1, 1, At, B1); PG8_BAR; PG8_SCHED;
        }
        if (wr == 0) PG8_BAR;
        E(acc, cur, wr, wc, fr, fq);
        if (!has_next) break;
        if (!cur.keep) {
#pragma unroll
            for (int a = 0; a < 2; ++a)
#pragma unroll
                for (int b = 0; b < 2; ++b)
#pragma unroll
                    for (int m = 0; m < 4; ++m)
#pragma unroll
                        for (int n = 0; n < 2; ++n) acc[a][b][m][n] = (f32x4){0.f, 0.f, 0.f, 0.f};
        }
        cur = nxt; cA = nAp; cB = nBp; hB = nhB; ++ui;
        if (wr == 1) PG8_BAR;
    }
    PG8_WAIT_V(0);
    PG8_BAR;
#undef PG8_SA
#undef PG8_SB
#undef PG8_STAGE
#undef PG8_LDA
#undef PG8_LDB
#undef PG8_MMA
#undef PG8_WAIT_V
#undef PG8_WAIT_L
#undef PG8_BAR
#undef PG8_SCHED
#undef PG8_OFFS
#undef PG8_TOKS
}
}
namespace gm {
struct SchedDense {
    const char* A; const char* B; unsigned lda, ldb; int nt, nM, nN, G, c, pn0;
    __device__ __forceinline__ bool next(int i, Unit& u) const {
        int pm, pn; if (!static_tile(i * G + c, nM, nN, pm, pn)) return false;
        u.A = A + (size_t)pm * BM * lda; u.B = B + (size_t)pn * BM * ldb; u.lda = lda; u.ldb = ldb; u.nt = nt; u.pm = pm; u.pn = pn + pn0; u.kind = 0; u.e = 0; u.rows = BM; u.keep = 0; return true;
    }
    static constexpr bool GATHER = false;
    __device__ __forceinline__ int tok(const Unit&, int) const { return 0; }
};
struct SchedMerge {
    const char* Af; const char* Bf; const char* Ar; const char* Br; int nM, nN, G, c;
    __device__ __forceinline__ bool next(int i, Unit& u) const {
        int pm, pn; if (!static_tile((i >> 1) * G + c, nM, nN, pm, pn)) return false;
        if ((i & 1) == 0) { u.lda = 1024 * 2; u.ldb = 1024 * 2; u.A = Af + (size_t)pm * BM * u.lda; u.B = Bf + (size_t)pn * BM * u.ldb; u.nt = 16; u.kind = 0; u.keep = 1; }
        else { u.lda = 2048 * 2; u.ldb = 2048 * 2; u.A = Ar + (size_t)pm * BM * u.lda; u.B = Br + (size_t)pn * BM * u.ldb; u.nt = 32; u.kind = 1; u.keep = 0; }
        u.pm = pm; u.pn = pn; u.e = 0; u.rows = BM; return true;
    }
    static constexpr bool GATHER = false;
    __device__ __forceinline__ int tok(const Unit&, int) const { return 0; }
};
template <bool GATHER_> struct SchedMoe {
    static constexpr bool GATHER = GATHER_;
    const LAS int* tab;
    const char* A; const char* W;
    const int* list;
    int NCT, G, c;
    __device__ __forceinline__ bool next(int i, Unit& u) const {
        const int L = i * G + c, ntile = __builtin_amdgcn_readfirstlane(tab[96]); if (L >= ntile * NCT) return false;
        const int rt = L / NCT, ct = L % NCT; const int ln = opaque_tid() & 63;
        const int tbv = tab[64 + (ln & 31)];
        const int e = __builtin_amdgcn_readfirstlane(__popcll(__ballot(ln >= 1 && ln < 32 && tbv <= rt)));
        const int tl = rt - __builtin_amdgcn_readfirstlane(tab[64 + e]), rows = __builtin_amdgcn_readfirstlane(tab[e]) - tl * BM;
        u.e = e; u.rows = rows < BM ? rows : BM; u.pn = ct; u.kind = 0; u.keep = 0;
        if (GATHER) { u.lda = 2048 * 2; u.ldb = 2048 * 2; u.nt = 32; u.A = A; u.B = W + ((size_t)e * 1024 + (size_t)ct * BM) * u.ldb; u.pm = tl; }
        else { u.lda = 512 * 2; u.ldb = 512 * 2; u.nt = 8; u.pm = __builtin_amdgcn_readfirstlane(tab[32 + e]) / BM + tl; u.A = A + (size_t)u.pm * BM * u.lda; u.B = W + ((size_t)e * 2048 + (size_t)ct * BM) * u.ldb; }
        return true;
    }
    __device__ __forceinline__ int tok(const Unit& u, int r) const { return (r < u.rows) ? list[u.e * 16384 + u.pm * BM + r] : 0; }
};

struct EpiProj {
    bf16_t* proj; const float* cosT; const float* sinT; float accs;
    __device__ __forceinline__ void operator()(const f32x4 (&acc)[2][2][4][2], const Unit& u, int wr, int wc, int fr, int fq) const {
        const int colt = u.pn * BM; const int row0 = u.pm * BM + wr * 64 + fr, col0 = colt + wc * 32 + 8 * fq;
        int kind; float sc = 1.f;
        if (colt < C_FK) { kind = 0; sc = QSCALE; } else if (colt < C_RQ) kind = 0; else if (colt < C_RV) { kind = 1; sc = (colt >= C_RK) ? KSCALE : 1.f; } else if (colt < C_RG) kind = 0; else if (colt < C_GF) kind = 2; else kind = 3;
        const int j0 = 16 * wc + 4 * fq;
#pragma unroll
        for (int ai = 0; ai < 2; ++ai)
#pragma unroll
            for (int m = 0; m < 4; ++m) { const int row = row0 + ai * HALF + m * 16; bf16_t* rowp = proj + (size_t)row * NPROJ + col0;
                f32x4 cs = (f32x4){1.f, 1.f, 1.f, 1.f}, sn = (f32x4){0.f, 0.f, 0.f, 0.f};
                if (kind == 1) { const int pos = row & (SEQ - 1); cs = *(const f32x4*)(cosT + pos * 64 + j0); sn = *(const f32x4*)(sinT + pos * 64 + j0); }
#pragma unroll
                for (int bj = 0; bj < 2; ++bj) { f32x4 v0 = acc[ai][bj][m][0] * accs, v1 = acc[ai][bj][m][1] * accs;
                    if (kind == 1) { const f32x4 y1 = v0 * cs - v1 * sn, y2 = v0 * sn + v1 * cs; v0 = y1 * sc; v1 = y2 * sc; }
                    else if (kind == 2) {
#pragma unroll
                        for (int j = 0; j < 4; ++j) { v0[j] = v0[j] * fast_sigmoid(v0[j]); v1[j] = v1[j] * fast_sigmoid(v1[j]); } }
                    else if (kind == 3) {
#pragma unroll
                        for (int j = 0; j < 4; ++j) { v0[j] = fast_sigmoid(v0[j]); v1[j] = fast_sigmoid(v1[j]); } }
                    else { v0 = v0 * sc; v1 = v1 * sc; }
                    u32x4 w; w.x = cvt_pk_bf16(v0[0], v0[1]); w.y = cvt_pk_bf16(v0[2], v0[3]); w.z = cvt_pk_bf16(v1[0], v1[1]); w.w = cvt_pk_bf16(v1[2], v1[3]);
                    *(u32x4*)(rowp + bj * HALF) = w; } }
    }
};
struct EpiMerge {
    const bf16_t* proj; bf16_t* mg;
    __device__ __forceinline__ void operator()(f32x4 (&acc)[2][2][4][2], const Unit& u, int wr, int wc, int fr, int fq) const {
        const int row0 = u.pm * BM + wr * 64 + fr, col0 = u.pn * BM + wc * 32 + 8 * fq;
#pragma unroll
        for (int ai = 0; ai < 2; ++ai)
#pragma unroll
            for (int m = 0; m < 4; ++m) { const int row = row0 + ai * HALF + m * 16; const bf16_t* pr = proj + (size_t)row * NPROJ + col0;
#pragma unroll
                for (int bj = 0; bj < 2; ++bj) {
                    const u32x4 gr = *(const u32x4*)(pr + C_GR + bj * HALF);
                    f32x4 r0 = (f32x4){bflo(gr.x), bfhi(gr.x), bflo(gr.y), bfhi(gr.y)}, r1 = (f32x4){bflo(gr.z), bfhi(gr.z), bflo(gr.w), bfhi(gr.w)};
                    if (u.kind == 0) { const u32x4 gf = *(const u32x4*)(pr + C_GF + bj * HALF);
                        const f32x4 f0 = (f32x4){bflo(gf.x), bfhi(gf.x), bflo(gf.y), bfhi(gf.y)}, f1 = (f32x4){bflo(gf.z), bfhi(gf.z), bflo(gf.w), bfhi(gf.w)};
#pragma unroll
                        for (int j = 0; j < 4; ++j) { acc[ai][bj][m][0][j] *= f0[j] * __builtin_amdgcn_rcpf(r0[j]); acc[ai][bj][m][1][j] *= f1[j] * __builtin_amdgcn_rcpf(r1[j]); } }
                    else { const f32x4 v0 = acc[ai][bj][m][0] * r0, v1 = acc[ai][bj][m][1] * r1;
                        u32x4 w; w.x = cvt_pk_bf16(v0[0], v0[1]); w.y = cvt_pk_bf16(v0[2], v0[3]); w.z = cvt_pk_bf16(v1[0], v1[1]); w.w = cvt_pk_bf16(v1[2], v1[3]);
                        *(u32x4*)(mg + (size_t)row * DM + col0 + bj * HALF) = w; } } }
    }
};
struct EpiOut {
    const float* hf; float* z1;
    __device__ __forceinline__ void operator()(const f32x4 (&acc)[2][2][4][2], const Unit& u, int wr, int wc, int fr, int fq) const {
        const int row0 = u.pm * BM + wr * 64 + fr, col0 = u.pn * BM + wc * 32 + 4 * fq;
#pragma unroll
        for (int ai = 0; ai < 2; ++ai)
#pragma unroll
            for (int m = 0; m < 4; ++m) { const size_t off = (size_t)(row0 + ai * HALF + m * 16) * DM + col0;
#pragma unroll
                for (int bj = 0; bj < 2; ++bj)
#pragma unroll
                    for (int n = 0; n < 2; ++n) { const f32x4 hv = *(const f32x4*)(hf + off + bj * HALF + n * 16); *(f32x4*)(z1 + off + bj * HALF + n * 16) = hv * ALPHA + acc[ai][bj][m][n]; }
                asm volatile("" ::: "memory"); }
    }
};
struct EpiMoe1 {
    bf16_t* hid; const float* wlist; const LAS int* tab;
    __device__ __forceinline__ void operator()(const f32x4 (&acc)[2][2][4][2], const Unit& u, int wr, int wc, int fr, int fq) const {
        const int r0 = wr * 64 + fr, hc0 = u.pn * 128 + wc * 16 + 4 * fq; const int slot0 = __builtin_amdgcn_readfirstlane(tab[32 + u.e]) + u.pm * BM;
#pragma unroll
        for (int ai = 0; ai < 2; ++ai)
#pragma unroll
            for (int m = 0; m < 4; ++m) { const int r = r0 + ai * HALF + m * 16; if (r < u.rows) {
                const float w = wlist[u.e * 16384 + u.pm * BM + r]; bf16_t* rowp = hid + (size_t)(slot0 + r) * DEXP + hc0;
#pragma unroll
                for (int bj = 0; bj < 2; ++bj) { const f32x4 g = acc[ai][bj][m][0], up = acc[ai][bj][m][1]; f32x4 h;
#pragma unroll
                    for (int j = 0; j < 4; ++j) h[j] = g[j] * fast_sigmoid(g[j]) * up[j] * w;
                    u32x2 o; o.x = cvt_pk_bf16(h[0], h[1]); o.y = cvt_pk_bf16(h[2], h[3]); *(u32x2*)(rowp + bj * 64) = o; } } }
    }
};
struct EpiMoe2 {
    bf16_t* ffo;
    __device__ __forceinline__ void operator()(const f32x4 (&acc)[2][2][4][2], const Unit& u, int wr, int wc, int fr, int fq) const {
        const int r0 = wr * 64 + fr, col0 = u.pn * BM + wc * 32 + 8 * fq;
#pragma unroll
        for (int ai = 0; ai < 2; ++ai)
#pragma unroll
            for (int m = 0; m < 4; ++m) { const int r = r0 + ai * HALF + m * 16; if (r < u.rows) { bf16_t* rowp = ffo + (size_t)(u.pm * BM + r) * DM + col0;
#pragma unroll
                for (int bj = 0; bj < 2; ++bj) { const f32x4 v0 = acc[ai][bj][m][0], v1 = acc[ai][bj][m][1];
                    u32x4 w; w.x = cvt_pk_bf16(v0[0], v0[1]); w.y = cvt_pk_bf16(v0[2], v0[3]); w.z = cvt_pk_bf16(v1[0], v1[1]); w.w = cvt_pk_bf16(v1[2], v1[3]);
                    *(u32x4*)(rowp + bj * HALF) = w; } } }
    }
};
}
#define XB_TMO      128
#define XB_XCNT(j)  (256  + 64 * (j))
#define XB_XSUB(j)  (1280 + 64 * (j))
#define XB_XGEN(j)  (2304 + 64 * (j))
#define XB_TOP      3328
#define XB_TOPGEN   3392
#define XCD_BAR_WORDS 3456
#define XB_SPIN_CAP (1u << 18)
__device__ __forceinline__ unsigned xb_ld(unsigned* p)              { return __hip_atomic_load(p, __ATOMIC_RELAXED, __HIP_MEMORY_SCOPE_AGENT); }
__device__ __forceinline__ unsigned xb_add(unsigned* p, unsigned v) { return __hip_atomic_fetch_add(p, v, __ATOMIC_RELAXED, __HIP_MEMORY_SCOPE_AGENT); }
__device__ __forceinline__ unsigned xb_xcc_id() { return (unsigned)__builtin_amdgcn_s_getreg((3 << 11) | 20) & 0xFu; }
#define XB_SPIN(cond, bar) do { unsigned _sp = 0; while (cond) { __builtin_amdgcn_s_sleep(1); \
    if ((++_sp & 255u) == 0u) { if (xb_ld(&(bar)[XB_TMO])) break; if (_sp > XB_SPIN_CAP) { atomicAdd(&(bar)[XB_TMO], 1u); break; } } } } while (0)
struct XcdBarrier { unsigned* bar; unsigned x; volatile LAS unsigned* st; };
__device__ __forceinline__ XcdBarrier xcd_barrier_post(unsigned* bar, volatile LAS unsigned* st) {
    XcdBarrier b; b.bar = bar; b.x = xb_xcc_id(); b.st = st;
    if (threadIdx.x == 0) (void)xb_add(&bar[XB_XCNT(b.x)], 1u);
    return b;
}
__device__ __forceinline__ void xcd_barrier_complete(unsigned* bar, unsigned x, unsigned& nloc, unsigned& nx) {
    const unsigned G = gridDim.x * gridDim.y * gridDim.z;
    unsigned sum, cnt, mine, sp = 0u;
    for (;;) {
        sum = 0u; cnt = 0u; mine = 0u;
#pragma unroll
        for (unsigned j = 0; j < 16; ++j) { const unsigned c = xb_ld(&bar[XB_XCNT(j)]); sum += c; cnt += (c > 0u) ? 1u : 0u; mine = (j == x) ? c : mine; }
        if (sum == G) break;
        __builtin_amdgcn_s_sleep(1);
        if ((++sp & 255u) == 0u) { if (xb_ld(&bar[XB_TMO])) break; if (sp > XB_SPIN_CAP) { atomicAdd(&bar[XB_TMO], 1u); break; } }
    }
    nloc = mine > 0u ? mine : 1u; nx = cnt > 0u ? cnt : 1u;
}
__device__ __forceinline__ void xcd_barrier(const XcdBarrier& b) {
    asm volatile("s_waitcnt vmcnt(0)" ::: "memory");
    __syncthreads();
    if (threadIdx.x == 0) {
        unsigned* bar = b.bar;
        __builtin_amdgcn_s_waitcnt(0);
        unsigned nloc = b.st[0], nx = b.st[1];
        if (nloc == 0u) { xcd_barrier_complete(bar, b.x, nloc, nx); b.st[0] = nloc; b.st[1] = nx; }
        const unsigned old = xb_add(&bar[XB_XSUB(b.x)], 1u);
        const unsigned gen = old / nloc;
        if (old + 1u == (gen + 1u) * nloc) {
            __builtin_amdgcn_fence(__ATOMIC_RELEASE, "agent");
            asm volatile("s_waitcnt vmcnt(0)" ::: "memory");
            const unsigned og = xb_add(&bar[XB_TOP], 1u);
            const unsigned tg = og / nx;
            if (og + 1u == (tg + 1u) * nx) xb_add(&bar[XB_TOPGEN], 1u);
            else XB_SPIN(xb_ld(&bar[XB_TOPGEN]) == tg, bar);
            __builtin_amdgcn_fence(__ATOMIC_ACQUIRE, "agent");
            xb_add(&bar[XB_XGEN(b.x)], 1u);
            asm volatile("s_waitcnt vmcnt(0)" ::: "memory");
        } else {
            XB_SPIN(xb_ld(&bar[XB_XGEN(b.x)]) == gen, bar);
            __builtin_amdgcn_fence(__ATOMIC_ACQUIRE, "agent");
            asm volatile("s_waitcnt vmcnt(0)" ::: "memory");
        }
    }
    __syncthreads();
}

constexpr int NWAVES = 8;
struct Frame {
    LAS unsigned char* lds; volatile LAS unsigned* MISC; gu32* ctl;
    int tid, lane, wave, G, bx;
    unsigned char* ws;
    float* out;
};
#define INP(i) ((const float*)(const GAS float*)(((const float* const*)__builtin_amdgcn_kernarg_segment_ptr())[i]))
#define KWS() ((unsigned char*)(GAS unsigned char*)(((unsigned char* const*)__builtin_amdgcn_kernarg_segment_ptr())[20]))
__device__ __forceinline__ float wave_sum(float v) {
#pragma unroll
    for (int o = 1; o < 64; o <<= 1) v += __shfl_xor(v, o);
    return v;
}

__device__ __forceinline__ void p0_transpose_item(const float* colp, size_t pitch, bf16_t* WT, int K, int n0, int k0, LAS float* scr, int lane) {
    float tv[32];
#pragma unroll
    for (int i = 0; i < 32; ++i) { const int kk = 2 * i + (lane >> 5); tv[i] = colp[(size_t)(k0 + kk) * pitch]; }
#pragma unroll
    for (int i = 0; i < 32; ++i) { const int kk = 2 * i + (lane >> 5); scr[kk * 33 + (lane & 31)] = tv[i]; }
    LDS_WAIT(); asm volatile("" ::: "memory");
    const int c = lane & 7;
#pragma unroll
    for (int j = 0; j < 4; ++j) { const int n = (lane >> 3) + 8 * j; const LAS float* s = scr + (8 * c) * 33 + n;
        u32x4 o; o.x = pk2(s[0 * 33], s[1 * 33]); o.y = pk2(s[2 * 33], s[3 * 33]); o.z = pk2(s[4 * 33], s[5 * 33]); o.w = pk2(s[6 * 33], s[7 * 33]);
        *(GAS u32x4*)(WT + (size_t)(n0 + n) * K + k0 + 8 * c) = o; }
    LDS_WAIT(); asm volatile("" ::: "memory");
}
__device__ __forceinline__ void p0_transpose_item8(const float* colp, size_t pitch, unsigned char* WT8, int K, int n0, int k0, float scale, LAS float* scr, int lane) {
    float tv[32];
#pragma unroll
    for (int i = 0; i < 32; ++i) { const int kk = 2 * i + (lane >> 5); tv[i] = colp[(size_t)(k0 + kk) * pitch]; }
#pragma unroll
    for (int i = 0; i < 32; ++i) { const int kk = 2 * i + (lane >> 5); scr[kk * 33 + (lane & 31)] = tv[i] * scale; }
    LDS_WAIT(); asm volatile("" ::: "memory");
    const int c = lane & 7;
#pragma unroll
    for (int j = 0; j < 4; ++j) { const int n = (lane >> 3) + 8 * j; const LAS float* s = scr + (8 * c) * 33 + n;
        u32x2 o; o.x = pk4_fp8(s[0 * 33], s[1 * 33], s[2 * 33], s[3 * 33]); o.y = pk4_fp8(s[4 * 33], s[5 * 33], s[6 * 33], s[7 * 33]);
        *(GAS u32x2*)(WT8 + (size_t)(n0 + n) * K + k0 + 8 * c) = o; }
    LDS_WAIT(); asm volatile("" ::: "memory");
}
__device__ __forceinline__ int win_srccol(int n) {
    if (n < C_RQ) return n;
    if (n < C_RV) { const int hh = (n - C_RQ) >> 7, p = (n - C_RQ) & 127; return 3080 + hh * 128 + 4 * (p >> 3) + (p & 3) + 64 * ((p >> 2) & 1); }
    return n + 8;
}
constexpr int IT_WIN = 32 * 416, IT_BF = 16 * 64, IT_BR = 32 * 64, IT_OUT = 32 * 64, IT_GU = 32 * 32 * 32, IT_D = 32 * 8 * 64, IT_LAYER = IT_WIN + IT_BF + IT_BR + IT_OUT + IT_GU + IT_D;
__device__ __forceinline__ void p0_weights(Frame& F, int l) {
    LAS float* scr = (LAS float*)(F.lds + F.wave * 16384);
    const int gw = F.bx * NWAVES + F.wave, NGW = F.G * NWAVES, lane = F.lane, nl = lane & 31;
    for (int it = gw; it < IT_LAYER; it += NGW) {
        int r = it; unsigned char* wl = F.ws + WS_W;
        if (r < IT_WIN) { const int kb = r / 416, nb = r % 416; const float* src = INP(3) + (size_t)l * DM * W_IN_COLS + win_srccol(32 * nb + nl);
            if (32 * nb < N_BF16_TILES * 256) p0_transpose_item(src, W_IN_COLS, (bf16_t*)(wl + WL_WIN), 2048, 32 * nb, 64 * kb, scr, lane);
            else p0_transpose_item8(src, W_IN_COLS, wl + WL_WIN8, 2048, 32 * nb - N_BF16_TILES * 256, 64 * kb, W8_SCALE, scr, lane);
            continue; } r -= IT_WIN;
        if (r < IT_BF) { const int kb = r / 64, nb = r % 64; p0_transpose_item(INP(5) + (size_t)l * 1024 * DM + 32 * nb + nl, DM, (bf16_t*)(wl + WL_WBF), 1024, 32 * nb, 64 * kb, scr, lane); continue; } r -= IT_BF;
        if (r < IT_BR) { const int kb = r / 64, nb = r % 64; p0_transpose_item(INP(6) + (size_t)l * 2048 * DM + 32 * nb + nl, DM, (bf16_t*)(wl + WL_WBR), 2048, 32 * nb, 64 * kb, scr, lane); continue; } r -= IT_BR;
        if (r < IT_OUT) { const int kb = r / 64, nb = r % 64; p0_transpose_item(INP(7) + (size_t)l * 2048 * DM + 32 * nb + nl, DM, (bf16_t*)(wl + WL_WOUT), 2048, 32 * nb, 64 * kb, scr, lane); continue; } r -= IT_OUT;
        if (r < IT_GU) { const int e = r / 1024, q = r % 1024, kb = q / 32, nb = q % 32; const int row = 32 * nb + nl, col = 4 * (row >> 3) + (row & 3);
            const float* src = (((row >> 2) & 1) ? INP(15) : INP(14)) + (size_t)(l * NEXP + e) * DM * DEXP + col;
            p0_transpose_item(src, DEXP, (bf16_t*)(wl + WL_WGU) + (size_t)e * 1024 * 2048, 2048, 32 * nb, 64 * kb, scr, lane); continue; } r -= IT_GU;
        { const int e = r / 512, q = r % 512, kb = q / 64, nb = q % 64;
            p0_transpose_item(INP(16) + (size_t)(l * NEXP + e) * DEXP * DM + 32 * nb + nl, DM, (bf16_t*)(wl + WL_WD) + (size_t)e * 2048 * 512, 512, 32 * nb, 64 * kb, scr, lane); }
    }
}
__device__ __forceinline__ void p0_tables(Frame& F) {
    const int gw = F.bx * NWAVES + F.wave, NGW = F.G * NWAVES, lane = F.lane;
    { float* cosT = (float*)(F.ws + WS_ROPE); float* sinT = cosT + SEQ * 64;
      for (int i = (F.bx * NWAVES + F.wave) * 64 + lane; i < SEQ * 64; i += NGW * 64) { const int pos = i >> 6, j = i & 63;
          double pw = 1.0; for (int t = 0; t < j; ++t) pw *= 0.8659643233600653;
          const float inv = (float)pw; const double ang = (double)((float)pos * inv);
          const double qd = __builtin_rint(ang * 0.6366197723675814); const double r = ang - qd * 1.5707963267948966, r2 = r * r; const int qi = (int)qd & 3;
          const double sr = r * (1.0 + r2 * (-1.0 / 6 + r2 * (1.0 / 120 + r2 * (-1.0 / 5040 + r2 * (1.0 / 362880 + r2 * (-1.0 / 39916800))))));
          const double cr = 1.0 + r2 * (-0.5 + r2 * (1.0 / 24 + r2 * (-1.0 / 720 + r2 * (1.0 / 40320 + r2 * (-1.0 / 3628800 + r2 * (1.0 / 479001600))))));
          const double sv = (qi == 0) ? sr : (qi == 1) ? cr : (qi == 2) ? -sr : -cr, cv = (qi == 0) ? cr : (qi == 1) ? -sr : (qi == 2) ? -cr : sr;
          cosT[i] = (float)cv; sinT[i] = (float)sv; } }
    for (int job = gw; job < 2 * 16 + 2 * 48; job += NGW) {
        int t, c; if (job < 32) { t = job >> 4; c = job & 15; } else { t = 2 + (job - 32) / 48; c = (job - 32) % 48; }
        const int l = t & 1; const float *g, *b; const float* W = nullptr; size_t pitch = 0;
        if (t < 2) { g = l ? INP(17) : INP(1); b = l ? INP(18) : INP(2); if (c < 8) { W = INP(3) + (size_t)l * DM * W_IN_COLS + 3072 + c; pitch = W_IN_COLS; } }
        else { g = INP(8) + l * DM; b = INP(9) + l * DM; if (c < 4) { W = INP(10) + (size_t)l * DM * 4 + c; pitch = 4; } else if (c < 36) { W = INP(12) + (size_t)l * DM * 32 + (c - 4); pitch = 32; } }
        bf16_t* hi = (bf16_t*)(F.ws + WS_SKW + (t < 2 ? (size_t)t * SKW_FGT_BYTES : 2 * SKW_FGT_BYTES + (size_t)(t - 2) * SKW_RTR_BYTES)); const int ncol = t < 2 ? 16 : 48; bf16_t* lo = hi + ncol * 2048;
        float s1 = 0.f, s2 = 0.f;
        for (int k = lane; k < DM; k += 64) { const float w = W ? W[(size_t)k * pitch] : 0.f; const float gw_ = g[k] * w; const unsigned h16 = f2bf(gw_); const float hf_ = __builtin_bit_cast(float, h16 << 16); const unsigned l16 = f2bf(gw_ - hf_);
            hi[c * 2048 + k] = (bf16_t)h16; lo[c * 2048 + k] = (bf16_t)l16; s1 += hf_ + __builtin_bit_cast(float, l16 << 16); s2 += b[k] * w; }
        s1 = wave_sum(s1); s2 = wave_sum(s2);
        if (lane == 0) { float* S = (float*)(F.ws + WS_SKS + (size_t)t * 512); S[c] = s1; S[64 + c] = s2; }
    }
}
struct LnArgs {
    const float* zin;
    float* hf; bf16_t* hb;
    unsigned char* h8;
    const float* g; const float* b;
    const bf16_t* whi; const bf16_t* wlo; const float* S12;
    const bf16_t* ffo; const int* route;
    const LAS int* tab;
    const float* bfor; float* logf;
    const float* brg; const float* bre; int* route_out; int* list; float* wlist; unsigned* cnt;
};
template <int MODE, int NCG, bool PROJ>
__device__ __forceinline__ void ln_pass(Frame& F, const LnArgs& a) {
    const int lane = F.lane, w = F.wave, r = lane & 15, q = lane >> 4, tid = F.tid;
    LAS float* red = (LAS float*)(F.lds + LNS_OFF);
    LAS float* part = (LAS float*)(F.lds + LNS_OFF + 1024);
    LAS float* lg = (LAS float*)(F.lds + LNS_OFF + 1024 + 24576);
    LAS unsigned char* stash = F.lds + w * 16384;
#define LN_ISSUE(g_) do { const int row_ = (g_) * 16 + r; const int kb_ = 256 * w + 8 * q; \
        if (MODE == 2) { const int4 rt = *(const int4*)(a.route + row_ * 4); \
            const size_t sa = (size_t)(a.tab[32 + rt.x] + rt.y), sb = (size_t)(a.tab[32 + rt.z] + rt.w); \
            const bf16_t* pa = a.ffo + sa * DM + kb_; const bf16_t* pb = a.ffo + sb * DM + kb_; \
            _Pragma("unroll") for (int s = 0; s < 8; ++s) { __builtin_amdgcn_global_load_lds((const unsigned*)(pa + 32 * s), (LAS unsigned*)(stash + (2 * s) * 1024), 16, 0, 0); \
                __builtin_amdgcn_global_load_lds((const unsigned*)(pb + 32 * s), (LAS unsigned*)(stash + (2 * s + 1) * 1024), 16, 0, 0); } } \
        else { const float* zp_ = a.zin + (size_t)row_ * DM + kb_; \
            _Pragma("unroll") for (int s = 0; s < 8; ++s) { __builtin_amdgcn_global_load_lds((const unsigned*)(zp_ + 32 * s), (LAS unsigned*)(stash + (2 * s) * 1024), 16, 0, 0); \
                __builtin_amdgcn_global_load_lds((const unsigned*)(zp_ + 32 * s + 4), (LAS unsigned*)(stash + (2 * s + 1) * 1024), 16, 0, 0); } } } while (0)
    const int kb = 256 * w + 8 * q;
    unsigned gq[8][2][4];
#define LN_GLOAD() do { _Pragma("unroll") for (int s = 0; s < 8; ++s) _Pragma("unroll") for (int hh = 0; hh < 2; ++hh) { \
            const f32x4 gv = *(const f32x4*)(a.g + kb + 32 * s + 4 * hh), bv = *(const f32x4*)(a.b + kb + 32 * s + 4 * hh); \
            gq[s][hh][0] = __builtin_bit_cast(unsigned, __builtin_amdgcn_cvt_pkrtz(gv[0] - 1.f, gv[1] - 1.f)); gq[s][hh][1] = __builtin_bit_cast(unsigned, __builtin_amdgcn_cvt_pkrtz(gv[2] - 1.f, gv[3] - 1.f)); \
            gq[s][hh][2] = __builtin_bit_cast(unsigned, __builtin_amdgcn_cvt_pkrtz(bv[0], bv[1])); gq[s][hh][3] = __builtin_bit_cast(unsigned, __builtin_amdgcn_cvt_pkrtz(bv[2], bv[3])); } } while (0)
    constexpr bool GRES = (MODE != 1);
    if (GRES) LN_GLOAD();
    typedef _Float16 h16x2 __attribute__((ext_vector_type(2)));
#define LN_UNPK(dst, s_, hh_, i_) do { unsigned u0_ = gq[s_][hh_][i_], u1_ = gq[s_][hh_][(i_) + 1]; asm volatile("" : "+v"(u0_), "+v"(u1_)); const h16x2 h0_ = __builtin_bit_cast(h16x2, u0_), h1_ = __builtin_bit_cast(h16x2, u1_); \
        dst = (f32x4){(float)h0_[0], (float)h0_[1], (float)h1_[0], (float)h1_[1]}; } while (0)
    LAS float* tb = (LAS float*)(F.lds + LNS_OFF + 1024 + 24576 + 3072);
    float s1a = 0.f, s2a = 0.f, s1b = 0.f, s2b = 0.f;
    if (PROJ) {
        if (MODE != 1) { if (tid < 8) tb[tid] = a.bfor[tid]; } else { if (tid < 4) tb[16 + tid] = a.brg[tid]; if (tid >= 32 && tid < 64) tb[tid] = a.bre[tid - 32]; }
        if (tid < 16 * 16 * NCG) { const int cc = tid % (16 * NCG); s1a = a.S12[cc]; s2a = a.S12[64 + cc]; }
        if (tid + NWAVES * 64 < 16 * 16 * NCG) { const int cc = (tid + NWAVES * 64) % (16 * NCG); s1b = a.S12[cc]; s2b = a.S12[64 + cc]; }
    }
    asm volatile("s_waitcnt vmcnt(0)" ::: "memory");
    if (F.bx < NTOK / 16) LN_ISSUE(F.bx);
    for (int gi = F.bx; gi < NTOK / 16; gi += F.G) {
        const int row = gi * 16 + r;
        f32x4 z[8][2];
        if (MODE == 2) {
            f32x4 rh[8][2];
            { const float* zp_ = a.zin + (size_t)row * DM + kb;
#pragma unroll
              for (int s = 0; s < 8; ++s) { rh[s][0] = *(const f32x4*)(zp_ + 32 * s); rh[s][1] = *(const f32x4*)(zp_ + 32 * s + 4); } }
            asm volatile("s_waitcnt vmcnt(0)" ::: "memory");
#pragma unroll
            for (int s = 0; s < 8; ++s) { const u32x4 ua = *(const LAS u32x4*)(stash + (2 * s) * 1024 + lane * 16), ub = *(const LAS u32x4*)(stash + (2 * s + 1) * 1024 + lane * 16);
                z[s][0] = rh[s][0] * ALPHA + ((f32x4){bflo(ua.x), bfhi(ua.x), bflo(ua.y), bfhi(ua.y)} + (f32x4){bflo(ub.x), bfhi(ub.x), bflo(ub.y), bfhi(ub.y)});
                z[s][1] = rh[s][1] * ALPHA + ((f32x4){bflo(ua.z), bfhi(ua.z), bflo(ua.w), bfhi(ua.w)} + (f32x4){bflo(ub.z), bfhi(ub.z), bflo(ub.w), bfhi(ub.w)}); }
        } else {
            asm volatile("s_waitcnt vmcnt(0)" ::: "memory");
#pragma unroll
            for (int s = 0; s < 8; ++s) { z[s][0] = *(const LAS f32x4*)(stash + (2 * s) * 1024 + lane * 16); z[s][1] = *(const LAS f32x4*)(stash + (2 * s + 1) * 1024 + lane * 16); }
        }
        LDS_WAIT();
        float sm = 0.f, sq = 0.f;
#pragma unroll
        for (int s = 0; s < 8; ++s)
#pragma unroll
            for (int hh = 0; hh < 2; ++hh)
#pragma unroll
                for (int j = 0; j < 4; ++j) { const float v = z[s][hh][j]; sm += v; sq += v * v; }
        sm += __shfl_xor(sm, 16); sm += __shfl_xor(sm, 32); sq += __shfl_xor(sq, 16); sq += __shfl_xor(sq, 32);
        if (q == 0) { red[(w * 16 + r) * 2] = sm; red[(w * 16 + r) * 2 + 1] = sq; }
        if (PROJ) {
            f32x4 acc[NCG];
#pragma unroll
            for (int cg = 0; cg < NCG; ++cg) acc[cg] = (f32x4){0.f, 0.f, 0.f, 0.f};
            bf16x8 bh[2], bl[2];
            unsigned wof[NCG];
#pragma unroll
            for (int cg = 0; cg < NCG; ++cg) { wof[cg] = (unsigned)((16 * cg + r) * DM + kb) * 2u; asm volatile("" : "+v"(wof[cg])); }
#define LN_WLOAD(i_, bf_) do { const int cg_ = (i_) % NCG, s_ = (i_) / NCG; bh[bf_] = *(const bf16x8*)((const char*)a.whi + wof[cg_] + 64 * s_); bl[bf_] = *(const bf16x8*)((const char*)a.wlo + wof[cg_] + 64 * s_); } while (0)
            LN_WLOAD(0, 0);
#pragma unroll
            for (int i = 0; i < 8 * NCG; ++i) { const int cg = i % NCG, s = i / NCG;
                asm volatile("" ::: "memory");
                if (i + 1 < 8 * NCG) LN_WLOAD(i + 1, (i + 1) & 1);
                asm volatile("" ::: "memory");
                u32x4 hi, lo;
                { const f32x4 v0 = z[s][0], v1 = z[s][1];
                  hi.x = cvt_pk_bf16(v0[0], v0[1]); hi.y = cvt_pk_bf16(v0[2], v0[3]); hi.z = cvt_pk_bf16(v1[0], v1[1]); hi.w = cvt_pk_bf16(v1[2], v1[3]);
                  lo.x = cvt_pk_bf16(v0[0] - bflo(hi.x), v0[1] - bfhi(hi.x)); lo.y = cvt_pk_bf16(v0[2] - bflo(hi.y), v0[3] - bfhi(hi.y));
                  lo.z = cvt_pk_bf16(v1[0] - bflo(hi.z), v1[1] - bfhi(hi.z)); lo.w = cvt_pk_bf16(v1[2] - bflo(hi.w), v1[3] - bfhi(hi.w)); }
                const bf16x8 ahi = __builtin_bit_cast(bf16x8, hi), alo = __builtin_bit_cast(bf16x8, lo);
                const bf16x8 wh = bh[i & 1], wl_ = bl[i & 1];
                acc[cg] = __builtin_amdgcn_mfma_f32_16x16x32_bf16(ahi, wh, acc[cg], 0, 0, 0);
                acc[cg] = __builtin_amdgcn_mfma_f32_16x16x32_bf16(alo, wh, acc[cg], 0, 0, 0);
                acc[cg] = __builtin_amdgcn_mfma_f32_16x16x32_bf16(ahi, wl_, acc[cg], 0, 0, 0);
            }
#undef LN_WLOAD
#pragma unroll
            for (int cg = 0; cg < NCG; ++cg)
#pragma unroll
                for (int j = 0; j < 4; ++j) part[(w * 16 + 4 * q + j) * 48 + 16 * cg + r] = acc[cg][j];
        }
        asm volatile("" ::: "memory");
        if (!GRES) { LN_GLOAD(); asm volatile("" ::: "memory"); }
        if (gi + F.G < NTOK / 16) LN_ISSUE(gi + F.G);
        asm volatile("" ::: "memory");
        LDS_WAIT(); __syncthreads();
        float mean, rstd;
        { float ts = 0.f, tq = 0.f;
#pragma unroll
          for (int ww = 0; ww < 8; ++ww) { ts += red[(ww * 16 + r) * 2]; tq += red[(ww * 16 + r) * 2 + 1]; }
          mean = ts * (1.0f / DM); const float var = tq * (1.0f / DM) - mean * mean; rstd = 1.0f / sqrtf(fmaxf(var, 0.f) + LN_EPS); }
        { float* op = a.hf + (size_t)row * DM + kb; bf16_t* ob = a.hb ? a.hb + (size_t)row * DM + kb : nullptr;
#pragma unroll
          for (int s = 0; s < 8; ++s) {
              f32x4 dg0, dg1, bb0, bb1; LN_UNPK(dg0, s, 0, 0); LN_UNPK(dg1, s, 1, 0); LN_UNPK(bb0, s, 0, 2); LN_UNPK(bb1, s, 1, 2);
              const f32x4 n0 = (z[s][0] - mean) * rstd, n1 = (z[s][1] - mean) * rstd; const f32x4 y0 = n0 + n0 * dg0 + bb0, y1 = n1 + n1 * dg1 + bb1;
              *(f32x4*)(op + 32 * s) = y0; *(f32x4*)(op + 32 * s + 4) = y1;
              if (ob) { u32x4 o; o.x = cvt_pk_bf16(y0[0], y0[1]); o.y = cvt_pk_bf16(y0[2], y0[3]); o.z = cvt_pk_bf16(y1[0], y1[1]); o.w = cvt_pk_bf16(y1[2], y1[3]); *(u32x4*)(ob + 32 * s) = o; }
              if (a.h8) { u32x2 o8; o8.x = pk4_fp8(y0[0], y0[1], y0[2], y0[3]); o8.y = pk4_fp8(y1[0], y1[1], y1[2], y1[3]); *(u32x2*)(a.h8 + (size_t)row * DM + kb + 32 * s) = o8; } } }
        if (PROJ) {
#define LN_LOGIT(t_, s1_, s2_) do { const int t = (t_); if (t < 16 * 16 * NCG) { const int rr = t / (16 * NCG), cc = t % (16 * NCG); float ts = 0.f, tq = 0.f, ps = 0.f; \
                _Pragma("unroll") for (int ww = 0; ww < 8; ++ww) { ts += red[(ww * 16 + rr) * 2]; tq += red[(ww * 16 + rr) * 2 + 1]; ps += part[(ww * 16 + rr) * 48 + cc]; } \
                const float mr = ts * (1.0f / DM), vr = tq * (1.0f / DM) - mr * mr, rs = 1.0f / sqrtf(fmaxf(vr, 0.f) + LN_EPS); \
                lg[rr * 48 + cc] = rs * (ps - mr * (s1_)) + (s2_); } } while (0)
            LN_LOGIT(tid, s1a, s2a); if (16 * 16 * NCG > NWAVES * 64) LN_LOGIT(tid + NWAVES * 64, s1b, s2b);
#undef LN_LOGIT
            LDS_WAIT(); __syncthreads();
            if (tid < 16) {
                const int tok = gi * 16 + tid; const LAS float* L = lg + tid * 48;
                if (MODE != 1) {
                    const int bb = tok / SEQ, ss = tok % SEQ;
#pragma unroll
                    for (int hh = 0; hh < 8; ++hh) { const float xv = L[hh] + tb[hh]; const float lsg = fminf(xv, 0.f) - log1pf(expf(-fabsf(xv))); a.logf[((size_t)bb * 8 + hh) * SEQ + ss] = lsg; }
                } else {
                    float gl[4]; float gmax = -3.0e38f; int gi_ = 0;
#pragma unroll
                    for (int j = 0; j < 4; ++j) { gl[j] = L[j] + tb[16 + j]; if (gl[j] > gmax) { gmax = gl[j]; gi_ = j; } }
                    float den = 0.f;
#pragma unroll
                    for (int j = 0; j < 4; ++j) den += expf(gl[j] - gmax);
                    const float grp_w = 1.0f / den;
                    float e1 = -3.0e38f, e2 = -3.0e38f; int i1 = 0, i2 = 0;
#pragma unroll
                    for (int j = 0; j < 8; ++j) { const float v = L[4 + 8 * gi_ + j] + tb[32 + 8 * gi_ + j];
                        if (v > e1) { e2 = e1; i2 = i1; e1 = v; i1 = j; } else if (v > e2) { e2 = v; i2 = j; } }
                    const float t2 = expf(e2 - e1), w1 = grp_w / (1.0f + t2), w2 = grp_w * t2 / (1.0f + t2);
                    const int x1 = 8 * gi_ + i1, x2 = 8 * gi_ + i2;
                    const int p1 = (int)__hip_atomic_fetch_add(a.cnt + 64 * x1, 1u, RLX_AGENT), p2 = (int)__hip_atomic_fetch_add(a.cnt + 64 * x2, 1u, RLX_AGENT);
                    a.list[x1 * 16384 + p1] = tok; a.wlist[x1 * 16384 + p1] = w1; a.list[x2 * 16384 + p2] = tok; a.wlist[x2 * 16384 + p2] = w2;
                    *(int4*)(a.route_out + tok * 4) = make_int4(x1, p1, x2, p2);
                }
            }
        }
        __syncthreads();
    }
#undef LN_ISSUE
#undef LN_UNPK
#undef LN_GLOAD
}
namespace fox {
constexpr int D = 128, NW = 8, QBLK = 32, KVBLK = 64, QB = NW * QBLK;
constexpr int SHM_V = KVBLK * D * 2, SHM_K = KVBLK * D * 2;
constexpr int OFF_WS = 2 * SHM_V + 2 * SHM_K, OFF_BIAS = OFF_WS + NW * 64 * 4, LDS_BYTES = OFF_BIAS + SEQ * 4;
constexpr float THR = 8.f, LN2 = 0.6931471805599453f;
#define KSWZ(row, colB) ((row) * 256 + ((colB) ^ (((row) & 7) << 4)))
__device__ __forceinline__ int v_st(int k, int c) { const int kk = (k & ~0xC) | ((k & 4) << 1) | ((k & 8) >> 1); return ((kk >> 3) * 4 + (c >> 5)) * 512 + ((kk & 7) * 32 + (c & 31)) * 2; }
__device__ __forceinline__ int v_rd_base(int lane) { return ((lane & 3) << 3) | (((lane >> 2) & 3) << 6) | (((lane >> 4) & 1) << 5) | (((lane >> 5) & 1) << 8); }
constexpr int v_rd_off(int d0, int ks, int half) { return d0 * 512 + ks * 4096 + half * 2048; }
__device__ __forceinline__ int crow(int r, int hi) { return (r & 3) + 8 * (r >> 2) + 4 * hi; }
__device__ __forceinline__ void mask_tile(f32x16& p0, f32x16& p1, int dq) {
    const float NEG = -__builtin_inff();
#pragma unroll
    for (int r = 0; r < 16; ++r) { const int c = (r & 3) + 8 * (r >> 2); if (dq - c < 0) p0[r] = NEG; if (dq - c - 32 < 0) p1[r] = NEG; }
}
__device__ __forceinline__ void partialSM(f32x16& p0, f32x16& p1, float& m_reg, float& mn, float& alpha) {
    float pmax = p0[0];
#pragma unroll
    for (int r = 1; r < 16; ++r) pmax = fmaxf(pmax, p0[r]);
#pragma unroll
    for (int r = 0; r < 16; ++r) pmax = fmaxf(pmax, p1[r]);
    { auto rr = __builtin_amdgcn_permlane32_swap(__float_as_uint(pmax), __float_as_uint(pmax), false, false); pmax = fmaxf(__uint_as_float(rr[0]), __uint_as_float(rr[1])); }
    if (__builtin_expect(__all((pmax - m_reg) * LN2 <= THR), 1)) { mn = m_reg; alpha = 1.f; }
    else { mn = fmaxf(m_reg, pmax); alpha = __builtin_amdgcn_exp2f(m_reg - mn); m_reg = mn; }
#pragma unroll
    for (int r = 0; r < 16; ++r) p0[r] = p0[r] - mn;
#pragma unroll
    for (int r = 0; r < 16; ++r) p1[r] = p1[r] - mn;
#pragma unroll
    for (int r = 0; r < 16; ++r) p0[r] = __builtin_amdgcn_exp2f(p0[r]);
}
__device__ __forceinline__ void finishSM(f32x16& p0, f32x16& p1, float alpha, float& l_reg, bf16x8& pa0, bf16x8& pa1, bf16x8& pa2, bf16x8& pa3) {
#pragma unroll
    for (int r = 0; r < 16; ++r) p1[r] = __builtin_amdgcn_exp2f(p1[r]);
    float ps = 0;
#pragma unroll
    for (int r = 0; r < 16; ++r) ps += p0[r];
#pragma unroll
    for (int r = 0; r < 16; ++r) ps += p1[r];
    { auto rr = __builtin_amdgcn_permlane32_swap(__float_as_uint(ps), __float_as_uint(ps), false, false); ps = __uint_as_float(rr[0]) + __uint_as_float(rr[1]); }
    l_reg = l_reg * alpha + ps;
#define PK4(P, B_, OUT) do { unsigned a0 = cvt_pk_bf16(P[B_+0], P[B_+1]), a1 = cvt_pk_bf16(P[B_+2], P[B_+3]);                          \
        unsigned b0 = cvt_pk_bf16(P[B_+4], P[B_+5]), b1 = cvt_pk_bf16(P[B_+6], P[B_+7]);                                             \
        auto r0 = __builtin_amdgcn_permlane32_swap(a0, b0, false, false); auto r1 = __builtin_amdgcn_permlane32_swap(a1, b1, false, false); \
        u32x4 w = {r0[0], r1[0], r0[1], r1[1]}; OUT = __builtin_bit_cast(bf16x8, w); } while (0)
    PK4(p0, 0, pa0); PK4(p0, 8, pa1); PK4(p1, 0, pa2); PK4(p1, 8, pa3);
#undef PK4
}
template <int KB>
__device__ __forceinline__ void qkt(f32x16& p0, f32x16& p1, const LAS char* K_lds, int r32, int hi, const bf16x8* qr, const LAS float* bl) {
#pragma unroll
    for (int g = 0; g < 4; ++g) { const f32x4 b0 = *(const LAS f32x4*)(bl + 8 * g), b1 = *(const LAS f32x4*)(bl + 32 + 8 * g);
        p0[4 * g] = b0[0]; p0[4 * g + 1] = b0[1]; p0[4 * g + 2] = b0[2]; p0[4 * g + 3] = b0[3]; p1[4 * g] = b1[0]; p1[4 * g + 1] = b1[1]; p1[4 * g + 2] = b1[2]; p1[4 * g + 3] = b1[3]; }
    const LAS char* kb[4];
#pragma unroll
    for (int dd = 0; dd < 4; ++dd) kb[dd] = K_lds + KB * SHM_K + KSWZ(r32, (dd * 16 + hi * 8) * 2);
#pragma unroll
    for (int d0 = 0; d0 < 8; ++d0) { const LAS char* a = kb[d0 & 3] + (d0 >> 2) * 128;
        bf16x8 b0 = *(const LAS bf16x8*)(a);
        bf16x8 b1 = *(const LAS bf16x8*)(a + 32 * 256);
        p0 = __builtin_amdgcn_mfma_f32_32x32x16_bf16(b0, qr[d0], p0, 0, 0, 0);
        p1 = __builtin_amdgcn_mfma_f32_32x32x16_bf16(b1, qr[d0], p1, 0, 0, 0); }
}
template <int VB>
__device__ __forceinline__ void pv_tile(f32x16* o, int vb0, bf16x8 pa0, bf16x8 pa1, bf16x8 pa2, bf16x8 pa3) {
#define TRRD(dst, off) asm volatile("ds_read_b64_tr_b16 %0, %1 offset:%2" : "=&v"(dst) : "v"(vb0), "i"(off) : "memory")
#define PV_D0(d0) do { s16x4 l0, l1, l2, l3, h0, h1, h2, h3; constexpr int b_ = VB * SHM_V + v_rd_off(d0, 0, 0); \
        TRRD(l0, b_); TRRD(h0, b_ + 2048); TRRD(l1, b_ + 4096); TRRD(h1, b_ + 6144); TRRD(l2, b_ + 8192); TRRD(h2, b_ + 10240); TRRD(l3, b_ + 12288); TRRD(h3, b_ + 14336); \
        asm volatile("s_waitcnt lgkmcnt(0)" ::: "memory"); SBAR();   \
        o[d0] = __builtin_amdgcn_mfma_f32_32x32x16_bf16(pa0, (bf16x8){l0[0], l0[1], l0[2], l0[3], h0[0], h0[1], h0[2], h0[3]}, o[d0], 0, 0, 0);   \
        o[d0] = __builtin_amdgcn_mfma_f32_32x32x16_bf16(pa1, (bf16x8){l1[0], l1[1], l1[2], l1[3], h1[0], h1[1], h1[2], h1[3]}, o[d0], 0, 0, 0);   \
        o[d0] = __builtin_amdgcn_mfma_f32_32x32x16_bf16(pa2, (bf16x8){l2[0], l2[1], l2[2], l2[3], h2[0], h2[1], h2[2], h2[3]}, o[d0], 0, 0, 0);   \
        o[d0] = __builtin_amdgcn_mfma_f32_32x32x16_bf16(pa3, (bf16x8){l3[0], l3[1], l3[2], l3[3], h3[0], h3[1], h3[2], h3[3]}, o[d0], 0, 0, 0); } while (0)
    PV_D0(0); PV_D0(1); PV_D0(2); PV_D0(3);
#undef PV_D0
#undef TRRD
}
struct BlockRef { const bf16_t* Q; const bf16_t* K; const bf16_t* V; bf16_t* O; int P0; };
struct Seam { bf16x8 qr[8]; bf16x8 st_v0, st_v1, st_k0, st_k1; };
#define VMW() asm volatile("s_waitcnt vmcnt(0)" ::: "memory")
#define VMWN(n) asm volatile("s_waitcnt vmcnt(%0)" :: "i"(n) : "memory")
#define SLOAD_H(Kp, Vp, k0) do { const char* vb_ = (const char*)(Vp) + (size_t)(k0) * (ld * 2); const char* kb_ = (const char*)(Kp) + (size_t)(k0) * (ld * 2); \
        S.st_v0 = *(const bf16x8*)(vb_ + soff); S.st_v1 = *(const bf16x8*)(vb_ + 32 * ld * 2 + soff); S.st_k0 = *(const bf16x8*)(kb_ + soff); S.st_k1 = *(const bf16x8*)(kb_ + 32 * ld * 2 + soff); } while (0)
#define SWRITE_HK(bf) do { *(LAS bf16x8*)(K_lds + (bf) * SHM_K + kws) = S.st_k0; *(LAS bf16x8*)(K_lds + (bf) * SHM_K + kws + 32 * 256) = S.st_k1; } while (0)
#define SWRITE_HV(bf) do { *(LAS bf16x8*)(V_lds + (bf) * SHM_V + vst0) = S.st_v0; *(LAS bf16x8*)(V_lds + (bf) * SHM_V + vst1) = S.st_v1; } while (0)
#define SWRITE_H(bf) do { SWRITE_HV(bf); SWRITE_HK(bf); } while (0)
template <int ld> __device__ __forceinline__ void prime(const BlockRef& cur, LAS char* lds, Seam& S) {
    const int tid = opaque_tid(), wid = __builtin_amdgcn_readfirstlane(tid >> 6), lane = tid & 63, r32 = lane & 31, hi = lane >> 5;
    const int sr = tid >> 4, sc = (tid & 15) * 8, kws = KSWZ(sr, sc * 2); LAS char* K_lds = lds + 2 * SHM_V;
    const unsigned soff = (unsigned)(sr * ld + sc) * 2u, qoff = (unsigned)((wid * QBLK + r32) * ld + hi * 8) * 2u;
#pragma unroll
    for (int d0 = 0; d0 < 8; ++d0) S.qr[d0] = *(const bf16x8*)((const char*)cur.Q + qoff + d0 * 32);
    SLOAD_H(cur.K, cur.V, 0); VMW(); SWRITE_HK(0);
    __syncthreads();
}
template <int ld, int ldo> __device__ __forceinline__ void block(const BlockRef& cur, const BlockRef& nxt, LAS char* lds, Seam& S) {
    const int tid = opaque_tid(), wid = __builtin_amdgcn_readfirstlane(tid >> 6), lane = tid & 63, r32 = lane & 31, hi = lane >> 5;
    const int NT = (cur.P0 + QB - 1) / KVBLK + 1;
    const int qlo = cur.P0 + wid * QBLK, qm = qlo + r32 - 4 * hi;
    LAS char* V_lds = lds; LAS char* K_lds = lds + 2 * SHM_V;
    LAS float* ws = (LAS float*)(lds + OFF_WS) + wid * 64; LAS float* li_l = ws; LAS float* al_l = ws + 32;
    const LAS float* bias = (const LAS float*)(lds + OFF_BIAS) + 4 * hi;
    float m_reg = -1e30f, l_reg = 0; f32x16 o[4] = {};
    const int sr = tid >> 4, sc = (tid & 15) * 8, vst0 = v_st(sr, sc), vst1 = v_st(32 + sr, sc), kws = KSWZ(sr, sc * 2);
    const unsigned soff = (unsigned)(sr * ld + sc) * 2u;
    const int vb0 = (int)(uintptr_t)V_lds + v_rd_base(lane);
    const bf16_t* Kh = cur.K; const bf16_t* Vh = cur.V;
#define RESC(a) do { if (__any((a) < 1.f)) { if (hi == 0) al_l[r32] = (a); asm volatile("s_waitcnt lgkmcnt(0)" ::: "memory");              \
                     for (int d_ = 0; d_ < 4; ++d_) for (int r = 0; r < 16; ++r) o[d_][r] *= al_l[crow(r, hi)]; } } while (0)
#define KBASE(t) ((t) * KVBLK)
#define MASKT(P0_, P1_, t) do { const int kb_ = KBASE(t); if (kb_ + KVBLK - 1 > qlo) mask_tile(P0_, P1_, qm - kb_); } while (0)
    constexpr int NQL = 8;
#define SEAM_K0() do { VMWN(NQL); SWRITE_HK(0); SBAR(); } while (0)
    f32x16 pA0, pA1, pB0, pB1; float mnA, mnB, alA, alB; bf16x8 pa0, pa1, pa2, pa3;
    SWRITE_HV(0); SBAR();
    if (NT > 1) { SLOAD_H(Kh, Vh, KBASE(1)); }
    SBAR(); qkt<0>(pA0, pA1, K_lds, r32, hi, S.qr, bias + KBASE(0));
    MASKT(pA0, pA1, 0); partialSM(pA0, pA1, m_reg, mnA, alA);
    if (NT > 1) { VMW(); SWRITE_H(1); }
    __syncthreads();
#define HALF_STEP(PX0, PX1, mnX, alX, PY0, PY1, alY, t, KB, VB, SB) do {                                                      \
        SBAR(); qkt<KB>(PX0, PX1, K_lds, r32, hi, S.qr, bias + KBASE(t));                                             \
        finishSM(PY0, PY1, alY, l_reg, pa0, pa1, pa2, pa3); SBAR();                                                           \
        if ((t) + 1 < NT) { SLOAD_H(Kh, Vh, KBASE((t) + 1)); SBAR(); }                                               \
        pv_tile<VB>(o, vb0, pa0, pa1, pa2, pa3); MASKT(PX0, PX1, (t)); partialSM(PX0, PX1, m_reg, mnX, alX);                                        \
        __syncthreads();                                                                                                      \
        if ((t) + 1 < NT) { VMW(); SWRITE_H(SB); }                                                                          \
        RESC(alX); __syncthreads(); } while (0)
    for (int t = 1; t + 1 < NT; t += 2) {
        HALF_STEP(pB0, pB1, mnB, alB, pA0, pA1, alA, t, 1, 0, 0);
        HALF_STEP(pA0, pA1, mnA, alA, pB0, pB1, alB, t + 1, 0, 1, 1);
    }
    const bool even = (NT & 1) == 0;
    if (even) { SBAR(); qkt<1>(pB0, pB1, K_lds, r32, hi, S.qr, bias + KBASE(NT - 1)); SBAR(); }
    int tid2 = tid; asm volatile("" : "+v"(tid2));
    const int r32b = tid2 & 31, hib = (tid2 >> 5) & 1;
    SBAR();
    finishSM(pA0, pA1, alA, l_reg, pa0, pa1, pa2, pa3); SBAR();
    pv_tile<0>(o, vb0, pa0, pa1, pa2, pa3);
    if (even) { MASKT(pB0, pB1, NT - 1); partialSM(pB0, pB1, m_reg, mnB, alB); __syncthreads(); RESC(alB);
        finishSM(pB0, pB1, alB, l_reg, pa0, pa1, pa2, pa3); SBAR(); pv_tile<1>(o, vb0, pa0, pa1, pa2, pa3); }
    SBAR();
    if (hi == 0) li_l[r32] = l_reg; asm volatile("s_waitcnt lgkmcnt(0)" ::: "memory");
    float rli[16];
#pragma unroll
    for (int r = 0; r < 16; ++r) rli[r] = __builtin_amdgcn_rcpf(li_l[crow(r, hi)]);
    char* Ow = (char*)cur.O + (size_t)(wid * QBLK) * (ldo * 2); const unsigned ooff = (unsigned)(4 * hib * ldo + r32b) * 2u;
#pragma unroll
    for (int r = 0; r < 16; ++r) { const int orow0 = (r & 3) + 8 * (r >> 2);
#pragma unroll
        for (int d0 = 0; d0 < 4; ++d0) { const float v = o[d0][r] * rli[r]; const float vn = __shfl_xor(v, 1);
            if ((r32b & 1) == 0) *(unsigned*)(Ow + (size_t)(orow0 * ldo + d0 * 32) * 2 + ooff) = cvt_pk_bf16(v, vn); } }
    __syncthreads();
#undef RESC
#undef KBASE
#undef MASKT
#undef SEAM_K0
#undef HALF_STEP
}
#undef ROW
#undef VMW
#undef VMWN
#undef SLOAD_H
#undef SWRITE_HK
#undef SWRITE_HV
#undef SWRITE_H
#undef KSWZ
}
namespace ret {
constexpr int QS = 288, VS = 544, SS = 144;
constexpr int OFF_Q = 0, OFF_K = 64 * QS, OFF_V = 2 * 64 * QS, OFF_S = OFF_V + 64 * VS, OFF_QD = OFF_S + 64 * SS, OFF_RP = OFF_QD + 256, LDS_BYTES = OFF_RP + 8 * 64 * 4;
#define TRRD(dst, base, off) asm volatile("ds_read_b64_tr_b16 %0, %1 offset:%2" : "=&v"(dst) : "v"(base), "i"(off) : "memory")
__device__ __forceinline__ bf16x8 cat8(s16x4 a, s16x4 b) { return (bf16x8){a[0], a[1], a[2], a[3], b[0], b[1], b[2], b[3]}; }
__device__ __forceinline__ u32x4 scale8(u32x4 v, float s) {
    u32x4 o; o.x = cvt_pk_bf16(bflo(v.x) * s, bfhi(v.x) * s); o.y = cvt_pk_bf16(bflo(v.y) * s, bfhi(v.y) * s); o.z = cvt_pk_bf16(bflo(v.z) * s, bfhi(v.z) * s); o.w = cvt_pk_bf16(bflo(v.w) * s, bfhi(v.w) * s); return o;
}
__device__ __forceinline__ void item(const bf16_t* proj, bf16_t* yret, int b, int h, LAS unsigned char* lds) {
    const int tid = opaque_tid(), w = __builtin_amdgcn_readfirstlane(tid >> 6), lane = tid & 63, c = lane & 15, q = lane >> 4, qq = c >> 2, p = c & 3;
    const float gam = 1.0f - __builtin_amdgcn_exp2f(-5.0f - (float)h);
    const float lg = log2f(gam);
    const float cd = __builtin_amdgcn_exp2f(lg * 64.0f);
    const int srow = tid >> 3, sseg = tid & 7;
    const float kd = __builtin_amdgcn_exp2f(lg * (float)(63 - srow));
    if (tid < 64) ((LAS float*)(lds + OFF_QD))[tid] = __builtin_amdgcn_exp2f(lg * (float)(tid + 1));
    const size_t tok0 = (size_t)b * SEQ;
    const bf16_t* gq = proj + (tok0 + srow) * NPROJ + C_RQ + h * 128 + 16 * sseg;
    const bf16_t* gk = proj + (tok0 + srow) * NPROJ + C_RK + h * 128 + 16 * sseg;
    const bf16_t* gv = proj + (tok0 + srow) * NPROJ + C_RV + h * 256 + 32 * sseg;
    LAS unsigned char* wq = lds + OFF_Q + srow * QS + sseg * 32; LAS unsigned char* wk = lds + OFF_K + srow * QS + sseg * 32; LAS unsigned char* wv = lds + OFF_V + srow * VS + sseg * 64;
    u32x4 pq0, pq1, pk0, pk1, pv0, pv1, pv2, pv3;
#define RET_LOAD(ch) do { const size_t o_ = (size_t)(ch) * 64 * NPROJ; pq0 = *(const u32x4*)(gq + o_); pq1 = *(const u32x4*)(gq + o_ + 8); pk0 = *(const u32x4*)(gk + o_); pk1 = *(const u32x4*)(gk + o_ + 8); \
        pv0 = *(const u32x4*)(gv + o_); pv1 = *(const u32x4*)(gv + o_ + 8); pv2 = *(const u32x4*)(gv + o_ + 16); pv3 = *(const u32x4*)(gv + o_ + 24); } while (0)
#define RET_WRITE() do { *(LAS u32x4*)(wq) = pq0; *(LAS u32x4*)(wq + 16) = pq1; *(LAS u32x4*)(wk) = scale8(pk0, kd); *(LAS u32x4*)(wk + 16) = scale8(pk1, kd); \
        *(LAS u32x4*)(wv) = pv0; *(LAS u32x4*)(wv + 16) = pv1; *(LAS u32x4*)(wv + 32) = pv2; *(LAS u32x4*)(wv + 48) = pv3; } while (0)
    f32x4 st[8][2];
#pragma unroll
    for (int dt = 0; dt < 8; ++dt) { st[dt][0] = (f32x4){0.f, 0.f, 0.f, 0.f}; st[dt][1] = (f32x4){0.f, 0.f, 0.f, 0.f}; }
    RET_LOAD(0); RET_WRITE();
    LDS_WAIT(); __syncthreads();
    const int mt = w & 3, nt0 = 2 * (w >> 2);
    const unsigned vbase = (unsigned)(uintptr_t)(lds + OFF_V) + (unsigned)((4 * q + qq) * VS + (32 * w + 4 * p) * 2);
    const unsigned kbase = (unsigned)(uintptr_t)(lds + OFF_K) + (unsigned)((4 * q + qq) * QS + (4 * p) * 2);
    const LAS unsigned char* qperm = lds + OFF_Q + c * QS + (4 * q) * 2;
    const LAS unsigned char* sperm = lds + OFF_S + c * SS + (4 * q) * 2;
    const LAS float* qd = (const LAS float*)(lds + OFF_QD); LAS float* rp = (LAS float*)(lds + OFF_RP);
    for (int ch = 0; ch < SEQ / 64; ++ch) {
        if (ch + 1 < SEQ / 64) RET_LOAD(ch + 1);
        {
            f32x4 s0 = (f32x4){0.f, 0.f, 0.f, 0.f}, s1 = (f32x4){0.f, 0.f, 0.f, 0.f};
#pragma unroll
            for (int ks = 0; ks < 4; ++ks) { const bf16x8 ak = *(const LAS bf16x8*)(lds + OFF_K + (16 * mt + c) * QS + (32 * ks + 8 * q) * 2);
                const bf16x8 b0 = *(const LAS bf16x8*)(lds + OFF_Q + (16 * nt0 + c) * QS + (32 * ks + 8 * q) * 2), b1 = *(const LAS bf16x8*)(lds + OFF_Q + (16 * nt0 + 16 + c) * QS + (32 * ks + 8 * q) * 2);
                s0 = __builtin_amdgcn_mfma_f32_16x16x32_bf16(ak, b0, s0, 0, 0, 0); s1 = __builtin_amdgcn_mfma_f32_16x16x32_bf16(ak, b1, s1, 0, 0, 0); }
#pragma unroll
            for (int t = 0; t < 2; ++t) { const int n = 16 * (nt0 + t) + c; f32x4 sv = t ? s1 : s0;
#pragma unroll
                for (int j = 0; j < 4; ++j) { const int m = 16 * mt + 4 * q + j; const int d = n > m ? n - m : m - n; sv[j] *= __builtin_amdgcn_exp2f(lg * (float)(d + m - 63)); }
                u32x2 o; o.x = cvt_pk_bf16(sv[0], sv[1]); o.y = cvt_pk_bf16(sv[2], sv[3]); *(LAS u32x2*)(lds + OFF_S + n * SS + (16 * mt + 4 * q) * 2) = o; }
        }
        LDS_WAIT(); __syncthreads();
        f32x4 acc[2][4];
#pragma unroll
        for (int ct = 0; ct < 2; ++ct)
#pragma unroll
            for (int nt = 0; nt < 4; ++nt) acc[ct][nt] = (f32x4){0.f, 0.f, 0.f, 0.f};
#pragma unroll
        for (int ks = 0; ks < 4; ++ks) {
            bf16x8 as[2];
#pragma unroll
            for (int ct = 0; ct < 2; ++ct) { const f32x4 x0 = st[2 * ks][ct], x1 = st[2 * ks + 1][ct]; u32x4 u; u.x = cvt_pk_bf16(x0[0], x0[1]); u.y = cvt_pk_bf16(x0[2], x0[3]); u.z = cvt_pk_bf16(x1[0], x1[1]); u.w = cvt_pk_bf16(x1[2], x1[3]); as[ct] = __builtin_bit_cast(bf16x8, u); }
#pragma unroll
            for (int nt = 0; nt < 4; ++nt) { const u32x2 lo = *(const LAS u32x2*)(qperm + nt * 16 * QS + ks * 64), hi = *(const LAS u32x2*)(qperm + nt * 16 * QS + ks * 64 + 32);
                const u32x4 bu = {lo.x, lo.y, hi.x, hi.y}; const bf16x8 bq = __builtin_bit_cast(bf16x8, bu);
                acc[0][nt] = __builtin_amdgcn_mfma_f32_16x16x32_bf16(as[0], bq, acc[0][nt], 0, 0, 0); acc[1][nt] = __builtin_amdgcn_mfma_f32_16x16x32_bf16(as[1], bq, acc[1][nt], 0, 0, 0); }
        }
#pragma unroll
        for (int nt = 0; nt < 4; ++nt) { const float f = qd[16 * nt + c]; acc[0][nt] = acc[0][nt] * f; acc[1][nt] = acc[1][nt] * f; }
        bf16x8 vt[2][2];
        { s16x4 a0, a1, a2, a3, a4, a5, a6, a7;
          TRRD(a0, vbase, 0); TRRD(a1, vbase, 16 * VS); TRRD(a2, vbase, 32); TRRD(a3, vbase, 16 * VS + 32);
          TRRD(a4, vbase, 32 * VS); TRRD(a5, vbase, 48 * VS); TRRD(a6, vbase, 32 * VS + 32); TRRD(a7, vbase, 48 * VS + 32);
          asm volatile("s_waitcnt lgkmcnt(0)" ::: "memory"); SBAR();
          vt[0][0] = cat8(a0, a1); vt[0][1] = cat8(a2, a3); vt[1][0] = cat8(a4, a5); vt[1][1] = cat8(a6, a7); }
#pragma unroll
        for (int ks2 = 0; ks2 < 2; ++ks2)
#pragma unroll
            for (int nt = 0; nt < 4; ++nt) { const u32x2 lo = *(const LAS u32x2*)(sperm + nt * 16 * SS + ks2 * 64), hi = *(const LAS u32x2*)(sperm + nt * 16 * SS + ks2 * 64 + 32);
                const u32x4 bu = {lo.x, lo.y, hi.x, hi.y}; const bf16x8 bs = __builtin_bit_cast(bf16x8, bu);
                acc[0][nt] = __builtin_amdgcn_mfma_f32_16x16x32_bf16(vt[ks2][0], bs, acc[0][nt], 0, 0, 0); acc[1][nt] = __builtin_amdgcn_mfma_f32_16x16x32_bf16(vt[ks2][1], bs, acc[1][nt], 0, 0, 0); }
#pragma unroll
        for (int dt = 0; dt < 8; ++dt) { s16x4 k0, k1, k2, k3;
            TRRD(k0, kbase, dt * 32); TRRD(k1, kbase, 16 * QS + dt * 32); TRRD(k2, kbase, 32 * QS + dt * 32); TRRD(k3, kbase, 48 * QS + dt * 32);
            asm volatile("s_waitcnt lgkmcnt(0)" ::: "memory"); SBAR();
            const bf16x8 ka = cat8(k0, k1), kb = cat8(k2, k3);
#pragma unroll
            for (int ct = 0; ct < 2; ++ct) { f32x4 s = st[dt][ct] * cd; s = __builtin_amdgcn_mfma_f32_16x16x32_bf16(ka, vt[0][ct], s, 0, 0, 0); s = __builtin_amdgcn_mfma_f32_16x16x32_bf16(kb, vt[1][ct], s, 0, 0, 0); st[dt][ct] = s; } }
#pragma unroll
        for (int nt = 0; nt < 4; ++nt) { float ss = 0.f;
#pragma unroll
            for (int ct = 0; ct < 2; ++ct)
#pragma unroll
                for (int j = 0; j < 4; ++j) ss += acc[ct][nt][j] * acc[ct][nt][j];
            ss += __shfl_xor(ss, 16); ss += __shfl_xor(ss, 32);
            if (q == 0) rp[w * 64 + 16 * nt + c] = ss; }
        LDS_WAIT(); __syncthreads();
        const size_t trow = tok0 + (size_t)ch * 64;
#pragma unroll
        for (int nt = 0; nt < 4; ++nt) { float tot = 0.f;
#pragma unroll
            for (int ww = 0; ww < 8; ++ww) tot += rp[ww * 64 + 16 * nt + c];
            const float rstd = 1.0f / sqrtf(tot * (1.0f / 256.0f) + RMS_EPS); const size_t tk = trow + 16 * nt + c;
#pragma unroll
            for (int ct = 0; ct < 2; ++ct) { const int col = h * 256 + 32 * w + 16 * ct + 4 * q;
                const u32x2 g = *(const u32x2*)(proj + tk * NPROJ + C_RG + col); const f32x4 a = acc[ct][nt] * rstd;
                u32x2 o; o.x = cvt_pk_bf16(a[0] * bflo(g.x), a[1] * bfhi(g.x)); o.y = cvt_pk_bf16(a[2] * bflo(g.y), a[3] * bfhi(g.y));
                *(u32x2*)(yret + tk * DM + col) = o; } }
        if (ch + 1 < SEQ / 64) { RET_WRITE(); }
        LDS_WAIT(); __syncthreads();
    }
#undef RET_LOAD
#undef RET_WRITE
}
#undef TRRD
}
constexpr int N_PHASES = 2 + 8 * NLAYER;
struct Args { const float* in[19]; float* out; unsigned char* ws; int ph_lo, ph_hi; };

__device__ __forceinline__ void moe_tables(Frame& F, int l) {
    LAS int* tab = (LAS int*)(F.lds + MOE_OFF);
    __syncthreads();
    if (F.tid < 32) tab[F.tid] = (int)__hip_atomic_load(F.ctl + CW_CNT + l * 2048 + 64 * F.tid, RLX_AGENT);
    LDS_WAIT(); __syncthreads();
    if (F.tid == 0) { int sa = 0, ta = 0; for (int e = 0; e < 32; ++e) { const int t = (tab[e] + 255) >> 8; tab[32 + e] = sa; tab[64 + e] = ta; sa += t * 256; ta += t; } tab[96] = ta; }
    LDS_WAIT(); __syncthreads();
}

__device__ __forceinline__ void mixer_phase(int l, int mode = 0) {
    for (;;) {
        GAS unsigned char* wsg_ = (GAS unsigned char*)KWS(); asm volatile("" : "+s"(wsg_)); unsigned char* ws = (unsigned char*)wsg_;
        LAS unsigned char* ldsb = (LAS unsigned char*)0; volatile LAS unsigned* MISC = (volatile LAS unsigned*)(ldsb + MISC_OFF);
        const int tid = opaque_tid(), lane = tid & 63, wave = __builtin_amdgcn_readfirstlane(tid >> 6);
        __syncthreads();
        if (tid == 0) MISC[16] = __hip_atomic_fetch_add((gu32*)(ws + WS_CTL) + CW_QUEUE + 64 * l, 1u, RLX_AGENT);
        LDS_WAIT(); __syncthreads();
        const int it = __builtin_amdgcn_readfirstlane((int)MISC[16]);
        if (it >= 576) break;
        if ((mode == 1 && it >= 64) || (mode == 2 && it < 64)) continue;
        const bf16_t* proj = (const bf16_t*)(ws + WS_PROJ);
#ifndef NO_RET
        if (it < 64) { ret::item(proj, (bf16_t*)(ws + WS_YR), it >> 3, it & 7, ldsb); continue; }
#endif
#ifndef NO_FOX
        const int j = it - 64, x = 7 - (j >> 6), bh = j & 63, b = bh >> 3, h = bh & 7;
        { const int n = 256 * (x + 1); LAS float* bias = (LAS float*)(ldsb + fox::OFF_BIAS); LAS float* wt = (LAS float*)(ldsb + fox::OFF_WS);
          const float* logf = (const float*)(ws + WS_LOGF);
          f32x4 v = (f32x4){0.f, 0.f, 0.f, 0.f}; if (4 * tid < n) v = *(const f32x4*)(logf + (size_t)(b * 8 + h) * SEQ + 4 * tid);
          v[1] += v[0]; v[2] += v[1]; v[3] += v[2];
          float run = v[3];
#pragma unroll
          for (int o = 1; o < 64; o <<= 1) { const float t = __shfl_up(run, o); if (lane >= o) run += t; }
          if (lane == 63) wt[wave] = run;
          LDS_WAIT(); __syncthreads();
          float base = run - v[3];
          for (int ww = 0; ww < wave; ++ww) base += wt[ww];
          *(LAS f32x4*)(bias + 4 * tid) = (f32x4){-(v[0] + base) * LOG2E, -(v[1] + base) * LOG2E, -(v[2] + base) * LOG2E, -(v[3] + base) * LOG2E};
          LDS_WAIT(); __syncthreads(); }
        const size_t tok0 = (size_t)b * SEQ;
        fox::BlockRef cur;
        cur.Q = proj + (tok0 + 256 * x) * NPROJ + C_FQ + h * 128; cur.K = proj + tok0 * NPROJ + C_FK + h * 128; cur.V = proj + tok0 * NPROJ + C_FV + h * 128;
        cur.O = (bf16_t*)(ws + WS_YF) + (tok0 + 256 * x) * 1024 + h * 128; cur.P0 = 256 * x;
        fox::Seam S;
        fox::prime<NPROJ>(cur, (LAS char*)ldsb, S);
        fox::block<NPROJ, 1024>(cur, cur, (LAS char*)ldsb, S);
#endif
    }
}

__global__ void __launch_bounds__(NWAVES * 64, 2) hybrid_fwd(Args args) {
    extern __shared__ __attribute__((aligned(16))) unsigned char lds_raw[];
    { LAS unsigned char* l0 = (LAS unsigned char*)lds_raw;
      for (int u = threadIdx.x; u < (LDS_BYTES - LDSCTL_OFF) / 4; u += NWAVES * 64) ((LAS unsigned*)(l0 + LDSCTL_OFF))[u] = 0u;
      __syncthreads(); }
#if MK_N_LAUNCHES == 1
    { GAS unsigned char* wsg_ = (GAS unsigned char*)args.ws; asm volatile("" : "+s"(wsg_)); unsigned char* ws = (unsigned char*)wsg_; (void)xcd_barrier_post((unsigned*)((gu32*)(ws + WS_CTL) + CW_BAR), (volatile LAS unsigned*)((LAS unsigned char*)lds_raw + MISC_OFF) + 8); }
#define GRID_BAR() do { GAS unsigned char* wsg_ = (GAS unsigned char*)args.ws; asm volatile("" : "+s"(wsg_)); unsigned char* ws_ = (unsigned char*)wsg_; XcdBarrier bar_; bar_.bar = (unsigned*)((gu32*)(ws_ + WS_CTL) + CW_BAR); bar_.x = xb_xcc_id(); \
        bar_.st = (volatile LAS unsigned*)((LAS unsigned char*)lds_raw + MISC_OFF) + 8; xcd_barrier(bar_); } while (0)
#else
#define GRID_BAR() do {} while (0)
#endif
    const int lo = args.ph_lo, hi = args.ph_hi;
#define IN(k) (lo <= (k) && (k) < hi)
#define SEAM(k) do { if (IN(k) && IN((k) + 1)) GRID_BAR(); } while (0)
#define PHASE_PTRS() GAS unsigned char* wsg_ = (GAS unsigned char*)args.ws; asm volatile("" : "+s"(wsg_)); unsigned char* ws = (unsigned char*)wsg_; Frame F; F.lds = (LAS unsigned char*)lds_raw; F.MISC = (volatile LAS unsigned*)(F.lds + MISC_OFF); \
    F.tid = opaque_tid(); F.lane = F.tid & 63; F.wave = __builtin_amdgcn_readfirstlane(F.tid >> 6); F.G = gridDim.x; F.bx = blockIdx.x; F.ws = ws; F.ctl = (gu32*)(ws + WS_CTL); F.out = (float*)(GAS float*)args.out; \
    float* hf = (float*)(ws + WS_HF); bf16_t* hb = (bf16_t*)(ws + WS_HB); bf16_t* proj = (bf16_t*)(ws + WS_PROJ); \
    bf16_t* yfox = (bf16_t*)(ws + WS_YF); bf16_t* yret = (bf16_t*)(ws + WS_YR); bf16_t* mg = (bf16_t*)(ws + WS_MG); \
    float* z1 = (float*)(ws + WS_Z1); bf16_t* hid = (bf16_t*)(ws + WS_HID); bf16_t* ffo = (bf16_t*)(ws + WS_FFO); \
    float* logf = (float*)(ws + WS_LOGF); int* route = (int*)(ws + WS_ROUTE); int* list = (int*)(ws + WS_LIST); float* wlist = (float*)(ws + WS_WLIST); \
    const float* cosT = (const float*)(ws + WS_ROPE); const float* sinT = cosT + SEQ * 64; \
    const LAS int* tab = (const LAS int*)(F.lds + MOE_OFF); unsigned char* wl = ws + WS_W; \
    (void)hf; (void)hb; (void)proj; (void)yfox; (void)yret; (void)mg; (void)z1; (void)hid; (void)ffo; (void)logf; (void)route; (void)list; (void)wlist; (void)cosT; (void)sinT; (void)tab; (void)wl
#ifndef PH_MASK
#define PH_MASK 0xFFFF
#endif
#define PHON(k) ((PH_MASK >> (k)) & 1)
#ifndef DUP_MASK
#define DUP_MASK 0
#endif
#define REPS(k) (((DUP_MASK >> (k)) & 1) ? 2 : 1)
    if (PHON(0) && IN(0)) { const int l = 0; PHASE_PTRS(); for (int rep_ = 0; rep_ < REPS(0); ++rep_) p0_weights(F, 0); p0_tables(F); } SEAM(0);
    if (PHON(1) && IN(1)) { const int l = 0; PHASE_PTRS();
        LnArgs a{}; a.zin = INP(0); a.hf = hf; a.hb = hb; a.h8 = ws + WS_HB8; a.g = INP(1); a.b = INP(2);
        a.whi = (const bf16_t*)(ws + WS_SKW); a.wlo = a.whi + 16 * 2048; a.S12 = (const float*)(ws + WS_SKS); a.bfor = INP(4); a.logf = logf;
        for (int rep_ = 0; rep_ < REPS(1); ++rep_) ln_pass<0, 1, true>(F, a);
    } SEAM(1);
    { constexpr int l = 0;
        const int pb = 2 + 8 * l;
        if (PHON(2) && IN(pb + 0)) { PHASE_PTRS();
            gm::SchedDense S{(const char*)hb, (const char*)(wl + WL_WIN), 2048 * 2, 2048 * 2, 32, 64, N_BF16_TILES, F.G, F.bx, 0};
            gm::EpiProj E{proj, cosT, sinT, 1.f};
            for (int rep_ = 0; rep_ < REPS(2); ++rep_) gm::gemm_phase<true, false>(F.lds, S, E);
            gm::SchedDense S8{(const char*)(ws + WS_HB8), (const char*)(wl + WL_WIN8), 2048, 2048, 16, 64, N_FP8_TILES, F.G, F.bx, N_BF16_TILES};
            gm::EpiProj E8{proj, cosT, sinT, 1.f / W8_SCALE};
            for (int rep_ = 0; rep_ < REPS(2); ++rep_) gm::gemm_phase<true, true>(F.lds, S8, E8);
        } SEAM(pb + 0);
        if (PHON(3) && IN(pb + 1)) { for (int rep_ = 0; rep_ < REPS(3); ++rep_) mixer_phase(l + 2 * rep_, rep_ ? ((DUP_MASK >> 10) & 3) : 0); } SEAM(pb + 1);
        if (PHON(4) && IN(pb + 2)) { PHASE_PTRS();
            gm::SchedMerge S{(const char*)yfox, (const char*)(wl + WL_WBF), (const char*)yret, (const char*)(wl + WL_WBR), 64, 8, F.G, F.bx};
            gm::EpiMerge E{proj, mg};
            for (int rep_ = 0; rep_ < REPS(4); ++rep_) gm::gemm_phase<true, false>(F.lds, S, E);
        } SEAM(pb + 2);
        if (PHON(5) && IN(pb + 3)) { PHASE_PTRS();
            gm::SchedDense S{(const char*)mg, (const char*)(wl + WL_WOUT), 2048 * 2, 2048 * 2, 32, 64, 8, F.G, F.bx, 0};
            gm::EpiOut E{hf, z1};
            for (int rep_ = 0; rep_ < REPS(5); ++rep_) gm::gemm_phase<false, false>(F.lds, S, E);
        } SEAM(pb + 3);
        if (PHON(6) && IN(pb + 4)) { PHASE_PTRS();
            LnArgs a{}; a.zin = z1; a.hf = z1; a.hb = hb; a.g = INP(8) + l * DM; a.b = INP(9) + l * DM;
            a.whi = (const bf16_t*)(ws + WS_SKW + 2 * SKW_FGT_BYTES + (size_t)l * SKW_RTR_BYTES); a.wlo = a.whi + 48 * 2048; a.S12 = (const float*)(ws + WS_SKS + (size_t)(2 + l) * 512);
            a.brg = INP(11) + l * 4; a.bre = INP(13) + l * 32; a.route_out = route; a.list = list; a.wlist = wlist; a.cnt = (unsigned*)(F.ctl + CW_CNT + l * 2048);
            if (REPS(6) == 2) { LnArgs d = a; d.hf = hf; d.hb = mg; d.route_out = (int*)ffo; d.list = (int*)ffo + (1 << 20); d.wlist = (float*)ffo + (2 << 20); d.cnt = (unsigned*)(F.ctl + CW_CNT + 4096 + l * 2048);
                ln_pass<1, 3, true>(F, d); }
            ln_pass<1, 3, true>(F, a);
        } SEAM(pb + 4);
        if (PHON(7) && IN(pb + 5)) { PHASE_PTRS();
            moe_tables(F, l);
            gm::SchedMoe<true> S{tab, (const char*)hb, (const char*)(wl + WL_WGU), list, 4, F.G, F.bx};
            gm::EpiMoe1 E{hid, wlist, tab};
            for (int rep_ = 0; rep_ < REPS(7); ++rep_) gm::gemm_phase<true, false>(F.lds, S, E);
        } SEAM(pb + 5);
        if (PHON(8) && IN(pb + 6)) { PHASE_PTRS();
            moe_tables(F, l);
            gm::SchedMoe<false> S{tab, (const char*)hid, (const char*)(wl + WL_WD), list, 8, F.G, F.bx};
            gm::EpiMoe2 E{ffo};
            for (int rep_ = 0; rep_ < REPS(8); ++rep_) gm::gemm_phase<true, false>(F.lds, S, E);
        } SEAM(pb + 6);
        if (PHON(9) && IN(pb + 7)) { PHASE_PTRS();
            if (l + 1 < NLAYER) for (int rep_ = 0; rep_ < REPS(0); ++rep_) p0_weights(F, l + 1);
            moe_tables(F, l);
            LnArgs a{}; a.zin = z1; a.ffo = ffo; a.route = route; a.tab = tab; a.g = INP(17) + l * DM; a.b = INP(18) + l * DM;
            if (l + 1 < NLAYER) { a.hf = hf; a.hb = hb; a.h8 = ws + WS_HB8; a.whi = (const bf16_t*)(ws + WS_SKW + (size_t)(l + 1) * SKW_FGT_BYTES); a.wlo = a.whi + 16 * 2048; a.S12 = (const float*)(ws + WS_SKS + (size_t)(l + 1) * 512);
                a.bfor = INP(4) + (l + 1) * 8; a.logf = logf; for (int rep_ = 0; rep_ < REPS(9); ++rep_) ln_pass<2, 1, true>(F, a); }
            else { a.hf = F.out; a.hb = nullptr; ln_pass<2, 1, false>(F, a); }
        } SEAM(pb + 7);
    }
    { constexpr int l = 1;
        const int pb = 2 + 8 * l;
        if (PHON(2) && IN(pb + 0)) { PHASE_PTRS();
            gm::SchedDense S{(const char*)hb, (const char*)(wl + WL_WIN), 2048 * 2, 2048 * 2, 32, 64, N_BF16_TILES, F.G, F.bx, 0};
            gm::EpiProj E{proj, cosT, sinT, 1.f};
            for (int rep_ = 0; rep_ < REPS(2); ++rep_) gm::gemm_phase<true, false>(F.lds, S, E);
            gm::SchedDense S8{(const char*)(ws + WS_HB8), (const char*)(wl + WL_WIN8), 2048, 2048, 16, 64, N_FP8_TILES, F.G, F.bx, N_BF16_TILES};
            gm::EpiProj E8{proj, cosT, sinT, 1.f / W8_SCALE};
            for (int rep_ = 0; rep_ < REPS(2); ++rep_) gm::gemm_phase<true, true>(F.lds, S8, E8);
        } SEAM(pb + 0);
        if (PHON(3) && IN(pb + 1)) { for (int rep_ = 0; rep_ < REPS(3); ++rep_) mixer_phase(l + 2 * rep_, rep_ ? ((DUP_MASK >> 10) & 3) : 0); } SEAM(pb + 1);
        if (PHON(4) && IN(pb + 2)) { PHASE_PTRS();
            gm::SchedMerge S{(const char*)yfox, (const char*)(wl + WL_WBF), (const char*)yret, (const char*)(wl + WL_WBR), 64, 8, F.G, F.bx};
            gm::EpiMerge E{proj, mg};
            for (int rep_ = 0; rep_ < REPS(4); ++rep_) gm::gemm_phase<true, false>(F.lds, S, E);
        } SEAM(pb + 2);
        if (PHON(5) && IN(pb + 3)) { PHASE_PTRS();
            gm::SchedDense S{(const char*)mg, (const char*)(wl + WL_WOUT), 2048 * 2, 2048 * 2, 32, 64, 8, F.G, F.bx, 0};
            gm::EpiOut E{hf, z1};
            for (int rep_ = 0; rep_ < REPS(5); ++rep_) gm::gemm_phase<false, false>(F.lds, S, E);
        } SEAM(pb + 3);
        if (PHON(6) && IN(pb + 4)) { PHASE_PTRS();
            LnArgs a{}; a.zin = z1; a.hf = z1; a.hb = hb; a.g = INP(8) + l * DM; a.b = INP(9) + l * DM;
            a.whi = (const bf16_t*)(ws + WS_SKW + 2 * SKW_FGT_BYTES + (size_t)l * SKW_RTR_BYTES); a.wlo = a.whi + 48 * 2048; a.S12 = (const float*)(ws + WS_SKS + (size_t)(2 + l) * 512);
            a.brg = INP(11) + l * 4; a.bre = INP(13) + l * 32; a.route_out = route; a.list = list; a.wlist = wlist; a.cnt = (unsigned*)(F.ctl + CW_CNT + l * 2048);
            if (REPS(6) == 2) { LnArgs d = a; d.hf = hf; d.hb = mg; d.route_out = (int*)ffo; d.list = (int*)ffo + (1 << 20); d.wlist = (float*)ffo + (2 << 20); d.cnt = (unsigned*)(F.ctl + CW_CNT + 4096 + l * 2048);
                ln_pass<1, 3, true>(F, d); }
            ln_pass<1, 3, true>(F, a);
        } SEAM(pb + 4);
        if (PHON(7) && IN(pb + 5)) { PHASE_PTRS();
            moe_tables(F, l);
            gm::SchedMoe<true> S{tab, (const char*)hb, (const char*)(wl + WL_WGU), list, 4, F.G, F.bx};
            gm::EpiMoe1 E{hid, wlist, tab};
            for (int rep_ = 0; rep_ < REPS(7); ++rep_) gm::gemm_phase<true, false>(F.lds, S, E);
        } SEAM(pb + 5);
        if (PHON(8) && IN(pb + 6)) { PHASE_PTRS();
            moe_tables(F, l);
            gm::SchedMoe<false> S{tab, (const char*)hid, (const char*)(wl + WL_WD), list, 8, F.G, F.bx};
            gm::EpiMoe2 E{ffo};
            for (int rep_ = 0; rep_ < REPS(8); ++rep_) gm::gemm_phase<true, false>(F.lds, S, E);
        } SEAM(pb + 6);
        if (PHON(9) && IN(pb + 7)) { PHASE_PTRS();
            if (l + 1 < NLAYER) for (int rep_ = 0; rep_ < REPS(0); ++rep_) p0_weights(F, l + 1);
            moe_tables(F, l);
            LnArgs a{}; a.zin = z1; a.ffo = ffo; a.route = route; a.tab = tab; a.g = INP(17) + l * DM; a.b = INP(18) + l * DM;
            if (l + 1 < NLAYER) { a.hf = hf; a.hb = hb; a.h8 = ws + WS_HB8; a.whi = (const bf16_t*)(ws + WS_SKW + (size_t)(l + 1) * SKW_FGT_BYTES); a.wlo = a.whi + 16 * 2048; a.S12 = (const float*)(ws + WS_SKS + (size_t)(l + 1) * 512);
                a.bfor = INP(4) + (l + 1) * 8; a.logf = logf; for (int rep_ = 0; rep_ < REPS(9); ++rep_) ln_pass<2, 1, true>(F, a); }
            else { a.hf = F.out; a.hb = nullptr; ln_pass<2, 1, false>(F, a); }
        } SEAM(pb + 7);
    }
#undef IN
#undef SEAM
#undef GRID_BAR
}

extern "C" void kernel_launch(void* const* d_in, const int* in_sizes, int n_in, void* d_out, int out_size, void* d_ws, size_t ws_size, hipStream_t stream) {
    static int grid = 0;
    if (grid == 0) {
        if (n_in != 19 || out_size != NTOK * DM || ws_size < WS_END) { fprintf(stderr, "kernel_launch: unexpected problem (n_in %d, out %d, ws %zu)\n", n_in, out_size, ws_size); grid = -1; }
        int dev = 0, cus = 0;
        if (grid == 0 && (hipGetDevice(&dev) != hipSuccess || hipDeviceGetAttribute(&cus, hipDeviceAttributeMultiprocessorCount, dev) != hipSuccess)) grid = -1;
        if (grid == 0 && hipFuncSetAttribute((const void*)hybrid_fwd, hipFuncAttributeMaxDynamicSharedMemorySize, LDS_BYTES) != hipSuccess) { fprintf(stderr, "kernel_launch: hipFuncSetAttribute failed\n"); grid = -1; }
        (void)hipGetLastError();
        if (grid == 0) grid = cus;
    }
    if (grid < 0) { (void)hipMemsetAsync(d_out, 0xFF, (size_t)out_size * 4, stream); return; }
    if (hipMemsetAsync((char*)d_ws + WS_CTL, 0, CTL_ZERO_BYTES, stream) != hipSuccess) return;
    Args a{};
    for (int i = 0; i < 19; ++i) a.in[i] = (const float*)d_in[i];
    a.out = (float*)d_out; a.ws = (unsigned char*)d_ws;
#if MK_N_LAUNCHES == 1
    a.ph_lo = 0; a.ph_hi = N_PHASES;
    hipLaunchKernelGGL(hybrid_fwd, dim3(grid), dim3(NWAVES * 64), LDS_BYTES, stream, a);
#else
    for (int ph = 0; ph < N_PHASES; ++ph) { a.ph_lo = ph; a.ph_hi = ph + 1; hipLaunchKernelGGL(hybrid_fwd, dim3(grid), dim3(NWAVES * 64), LDS_BYTES, stream, a); }
#endif
}
```

```cpp
#include <hip/hip_runtime.h>
#include <cstdio>
#include <cstdint>

#ifndef MK_N_LAUNCHES
#define MK_N_LAUNCHES 1
#endif

#define LAS __attribute__((address_space(3)))
#define GAS __attribute__((address_space(1)))
typedef unsigned short bf16_t;
typedef short bf16x8 __attribute__((ext_vector_type(8)));
typedef short s16x4 __attribute__((ext_vector_type(4)));
typedef float f32x4 __attribute__((ext_vector_type(4)));
typedef float f32x2 __attribute__((ext_vector_type(2)));
typedef float f32x16 __attribute__((ext_vector_type(16)));
typedef unsigned u32x4 __attribute__((ext_vector_type(4)));
typedef unsigned u32x2 __attribute__((ext_vector_type(2)));
typedef GAS unsigned gu32;
#define RLX_AGENT __ATOMIC_RELAXED, __HIP_MEMORY_SCOPE_AGENT
#define LDS_WAIT() asm volatile("s_waitcnt lgkmcnt(0)" ::: "memory")
#define VM_WAIT() asm volatile("s_waitcnt vmcnt(0)" ::: "memory")
#define SBAR() __builtin_amdgcn_sched_barrier(0)

constexpr int NTOK = 16384, DM = 2048, SEQ = 2048, NBATCH = 8, NLAYER = 2;
constexpr int NPROJ = 13312;
constexpr int C_FQ = 0, C_FK = 1024, C_FV = 2048, C_RQ = 3072, C_RK = 4096, C_RV = 5120, C_RG = 7168, C_GF = 9216, C_GR = 11264;
constexpr int W_IN_COLS = 13320;
constexpr int NEXP = 32, DEXP = 512;
constexpr int HID_ROWS = 40960;
constexpr float ALPHA = 1.4142135623730951f;
constexpr float LN_EPS = 1e-5f, RMS_EPS = 1e-6f;
constexpr float LOG2E = 1.4426950408889634f;
constexpr float QSCALE = 0.08838834764831845f * LOG2E;
constexpr float KSCALE = 0.08838834764831845f;

constexpr size_t MiB = 1u << 20;
constexpr size_t WS_CTL = 0, CTL_ZERO_BYTES = 1 * MiB;
constexpr size_t WS_ROPE = 1 * MiB;
constexpr size_t WS_SKW = 2 * MiB;
constexpr size_t SKW_FGT_BYTES = 16 * 2048 * 2 * 2, SKW_RTR_BYTES = 48 * 2048 * 2 * 2;
constexpr size_t WS_SKS = 3 * MiB;
constexpr size_t WS_LOGF = 3 * MiB + 512 * 1024;
constexpr size_t WS_ROUTE = 4 * MiB;
constexpr size_t WS_LIST = 5 * MiB;
constexpr size_t WS_WLIST = 7 * MiB;
constexpr size_t WS_W = 16 * MiB;
constexpr size_t WL_WIN = 0, WL_WBF = 52 * MiB, WL_WBR = 56 * MiB, WL_WOUT = 64 * MiB, WL_WGU = 72 * MiB, WL_WD = 200 * MiB, WL_BYTES = 264 * MiB;
constexpr size_t WS_HF = 280 * MiB;
constexpr size_t WS_HB = 408 * MiB;
constexpr size_t WS_YF = 472 * MiB, WS_YR = 504 * MiB, WS_MG = 568 * MiB;
constexpr size_t WS_PROJ = 632 * MiB;
constexpr size_t WS_Z1 = WS_PROJ, WS_HID = WS_PROJ + 128 * MiB, WS_FFO = WS_PROJ + 168 * MiB;
constexpr size_t WS_END = 1048 * MiB;
static_assert(WS_FFO + (size_t)HID_ROWS * 2048 * 2 <= WS_END && WS_HID + (size_t)HID_ROWS * 512 * 2 <= WS_FFO, "overlay map");
constexpr int CW_TMO = 0;
constexpr int CW_BAR = 4096;
constexpr int CW_QUEUE = 8192;
constexpr int CW_CNT = 9216;

constexpr int RING_BYTES = 131072;
constexpr int LDSCTL_OFF = RING_BYTES;
constexpr int MISC_OFF = LDSCTL_OFF;
constexpr int MOE_OFF = LDSCTL_OFF + 256;
constexpr int LNS_OFF = LDSCTL_OFF + 1024;
constexpr int LDS_BYTES = 163840;

__device__ __forceinline__ unsigned cvt_pk_bf16(float lo, float hi) { unsigned r; asm volatile("v_cvt_pk_bf16_f32 %0, %1, %2" : "=v"(r) : "v"(lo), "v"(hi)); return r; }
__device__ __forceinline__ unsigned f2bf(float f) { unsigned u = __builtin_bit_cast(unsigned, f); return (u + 0x7fffu + ((u >> 16) & 1u)) >> 16; }
__device__ __forceinline__ unsigned pk2(float lo, float hi) { return f2bf(lo) | (f2bf(hi) << 16); }
__device__ __forceinline__ float bf2f(unsigned short b) { return __builtin_bit_cast(float, ((unsigned)b) << 16); }
__device__ __forceinline__ float bflo(unsigned w) { return __builtin_bit_cast(float, w << 16); }
__device__ __forceinline__ float bfhi(unsigned w) { return __builtin_bit_cast(float, w & 0xffff0000u); }
__device__ __forceinline__ float fast_sigmoid(float x) { return __builtin_amdgcn_rcpf(1.0f + __builtin_amdgcn_exp2f(-x * LOG2E)); }
__device__ __forceinline__ int opaque_tid() { int t = threadIdx.x; asm volatile("" : "+v"(t)); return t; }
typedef int v4i_t __attribute__((ext_vector_type(4)));
typedef int v8i_t __attribute__((ext_vector_type(8)));
__device__ __forceinline__ unsigned pk4_fp8(float a, float b, float c_, float d) { int w = __builtin_amdgcn_cvt_pk_fp8_f32(a, b, 0, false); w = __builtin_amdgcn_cvt_pk_fp8_f32(c_, d, w, true); return (unsigned)w; }
constexpr float W8_SCALE = 32.f;
constexpr float HID8_SCALE = 64.f;
constexpr int N_BF16_TILES = 36, N_FP8_TILES = 16;
constexpr size_t WL_WIN8 = WL_WIN + (size_t)N_BF16_TILES * 256 * 2048 * 2;
constexpr size_t WS_HB8 = WS_MG;
namespace gm {
constexpr int BM = 256, BK = 64, HALF = 128, HTB = HALF * BK * 2, STAGE_BYTES = 8 * HTB, NXCD = 8, WGM = 8;
__host__ __device__ __forceinline__ int lds_byte(int r, int c) { const int st = (r >> 4) * 2 + (c >> 5), rr = r & 15, cc = c & 31, ob = rr * 64 + cc * 2; return st * 1024 + (ob ^ (((ob >> 9) & 1) << 5)); }
__host__ __device__ __forceinline__ void stage_rc(int b, int& R, int& C) { const int st = b / 1024, sb = b % 1024, swz = sb ^ (((sb >> 9) & 1) << 5); R = (st >> 1) * 16 + swz / 64; C = (st & 1) * 32 + (swz % 64) / 2; }
__host__ __device__ __forceinline__ int perm32(int rho) { const int n = rho >> 4, i = rho & 15; return 8 * (i >> 2) + 4 * n + (i & 3); }

struct Unit {
    const char* A;
    const char* B;
    unsigned lda, ldb;
    int nt;
    int pm, pn;
    int kind;
    int e, rows;
    int keep;
};
__device__ __forceinline__ bool static_tile(int L, int nM, int nN, int& pm, int& pn) {
    const int nwg = nM * nN; if (L >= nwg) return false;
    int wgid = L; { const int q = nwg / NXCD, r = nwg % NXCD, xcd = wgid % NXCD, off = wgid / NXCD; wgid = (xcd < r ? xcd * (q + 1) : r * (q + 1) + (xcd - r) * q) + off; }
    const int nig = WGM * nN, gid = wgid / nig, fm = gid * WGM, gsz = (nM - fm) < WGM ? (nM - fm) : WGM;
    pm = fm + ((wgid % nig) % gsz); pn = (wgid % nig) / gsz; return true;
}

template <bool PERM, bool FP8, class Sched, class Epi>
__device__ __forceinline__ void gemm_phase(LAS unsigned char* lds, const Sched& S, const Epi& E) {
    const int tid = opaque_tid(), wid = __builtin_amdgcn_readfirstlane(tid >> 6), lane = tid & 63, wr = wid >> 2, wc = wid & 3, fr = lane & 15, fq = lane >> 4;
    int Rr[2], Cc[2], Rb[2];
#pragma unroll
    for (int i = 0; i < 2; ++i) { int R, C; stage_rc(tid * 16 + i * 8192, R, C); Rr[i] = R; Cc[i] = C; Rb[i] = PERM ? ((R & ~31) + perm32(R & 31)) : R; }
    const unsigned ldsw = (unsigned)wid * 1024u;
    const int aoff = lds_byte(wr * 64 + fr, fq * 8), boff = lds_byte(wc * 32 + fr, fq * 8);
#define PG8_SA(b, h) (((b) * 2 + (h)) * HTB)
#define PG8_SB(b, h) ((4 + (b) * 2 + (h)) * HTB)
#define PG8_STAGE(bufoff, gbase, voff) do { _Pragma("unroll") for (int _i = 0; _i < 2; ++_i) \
        __builtin_amdgcn_global_load_lds((const unsigned*)((const char*)(gbase) + (voff)[_i]), (LAS unsigned*)(lds + (bufoff) + ldsw + _i * 8192), 16, 0, 0); } while (0)
#define PG8_LDA(dst, b, h) do { _Pragma("unroll") for (int m = 0; m < 4; ++m) _Pragma("unroll") for (int k = 0; k < 2; ++k) dst[m][k] = *(const LAS bf16x8*)(lds + PG8_SA(b, h) + aoff + m * 2048 + k * 1024); } while (0)
#define PG8_LDB(dst, b, h) do { _Pragma("unroll") for (int n = 0; n < 2; ++n) _Pragma("unroll") for (int k = 0; k < 2; ++k) dst[n][k] = *(const LAS bf16x8*)(lds + PG8_SB(b, h) + boff + n * 2048 + k * 1024); } while (0)
#define PG8_MMA(ai, bj, At, Bt) do { __builtin_amdgcn_s_setprio(1); _Pragma("unroll") for (int m = 0; m < 4; ++m) _Pragma("unroll") for (int n = 0; n < 2; ++n) { \
        if constexpr (FP8) { const v8i_t bb_ = __builtin_shufflevector(__builtin_bit_cast(v4i_t, Bt[n][0]), __builtin_bit_cast(v4i_t, Bt[n][1]), 0, 1, 2, 3, 4, 5, 6, 7); \
            const v8i_t aa_ = __builtin_shufflevector(__builtin_bit_cast(v4i_t, At[m][0]), __builtin_bit_cast(v4i_t, At[m][1]), 0, 1, 2, 3, 4, 5, 6, 7); \
            acc[ai][bj][m][n] = __builtin_amdgcn_mfma_scale_f32_16x16x128_f8f6f4(bb_, aa_, acc[ai][bj][m][n], 0, 0, 0, 0x7f7f7f7f, 0, 0x7f7f7f7f); } \
        else { _Pragma("unroll") for (int k = 0; k < 2; ++k) acc[ai][bj][m][n] = __builtin_amdgcn_mfma_f32_16x16x32_bf16(Bt[n][k], At[m][k], acc[ai][bj][m][n], 0, 0, 0); } } \
        __builtin_amdgcn_s_setprio(0); } while (0)
#define PG8_WAIT_V(n) asm volatile("s_waitcnt vmcnt(" #n ")" ::: "memory")
#define PG8_WAIT_L(n) asm volatile("s_waitcnt lgkmcnt(" #n ")" ::: "memory")
#define PG8_BAR __builtin_amdgcn_s_barrier()
#define PG8_SCHED __builtin_amdgcn_sched_barrier(0)
#define PG8_OFFS(u, tk) do { _Pragma("unroll") for (int _i = 0; _i < 2; ++_i) { \
        vA0[_i] = (Sched::GATHER ? (unsigned)tk[_i] : (unsigned)Rr[_i]) * (u).lda + (unsigned)Cc[_i] * 2u; vA1[_i] = (Sched::GATHER ? (unsigned)tk[2 + _i] : (unsigned)(HALF + Rr[_i])) * (u).lda + (unsigned)Cc[_i] * 2u; \
        vB[_i] = (unsigned)Rb[_i] * (u).ldb + (unsigned)Cc[_i] * 2u; } } while (0)
#define PG8_TOKS(u, tk) do { if (Sched::GATHER) { tk[0] = S.tok(u, Rr[0]); tk[1] = S.tok(u, Rr[1]); tk[2] = S.tok(u, HALF + Rr[0]); tk[3] = S.tok(u, HALF + Rr[1]); } } while (0)
    Unit cur, nxt; int ui = 0;
    if (!S.next(0, cur)) return;
    f32x4 acc[2][2][4][2];
#pragma unroll
    for (int a = 0; a < 2; ++a)
#pragma unroll
        for (int b = 0; b < 2; ++b)
#pragma unroll
            for (int m = 0; m < 4; ++m)
#pragma unroll
                for (int n = 0; n < 2; ++n) acc[a][b][m][n] = (f32x4){0.f, 0.f, 0.f, 0.f};
    bf16x8 At[4][2], B0[2][2], B1[2][2];
    unsigned vA0[2], vA1[2], vB[2];
    int tk[4] = {0, 0, 0, 0};
    PG8_TOKS(cur, tk); PG8_OFFS(cur, tk);
    const char* cA = cur.A; const char* cB = cur.B; size_t hB = (size_t)HALF * cur.ldb;
    const size_t kstep = (size_t)(BK * 2);
    PG8_STAGE(PG8_SB(0, 0), cB, vB); PG8_STAGE(PG8_SB(0, 1), cB + hB, vB); PG8_STAGE(PG8_SA(0, 0), cA, vA0); PG8_STAGE(PG8_SA(0, 1), cA, vA1);
    if (wr == 1) PG8_BAR;
    PG8_WAIT_V(2); PG8_BAR;
    PG8_STAGE(PG8_SB(1, 0), cB + kstep, vB); PG8_STAGE(PG8_SA(1, 0), cA + kstep, vA0); PG8_STAGE(PG8_SB(1, 1), cB + hB + kstep, vB);
    PG8_WAIT_V(6); PG8_BAR;
    for (;;) {
        bool has_next = false;
        const char* nAp = cA; const char* nBp = cB; size_t nhB = hB;
        int nt = cur.nt; asm volatile("" : "+s"(nt));
        for (int t = 0; t < nt; t += 2) {
            const bool last = (t == nt - 2);
            asm volatile("" : "+v"(vA0[0]), "+v"(vA0[1]), "+v"(vA1[0]), "+v"(vA1[1]), "+v"(vB[0]), "+v"(vB[1]));
            if (last) { has_next = S.next(ui + 1, nxt); if (has_next) { nAp = nxt.A; nBp = nxt.B; nhB = (size_t)HALF * nxt.ldb; } }
            const char* a1 = cA + (size_t)(t + 1) * kstep;
            const char* a2 = last ? nAp : cA + (size_t)(t + 2) * kstep; const char* b2 = last ? nBp : cB + (size_t)(t + 2) * kstep;
            const char* a3 = a2 + kstep; const char* b3 = b2 + kstep;
            const size_t h2 = last ? nhB : hB;
            PG8_LDB(B0, 0, 0); PG8_LDB(B1, 0, 1); PG8_SCHED; PG8_LDA(At, 0, 0); PG8_STAGE(PG8_SA(1, 1), a1, vA1);
            if (last && has_next) { PG8_TOKS(nxt, tk); PG8_OFFS(nxt, tk); }
            PG8_WAIT_V(8); PG8_WAIT_L(0); PG8_BAR; PG8_MMA(0, 0, At, B0); PG8_MMA(0, 1, At, B1); PG8_BAR; PG8_SCHED;
            PG8_LDA(At, 0, 1); PG8_STAGE(PG8_SB(0, 0), b2, vB); PG8_STAGE(PG8_SB(0, 1), b2 + h2, vB); PG8_STAGE(PG8_SA(0, 0), a2, vA0);
            PG8_WAIT_V(8); PG8_WAIT_L(0); PG8_BAR; PG8_MMA(1, 0, At, B0); PG8_MMA(1, 1, At, B1); PG8_BAR; PG8_SCHED;
            PG8_LDB(B0, 1, 0); PG8_LDB(B1, 1, 1); PG8_SCHED; PG8_LDA(At, 1, 0); PG8_STAGE(PG8_SA(0, 1), a2, vA1);
            PG8_WAIT_V(8); PG8_WAIT_L(0); PG8_BAR; PG8_MMA(0, 0, At, B0); PG8_MMA(0, 1, At, B1); PG8_BAR; PG8_SCHED;
            PG8_LDA(At, 1, 1); PG8_STAGE(PG8_SB(1, 0), b3, vB); PG8_STAGE(PG8_SB(1, 1), b3 + h2, vB); PG8_STAGE(PG8_SA(1, 0), a3, vA0);
            PG8_WAIT_V(8); PG8_WAIT_L(0); PG8_BAR; PG8_MMA(1, 0, At, B0); PG8_MMA(1, 1, At, B1); PG8_BAR; PG8_SCHED;
        }
        if (wr == 0) PG8_BAR;
        { const int tz = opaque_tid() & 63; E(acc, cur, wr, wc, tz & 15, tz >> 4); }
        if (!has_next) break;
        if (!cur.keep) {
#pragma unroll
            for (int a = 0; a < 2; ++a)
#pragma unroll
                for (int b = 0; b < 2; ++b)
#pragma unroll
                    for (int m = 0; m < 4; ++m)
#pragma unroll
                        for (int n = 0; n < 2; ++n) acc[a][b][m][n] = (f32x4){0.f, 0.f, 0.f, 0.f};
        }
        cur = nxt; cA = nAp; cB = nBp; hB = nhB; ++ui;
        if (wr == 1) PG8_BAR;
    }
    PG8_WAIT_V(0);
    PG8_BAR;
#undef PG8_SA
#undef PG8_SB
#undef PG8_STAGE
#undef PG8_LDA
#undef PG8_LDB
#undef PG8_MMA
#undef PG8_WAIT_V
#undef PG8_WAIT_L
#undef PG8_BAR
#undef PG8_SCHED
#undef PG8_OFFS
#undef PG8_TOKS
}
}
namespace gm {
struct SchedDense {
    const char* A; const char* B; unsigned lda, ldb; int nt, nM, nN, G, c, pn0;
    __device__ __forceinline__ bool next(int i, Unit& u) const {
        int pm, pn; if (!static_tile(i * G + c, nM, nN, pm, pn)) return false;
        u.A = A + (size_t)pm * BM * lda; u.B = B + (size_t)pn * BM * ldb; u.lda = lda; u.ldb = ldb; u.nt = nt; u.pm = pm; u.pn = pn + pn0; u.kind = 0; u.e = 0; u.rows = BM; u.keep = 0; return true;
    }
    static constexpr bool GATHER = false;
    __device__ __forceinline__ int tok(const Unit&, int) const { return 0; }
};
struct SchedMerge {
    const char* Af; const char* Bf; const char* Ar; const char* Br; int nM, nN, G, c;
    __device__ __forceinline__ bool next(int i, Unit& u) const {
        int pm, pn; if (!static_tile((i >> 1) * G + c, nM, nN, pm, pn)) return false;
        if ((i & 1) == 0) { u.lda = 1024 * 2; u.ldb = 1024 * 2; u.A = Af + (size_t)pm * BM * u.lda; u.B = Bf + (size_t)pn * BM * u.ldb; u.nt = 16; u.kind = 0; u.keep = 1; }
        else { u.lda = 2048 * 2; u.ldb = 2048 * 2; u.A = Ar + (size_t)pm * BM * u.lda; u.B = Br + (size_t)pn * BM * u.ldb; u.nt = 32; u.kind = 1; u.keep = 0; }
        u.pm = pm; u.pn = pn; u.e = 0; u.rows = BM; return true;
    }
    static constexpr bool GATHER = false;
    __device__ __forceinline__ int tok(const Unit&, int) const { return 0; }
};
template <bool GATHER_> struct SchedMoe {
    static constexpr bool GATHER = GATHER_;
    const LAS int* tab;
    const char* A; const char* W;
    const int* list;
    int NCT, G, c;
    __device__ __forceinline__ bool next(int i, Unit& u) const {
        const int L = i * G + c, ntile = __builtin_amdgcn_readfirstlane(tab[96]); if (L >= ntile * NCT) return false;
        const int rt = L / NCT, ct = L % NCT; const int ln = opaque_tid() & 63;
        const int tbv = tab[64 + (ln & 31)];
        const int e = __builtin_amdgcn_readfirstlane(__popcll(__ballot(ln >= 1 && ln < 32 && tbv <= rt)));
        const int tl = rt - __builtin_amdgcn_readfirstlane(tab[64 + e]), rows = __builtin_amdgcn_readfirstlane(tab[e]) - tl * BM;
        u.e = e; u.rows = rows < BM ? rows : BM; u.pn = ct; u.kind = 0; u.keep = 0;
        if (GATHER) { u.lda = 2048; u.ldb = 2048; u.nt = 16; u.A = A; u.B = W + ((size_t)e * 1024 + (size_t)ct * BM) * u.ldb; u.pm = tl; }
        else { u.lda = 512; u.ldb = 512; u.nt = 4; u.pm = __builtin_amdgcn_readfirstlane(tab[32 + e]) / BM + tl; u.A = A + (size_t)u.pm * BM * u.lda; u.B = W + ((size_t)e * 2048 + (size_t)ct * BM) * u.ldb; }
        return true;
    }
    __device__ __forceinline__ int tok(const Unit& u, int r) const { return (r < u.rows) ? list[u.e * 16384 + u.pm * BM + r] : 0; }
};

struct EpiProj {
    bf16_t* proj; const float* cosT; const float* sinT; float accs;
    __device__ __forceinline__ void operator()(const f32x4 (&acc)[2][2][4][2], const Unit& u, int wr, int wc, int fr, int fq) const {
        const int colt = u.pn * BM; const int row0 = u.pm * BM + wr * 64 + fr, col0 = colt + wc * 32 + 8 * fq;
        int kind; float sc = 1.f;
        if (colt < C_FK) { kind = 0; sc = QSCALE; } else if (colt < C_RQ) kind = 0; else if (colt < C_RV) { kind = 1; sc = (colt >= C_RK) ? KSCALE : 1.f; } else if (colt < C_RG) kind = 0; else if (colt < C_GF) kind = 2; else kind = 3;
        const int j0 = 16 * wc + 4 * fq;
#pragma unroll
        for (int ai = 0; ai < 2; ++ai)
#pragma unroll
            for (int m = 0; m < 4; ++m) { const int row = row0 + ai * HALF + m * 16; bf16_t* rowp = proj + (size_t)row * NPROJ + col0;
                f32x4 cs = (f32x4){1.f, 1.f, 1.f, 1.f}, sn = (f32x4){0.f, 0.f, 0.f, 0.f};
                if (kind == 1) { const int pos = row & (SEQ - 1); cs = *(const f32x4*)(cosT + pos * 64 + j0); sn = *(const f32x4*)(sinT + pos * 64 + j0); }
#pragma unroll
                for (int bj = 0; bj < 2; ++bj) { f32x4 v0 = acc[ai][bj][m][0] * accs, v1 = acc[ai][bj][m][1] * accs;
                    if (kind == 1) { const f32x4 y1 = v0 * cs - v1 * sn, y2 = v0 * sn + v1 * cs; v0 = y1 * sc; v1 = y2 * sc; }
                    else if (kind == 2) {
#pragma unroll
                        for (int j = 0; j < 4; ++j) { v0[j] = v0[j] * fast_sigmoid(v0[j]); v1[j] = v1[j] * fast_sigmoid(v1[j]); } }
                    else if (kind == 3) {
#pragma unroll
                        for (int j = 0; j < 4; ++j) { v0[j] = fast_sigmoid(v0[j]); v1[j] = fast_sigmoid(v1[j]); } }
                    else { v0 = v0 * sc; v1 = v1 * sc; }
                    u32x4 w; w.x = cvt_pk_bf16(v0[0], v0[1]); w.y = cvt_pk_bf16(v0[2], v0[3]); w.z = cvt_pk_bf16(v1[0], v1[1]); w.w = cvt_pk_bf16(v1[2], v1[3]);
                    *(u32x4*)(rowp + bj * HALF) = w; } }
    }
};
struct EpiMerge {
    const bf16_t* proj; bf16_t* mg;
    __device__ __forceinline__ void operator()(f32x4 (&acc)[2][2][4][2], const Unit& u, int wr, int wc, int fr, int fq) const {
        const int row0 = u.pm * BM + wr * 64 + fr, col0 = u.pn * BM + wc * 32 + 8 * fq;
#pragma unroll
        for (int ai = 0; ai < 2; ++ai)
#pragma unroll
            for (int m = 0; m < 4; ++m) { const int row = row0 + ai * HALF + m * 16; const bf16_t* pr = proj + (size_t)row * NPROJ + col0;
#pragma unroll
                for (int bj = 0; bj < 2; ++bj) {
                    const u32x4 gr = *(const u32x4*)(pr + C_GR + bj * HALF);
                    f32x4 r0 = (f32x4){bflo(gr.x), bfhi(gr.x), bflo(gr.y), bfhi(gr.y)}, r1 = (f32x4){bflo(gr.z), bfhi(gr.z), bflo(gr.w), bfhi(gr.w)};
                    if (u.kind == 0) { const u32x4 gf = *(const u32x4*)(pr + C_GF + bj * HALF);
                        const f32x4 f0 = (f32x4){bflo(gf.x), bfhi(gf.x), bflo(gf.y), bfhi(gf.y)}, f1 = (f32x4){bflo(gf.z), bfhi(gf.z), bflo(gf.w), bfhi(gf.w)};
#pragma unroll
                        for (int j = 0; j < 4; ++j) { acc[ai][bj][m][0][j] *= f0[j] * __builtin_amdgcn_rcpf(r0[j]); acc[ai][bj][m][1][j] *= f1[j] * __builtin_amdgcn_rcpf(r1[j]); } }
                    else { const f32x4 v0 = acc[ai][bj][m][0] * r0, v1 = acc[ai][bj][m][1] * r1;
                        u32x4 w; w.x = cvt_pk_bf16(v0[0], v0[1]); w.y = cvt_pk_bf16(v0[2], v0[3]); w.z = cvt_pk_bf16(v1[0], v1[1]); w.w = cvt_pk_bf16(v1[2], v1[3]);
                        *(u32x4*)(mg + (size_t)row * DM + col0 + bj * HALF) = w; } } }
    }
};
struct EpiOut {
    const float* hf; float* z1;
    __device__ __forceinline__ void operator()(const f32x4 (&acc)[2][2][4][2], const Unit& u, int wr, int wc, int fr, int fq) const {
        const int row0 = u.pm * BM + wr * 64 + fr, col0 = u.pn * BM + wc * 32 + 4 * fq;
#pragma unroll
        for (int ai = 0; ai < 2; ++ai)
#pragma unroll
            for (int m = 0; m < 4; ++m) { const size_t off = (size_t)(row0 + ai * HALF + m * 16) * DM + col0;
#pragma unroll
                for (int bj = 0; bj < 2; ++bj)
#pragma unroll
                    for (int n = 0; n < 2; ++n) { const f32x4 hv = *(const f32x4*)(hf + off + bj * HALF + n * 16); *(f32x4*)(z1 + off + bj * HALF + n * 16) = hv * ALPHA + acc[ai][bj][m][n]; }
                asm volatile("" ::: "memory"); }
    }
};
struct EpiMoe1 {
    unsigned char* hid; const float* wlist; const LAS int* tab;
    __device__ __forceinline__ void operator()(const f32x4 (&acc)[2][2][4][2], const Unit& u, int wr, int wc, int fr, int fq) const {
        const int r0 = wr * 64 + fr, hc0 = u.pn * 128 + wc * 16 + 4 * fq; const int slot0 = __builtin_amdgcn_readfirstlane(tab[32 + u.e]) + u.pm * BM;
#pragma unroll
        for (int ai = 0; ai < 2; ++ai)
#pragma unroll
            for (int m = 0; m < 4; ++m) { const int r = r0 + ai * HALF + m * 16; if (r < u.rows) {
                const float w = wlist[u.e * 16384 + u.pm * BM + r] * HID8_SCALE; unsigned char* rowp = hid + (size_t)(slot0 + r) * DEXP + hc0;
#pragma unroll
                for (int bj = 0; bj < 2; ++bj) { const f32x4 g = acc[ai][bj][m][0] * (1.f / W8_SCALE), up = acc[ai][bj][m][1] * (1.f / W8_SCALE); f32x4 h;
#pragma unroll
                    for (int j = 0; j < 4; ++j) h[j] = g[j] * fast_sigmoid(g[j]) * up[j] * w;
                    *(unsigned*)(rowp + bj * 64) = pk4_fp8(h[0], h[1], h[2], h[3]); } } }
    }
};
struct EpiMoe2 {
    bf16_t* ffo;
    __device__ __forceinline__ void operator()(const f32x4 (&acc)[2][2][4][2], const Unit& u, int wr, int wc, int fr, int fq) const {
        const int r0 = wr * 64 + fr, col0 = u.pn * BM + wc * 32 + 8 * fq;
#pragma unroll
        for (int ai = 0; ai < 2; ++ai)
#pragma unroll
            for (int m = 0; m < 4; ++m) { const int r = r0 + ai * HALF + m * 16; if (r < u.rows) { bf16_t* rowp = ffo + (size_t)(u.pm * BM + r) * DM + col0;
#pragma unroll
                for (int bj = 0; bj < 2; ++bj) { const f32x4 v0 = acc[ai][bj][m][0] * (1.f / (W8_SCALE * HID8_SCALE)), v1 = acc[ai][bj][m][1] * (1.f / (W8_SCALE * HID8_SCALE));
                    u32x4 w; w.x = cvt_pk_bf16(v0[0], v0[1]); w.y = cvt_pk_bf16(v0[2], v0[3]); w.z = cvt_pk_bf16(v1[0], v1[1]); w.w = cvt_pk_bf16(v1[2], v1[3]);
                    *(u32x4*)(rowp + bj * HALF) = w; } } }
    }
};
}
#define XB_TMO      128
#define XB_XCNT(j)  (256  + 64 * (j))
#define XB_XSUB(j)  (1280 + 64 * (j))
#define XB_XGEN(j)  (2304 + 64 * (j))
#define XB_TOP      3328
#define XB_TOPGEN   3392
#define XCD_BAR_WORDS 3456
#define XB_SPIN_CAP (1u << 18)
__device__ __forceinline__ unsigned xb_ld(unsigned* p)              { return __hip_atomic_load(p, __ATOMIC_RELAXED, __HIP_MEMORY_SCOPE_AGENT); }
__device__ __forceinline__ unsigned xb_add(unsigned* p, unsigned v) { return __hip_atomic_fetch_add(p, v, __ATOMIC_RELAXED, __HIP_MEMORY_SCOPE_AGENT); }
__device__ __forceinline__ unsigned xb_xcc_id() { return (unsigned)__builtin_amdgcn_s_getreg((3 << 11) | 20) & 0xFu; }
#define XB_SPIN(cond, bar) do { unsigned _sp = 0; while (cond) { __builtin_amdgcn_s_sleep(1); \
    if ((++_sp & 255u) == 0u) { if (xb_ld(&(bar)[XB_TMO])) break; if (_sp > XB_SPIN_CAP) { atomicAdd(&(bar)[XB_TMO], 1u); break; } } } } while (0)
struct XcdBarrier { unsigned* bar; unsigned x; volatile LAS unsigned* st; };
__device__ __forceinline__ XcdBarrier xcd_barrier_post(unsigned* bar, volatile LAS unsigned* st) {
    XcdBarrier b; b.bar = bar; b.x = xb_xcc_id(); b.st = st;
    if (threadIdx.x == 0) (void)xb_add(&bar[XB_XCNT(b.x)], 1u);
    return b;
}
__device__ __forceinline__ void xcd_barrier_complete(unsigned* bar, unsigned x, unsigned& nloc, unsigned& nx) {
    const unsigned G = gridDim.x * gridDim.y * gridDim.z;
    unsigned sum, cnt, mine, sp = 0u;
    for (;;) {
        sum = 0u; cnt = 0u; mine = 0u;
#pragma unroll
        for (unsigned j = 0; j < 16; ++j) { const unsigned c = xb_ld(&bar[XB_XCNT(j)]); sum += c; cnt += (c > 0u) ? 1u : 0u; mine = (j == x) ? c : mine; }
        if (sum == G) break;
        __builtin_amdgcn_s_sleep(1);
        if ((++sp & 255u) == 0u) { if (xb_ld(&bar[XB_TMO])) break; if (sp > XB_SPIN_CAP) { atomicAdd(&bar[XB_TMO], 1u); break; } }
    }
    nloc = mine > 0u ? mine : 1u; nx = cnt > 0u ? cnt : 1u;
}
__device__ __forceinline__ void xcd_barrier(const XcdBarrier& b) {
    asm volatile("s_waitcnt vmcnt(0)" ::: "memory");
    __syncthreads();
    if (threadIdx.x == 0) {
        unsigned* bar = b.bar;
        __builtin_amdgcn_s_waitcnt(0);
        unsigned nloc = b.st[0], nx = b.st[1];
        if (nloc == 0u) { xcd_barrier_complete(bar, b.x, nloc, nx); b.st[0] = nloc; b.st[1] = nx; }
        const unsigned old = xb_add(&bar[XB_XSUB(b.x)], 1u);
        const unsigned gen = old / nloc;
        if (old + 1u == (gen + 1u) * nloc) {
            __builtin_amdgcn_fence(__ATOMIC_RELEASE, "agent");
            asm volatile("s_waitcnt vmcnt(0)" ::: "memory");
            const unsigned og = xb_add(&bar[XB_TOP], 1u);
            const unsigned tg = og / nx;
            if (og + 1u == (tg + 1u) * nx) xb_add(&bar[XB_TOPGEN], 1u);
            else XB_SPIN(xb_ld(&bar[XB_TOPGEN]) == tg, bar);
            __builtin_amdgcn_fence(__ATOMIC_ACQUIRE, "agent");
            xb_add(&bar[XB_XGEN(b.x)], 1u);
            asm volatile("s_waitcnt vmcnt(0)" ::: "memory");
        } else {
            XB_SPIN(xb_ld(&bar[XB_XGEN(b.x)]) == gen, bar);
            __builtin_amdgcn_fence(__ATOMIC_ACQUIRE, "agent");
            asm volatile("s_waitcnt vmcnt(0)" ::: "memory");
        }
    }
    __syncthreads();
}

constexpr int NWAVES = 8;
struct Frame {
    LAS unsigned char* lds; volatile LAS unsigned* MISC; gu32* ctl;
    int tid, lane, wave, G, bx;
    unsigned char* ws;
    float* out;
};
#define INP(i) ((const float*)(const GAS float*)(((const float* const*)__builtin_amdgcn_kernarg_segment_ptr())[i]))
#define KWS() ((unsigned char*)(GAS unsigned char*)(((unsigned char* const*)__builtin_amdgcn_kernarg_segment_ptr())[20]))
__device__ __forceinline__ float wave_sum(float v) {
#pragma unroll
    for (int o = 1; o < 64; o <<= 1) v += __shfl_xor(v, o);
    return v;
}

__device__ __forceinline__ void p0_transpose_item(const float* colp, size_t pitch, bf16_t* WT, int K, int n0, int k0, LAS float* scr, int lane) {
    float tv[32];
#pragma unroll
    for (int i = 0; i < 32; ++i) { const int kk = 2 * i + (lane >> 5); tv[i] = colp[(size_t)(k0 + kk) * pitch]; }
#pragma unroll
    for (int i = 0; i < 32; ++i) { const int kk = 2 * i + (lane >> 5); scr[kk * 33 + (lane & 31)] = tv[i]; }
    LDS_WAIT(); asm volatile("" ::: "memory");
    const int c = lane & 7;
#pragma unroll
    for (int j = 0; j < 4; ++j) { const int n = (lane >> 3) + 8 * j; const LAS float* s = scr + (8 * c) * 33 + n;
        u32x4 o; o.x = pk2(s[0 * 33], s[1 * 33]); o.y = pk2(s[2 * 33], s[3 * 33]); o.z = pk2(s[4 * 33], s[5 * 33]); o.w = pk2(s[6 * 33], s[7 * 33]);
        *(GAS u32x4*)(WT + (size_t)(n0 + n) * K + k0 + 8 * c) = o; }
    LDS_WAIT(); asm volatile("" ::: "memory");
}
__device__ __forceinline__ void p0_transpose_item8(const float* colp, size_t pitch, unsigned char* WT8, int K, int n0, int k0, float scale, LAS float* scr, int lane) {
    float tv[32];
#pragma unroll
    for (int i = 0; i < 32; ++i) { const int kk = 2 * i + (lane >> 5); tv[i] = colp[(size_t)(k0 + kk) * pitch]; }
#pragma unroll
    for (int i = 0; i < 32; ++i) { const int kk = 2 * i + (lane >> 5); scr[kk * 33 + (lane & 31)] = tv[i] * scale; }
    LDS_WAIT(); asm volatile("" ::: "memory");
    const int c = lane & 7;
#pragma unroll
    for (int j = 0; j < 4; ++j) { const int n = (lane >> 3) + 8 * j; const LAS float* s = scr + (8 * c) * 33 + n;
        u32x2 o; o.x = pk4_fp8(s[0 * 33], s[1 * 33], s[2 * 33], s[3 * 33]); o.y = pk4_fp8(s[4 * 33], s[5 * 33], s[6 * 33], s[7 * 33]);
        *(GAS u32x2*)(WT8 + (size_t)(n0 + n) * K + k0 + 8 * c) = o; }
    LDS_WAIT(); asm volatile("" ::: "memory");
}
__device__ __forceinline__ int win_srccol(int n) {
    if (n < C_RQ) return n;
    if (n < C_RV) { const int hh = (n - C_RQ) >> 7, p = (n - C_RQ) & 127; return 3080 + hh * 128 + 4 * (p >> 3) + (p & 3) + 64 * ((p >> 2) & 1); }
    return n + 8;
}
constexpr int IT_WIN = 32 * 416, IT_BF = 16 * 64, IT_BR = 32 * 64, IT_OUT = 32 * 64, IT_GU = 32 * 32 * 32, IT_D = 32 * 8 * 64, IT_LAYER = IT_WIN + IT_BF + IT_BR + IT_OUT + IT_GU + IT_D;
__device__ __forceinline__ void p0_weights(Frame& F, int l) {
    LAS float* scr = (LAS float*)(F.lds + F.wave * 16384);
    const int gw = F.bx * NWAVES + F.wave, NGW = F.G * NWAVES, lane = F.lane, nl = lane & 31;
    for (int it = gw; it < IT_LAYER; it += NGW) {
        int r = it; unsigned char* wl = F.ws + WS_W;
        if (r < IT_WIN) { const int kb = r / 416, nb = r % 416; const float* src = INP(3) + (size_t)l * DM * W_IN_COLS + win_srccol(32 * nb + nl);
            if (32 * nb < N_BF16_TILES * 256) p0_transpose_item(src, W_IN_COLS, (bf16_t*)(wl + WL_WIN), 2048, 32 * nb, 64 * kb, scr, lane);
            else p0_transpose_item8(src, W_IN_COLS, wl + WL_WIN8, 2048, 32 * nb - N_BF16_TILES * 256, 64 * kb, W8_SCALE, scr, lane);
            continue; } r -= IT_WIN;
        if (r < IT_BF) { const int kb = r / 64, nb = r % 64; p0_transpose_item(INP(5) + (size_t)l * 1024 * DM + 32 * nb + nl, DM, (bf16_t*)(wl + WL_WBF), 1024, 32 * nb, 64 * kb, scr, lane); continue; } r -= IT_BF;
        if (r < IT_BR) { const int kb = r / 64, nb = r % 64; p0_transpose_item(INP(6) + (size_t)l * 2048 * DM + 32 * nb + nl, DM, (bf16_t*)(wl + WL_WBR), 2048, 32 * nb, 64 * kb, scr, lane); continue; } r -= IT_BR;
        if (r < IT_OUT) { const int kb = r / 64, nb = r % 64; p0_transpose_item(INP(7) + (size_t)l * 2048 * DM + 32 * nb + nl, DM, (bf16_t*)(wl + WL_WOUT), 2048, 32 * nb, 64 * kb, scr, lane); continue; } r -= IT_OUT;
        if (r < IT_GU) { const int e = r / 1024, q = r % 1024, kb = q / 32, nb = q % 32; const int row = 32 * nb + nl, col = 4 * (row >> 3) + (row & 3);
            const float* src = (((row >> 2) & 1) ? INP(15) : INP(14)) + (size_t)(l * NEXP + e) * DM * DEXP + col;
            p0_transpose_item8(src, DEXP, wl + WL_WGU + (size_t)e * 1024 * 2048, 2048, 32 * nb, 64 * kb, W8_SCALE, scr, lane); continue; } r -= IT_GU;
        { const int e = r / 512, q = r % 512, kb = q / 64, nb = q % 64;
            p0_transpose_item8(INP(16) + (size_t)(l * NEXP + e) * DEXP * DM + 32 * nb + nl, DM, wl + WL_WD + (size_t)e * 2048 * 512, 512, 32 * nb, 64 * kb, W8_SCALE, scr, lane); }
    }
}
__device__ __forceinline__ void p0_tables(Frame& F) {
    const int gw = F.bx * NWAVES + F.wave, NGW = F.G * NWAVES, lane = F.lane;
    { float* cosT = (float*)(F.ws + WS_ROPE); float* sinT = cosT + SEQ * 64;
      for (int i = (F.bx * NWAVES + F.wave) * 64 + lane; i < SEQ * 64; i += NGW * 64) { const int pos = i >> 6, j = i & 63;
          double pw = 1.0; for (int t = 0; t < j; ++t) pw *= 0.8659643233600653;
          const float inv = (float)pw; const double ang = (double)((float)pos * inv);
          const double qd = __builtin_rint(ang * 0.6366197723675814); const double r = ang - qd * 1.5707963267948966, r2 = r * r; const int qi = (int)qd & 3;
          const double sr = r * (1.0 + r2 * (-1.0 / 6 + r2 * (1.0 / 120 + r2 * (-1.0 / 5040 + r2 * (1.0 / 362880 + r2 * (-1.0 / 39916800))))));
          const double cr = 1.0 + r2 * (-0.5 + r2 * (1.0 / 24 + r2 * (-1.0 / 720 + r2 * (1.0 / 40320 + r2 * (-1.0 / 3628800 + r2 * (1.0 / 479001600))))));
          const double sv = (qi == 0) ? sr : (qi == 1) ? cr : (qi == 2) ? -sr : -cr, cv = (qi == 0) ? cr : (qi == 1) ? -sr : (qi == 2) ? -cr : sr;
          cosT[i] = (float)cv; sinT[i] = (float)sv; } }
    for (int job = gw; job < 2 * 16 + 2 * 48; job += NGW) {
        int t, c; if (job < 32) { t = job >> 4; c = job & 15; } else { t = 2 + (job - 32) / 48; c = (job - 32) % 48; }
        const int l = t & 1; const float *g, *b; const float* W = nullptr; size_t pitch = 0;
        if (t < 2) { g = l ? INP(17) : INP(1); b = l ? INP(18) : INP(2); if (c < 8) { W = INP(3) + (size_t)l * DM * W_IN_COLS + 3072 + c; pitch = W_IN_COLS; } }
        else { g = INP(8) + l * DM; b = INP(9) + l * DM; if (c < 4) { W = INP(10) + (size_t)l * DM * 4 + c; pitch = 4; } else if (c < 36) { W = INP(12) + (size_t)l * DM * 32 + (c - 4); pitch = 32; } }
        bf16_t* hi = (bf16_t*)(F.ws + WS_SKW + (t < 2 ? (size_t)t * SKW_FGT_BYTES : 2 * SKW_FGT_BYTES + (size_t)(t - 2) * SKW_RTR_BYTES)); const int ncol = t < 2 ? 16 : 48; bf16_t* lo = hi + ncol * 2048;
        float s1 = 0.f, s2 = 0.f;
        for (int k = lane; k < DM; k += 64) { const float w = W ? W[(size_t)k * pitch] : 0.f; const float gw_ = g[k] * w; const unsigned h16 = f2bf(gw_); const float hf_ = __builtin_bit_cast(float, h16 << 16); const unsigned l16 = f2bf(gw_ - hf_);
            hi[c * 2048 + k] = (bf16_t)h16; lo[c * 2048 + k] = (bf16_t)l16; s1 += hf_ + __builtin_bit_cast(float, l16 << 16); s2 += b[k] * w; }
        s1 = wave_sum(s1); s2 = wave_sum(s2);
        if (lane == 0) { float* S = (float*)(F.ws + WS_SKS + (size_t)t * 512); S[c] = s1; S[64 + c] = s2; }
    }
}
struct LnArgs {
    const float* zin;
    float* hf; bf16_t* hb;
    unsigned char* h8;
    const float* g; const float* b;
    const bf16_t* whi; const bf16_t* wlo; const float* S12;
    const bf16_t* ffo; const int* route;
    const LAS int* tab;
    const float* bfor; float* logf;
    const float* brg; const float* bre; int* route_out; int* list; float* wlist; unsigned* cnt;
};
template <int MODE, int NCG, bool PROJ>
__device__ __forceinline__ void ln_pass(Frame& F, const LnArgs& a) {
    const int lane = F.lane, w = F.wave, r = lane & 15, q = lane >> 4, tid = F.tid;
    LAS float* red = (LAS float*)(F.lds + LNS_OFF);
    LAS float* part = (LAS float*)(F.lds + LNS_OFF + 1024);
    LAS float* lg = (LAS float*)(F.lds + LNS_OFF + 1024 + 24576);
    LAS unsigned char* stash = F.lds + w * 16384;
#define LN_ISSUE(g_) do { const int row_ = (g_) * 16 + r; const int kb_ = 256 * w + 8 * q; \
        if (MODE == 2) { const int4 rt = *(const int4*)(a.route + row_ * 4); \
            const size_t sa = (size_t)(a.tab[32 + rt.x] + rt.y), sb = (size_t)(a.tab[32 + rt.z] + rt.w); \
            const bf16_t* pa = a.ffo + sa * DM + kb_; const bf16_t* pb = a.ffo + sb * DM + kb_; \
            _Pragma("unroll") for (int s = 0; s < 8; ++s) { __builtin_amdgcn_global_load_lds((const unsigned*)(pa + 32 * s), (LAS unsigned*)(stash + (2 * s) * 1024), 16, 0, 0); \
                __builtin_amdgcn_global_load_lds((const unsigned*)(pb + 32 * s), (LAS unsigned*)(stash + (2 * s + 1) * 1024), 16, 0, 0); } } \
        else { const float* zp_ = a.zin + (size_t)row_ * DM + kb_; \
            _Pragma("unroll") for (int s = 0; s < 8; ++s) { __builtin_amdgcn_global_load_lds((const unsigned*)(zp_ + 32 * s), (LAS unsigned*)(stash + (2 * s) * 1024), 16, 0, 0); \
                __builtin_amdgcn_global_load_lds((const unsigned*)(zp_ + 32 * s + 4), (LAS unsigned*)(stash + (2 * s + 1) * 1024), 16, 0, 0); } } } while (0)
    const int kb = 256 * w + 8 * q;
    unsigned gq[8][2][4];
#define LN_GLOAD() do { _Pragma("unroll") for (int s = 0; s < 8; ++s) _Pragma("unroll") for (int hh = 0; hh < 2; ++hh) { \
            const f32x4 gv = *(const f32x4*)(a.g + kb + 32 * s + 4 * hh), bv = *(const f32x4*)(a.b + kb + 32 * s + 4 * hh); \
            gq[s][hh][0] = __builtin_bit_cast(unsigned, __builtin_amdgcn_cvt_pkrtz(gv[0] - 1.f, gv[1] - 1.f)); gq[s][hh][1] = __builtin_bit_cast(unsigned, __builtin_amdgcn_cvt_pkrtz(gv[2] - 1.f, gv[3] - 1.f)); \
            gq[s][hh][2] = __builtin_bit_cast(unsigned, __builtin_amdgcn_cvt_pkrtz(bv[0], bv[1])); gq[s][hh][3] = __builtin_bit_cast(unsigned, __builtin_amdgcn_cvt_pkrtz(bv[2], bv[3])); } } while (0)
    constexpr bool GRES = (MODE != 1);
    if (GRES) LN_GLOAD();
    typedef _Float16 h16x2 __attribute__((ext_vector_type(2)));
#define LN_UNPK(dst, s_, hh_, i_) do { unsigned u0_ = gq[s_][hh_][i_], u1_ = gq[s_][hh_][(i_) + 1]; asm volatile("" : "+v"(u0_), "+v"(u1_)); const h16x2 h0_ = __builtin_bit_cast(h16x2, u0_), h1_ = __builtin_bit_cast(h16x2, u1_); \
        dst = (f32x4){(float)h0_[0], (float)h0_[1], (float)h1_[0], (float)h1_[1]}; } while (0)
    LAS float* tb = (LAS float*)(F.lds + LNS_OFF + 1024 + 24576 + 3072);
    float s1a = 0.f, s2a = 0.f, s1b = 0.f, s2b = 0.f;
    if (PROJ) {
        if (MODE != 1) { if (tid < 8) tb[tid] = a.bfor[tid]; } else { if (tid < 4) tb[16 + tid] = a.brg[tid]; if (tid >= 32 && tid < 64) tb[tid] = a.bre[tid - 32]; }
        if (tid < 16 * 16 * NCG) { const int cc = tid % (16 * NCG); s1a = a.S12[cc]; s2a = a.S12[64 + cc]; }
        if (tid + NWAVES * 64 < 16 * 16 * NCG) { const int cc = (tid + NWAVES * 64) % (16 * NCG); s1b = a.S12[cc]; s2b = a.S12[64 + cc]; }
    }
    asm volatile("s_waitcnt vmcnt(0)" ::: "memory");
    if (F.bx < NTOK / 16) LN_ISSUE(F.bx);
    for (int gi = F.bx; gi < NTOK / 16; gi += F.G) {
        const int row = gi * 16 + r;
        f32x4 z[8][2];
        if (MODE == 2) {
            f32x4 rh[8][2];
            { const float* zp_ = a.zin + (size_t)row * DM + kb;
#pragma unroll
              for (int s = 0; s < 8; ++s) { rh[s][0] = *(const f32x4*)(zp_ + 32 * s); rh[s][1] = *(const f32x4*)(zp_ + 32 * s + 4); } }
            asm volatile("s_waitcnt vmcnt(0)" ::: "memory");
#pragma unroll
            for (int s = 0; s < 8; ++s) { const u32x4 ua = *(const LAS u32x4*)(stash + (2 * s) * 1024 + lane * 16), ub = *(const LAS u32x4*)(stash + (2 * s + 1) * 1024 + lane * 16);
                z[s][0] = rh[s][0] * ALPHA + ((f32x4){bflo(ua.x), bfhi(ua.x), bflo(ua.y), bfhi(ua.y)} + (f32x4){bflo(ub.x), bfhi(ub.x), bflo(ub.y), bfhi(ub.y)});
                z[s][1] = rh[s][1] * ALPHA + ((f32x4){bflo(ua.z), bfhi(ua.z), bflo(ua.w), bfhi(ua.w)} + (f32x4){bflo(ub.z), bfhi(ub.z), bflo(ub.w), bfhi(ub.w)}); }
        } else {
            asm volatile("s_waitcnt vmcnt(0)" ::: "memory");
#pragma unroll
            for (int s = 0; s < 8; ++s) { z[s][0] = *(const LAS f32x4*)(stash + (2 * s) * 1024 + lane * 16); z[s][1] = *(const LAS f32x4*)(stash + (2 * s + 1) * 1024 + lane * 16); }
        }
        LDS_WAIT();
        float sm = 0.f, sq = 0.f;
#pragma unroll
        for (int s = 0; s < 8; ++s)
#pragma unroll
            for (int hh = 0; hh < 2; ++hh)
#pragma unroll
                for (int j = 0; j < 4; ++j) { const float v = z[s][hh][j]; sm += v; sq += v * v; }
        sm += __shfl_xor(sm, 16); sm += __shfl_xor(sm, 32); sq += __shfl_xor(sq, 16); sq += __shfl_xor(sq, 32);
        if (q == 0) { red[(w * 16 + r) * 2] = sm; red[(w * 16 + r) * 2 + 1] = sq; }
        if (PROJ) {
            f32x4 acc[NCG];
#pragma unroll
            for (int cg = 0; cg < NCG; ++cg) acc[cg] = (f32x4){0.f, 0.f, 0.f, 0.f};
            bf16x8 bh[2], bl[2];
            unsigned wof[NCG];
#pragma unroll
            for (int cg = 0; cg < NCG; ++cg) { wof[cg] = (unsigned)((16 * cg + r) * DM + kb) * 2u; asm volatile("" : "+v"(wof[cg])); }
#define LN_WLOAD(i_, bf_) do { const int cg_ = (i_) % NCG, s_ = (i_) / NCG; bh[bf_] = *(const bf16x8*)((const char*)a.whi + wof[cg_] + 64 * s_); bl[bf_] = *(const bf16x8*)((const char*)a.wlo + wof[cg_] + 64 * s_); } while (0)
            LN_WLOAD(0, 0);
#pragma unroll
            for (int i = 0; i < 8 * NCG; ++i) { const int cg = i % NCG, s = i / NCG;
                asm volatile("" ::: "memory");
                if (i + 1 < 8 * NCG) LN_WLOAD(i + 1, (i + 1) & 1);
                asm volatile("" ::: "memory");
                u32x4 hi, lo;
                { const f32x4 v0 = z[s][0], v1 = z[s][1];
                  hi.x = cvt_pk_bf16(v0[0], v0[1]); hi.y = cvt_pk_bf16(v0[2], v0[3]); hi.z = cvt_pk_bf16(v1[0], v1[1]); hi.w = cvt_pk_bf16(v1[2], v1[3]);
                  lo.x = cvt_pk_bf16(v0[0] - bflo(hi.x), v0[1] - bfhi(hi.x)); lo.y = cvt_pk_bf16(v0[2] - bflo(hi.y), v0[3] - bfhi(hi.y));
                  lo.z = cvt_pk_bf16(v1[0] - bflo(hi.z), v1[1] - bfhi(hi.z)); lo.w = cvt_pk_bf16(v1[2] - bflo(hi.w), v1[3] - bfhi(hi.w)); }
                const bf16x8 ahi = __builtin_bit_cast(bf16x8, hi), alo = __builtin_bit_cast(bf16x8, lo);
                const bf16x8 wh = bh[i & 1], wl_ = bl[i & 1];
                acc[cg] = __builtin_amdgcn_mfma_f32_16x16x32_bf16(ahi, wh, acc[cg], 0, 0, 0);
                acc[cg] = __builtin_amdgcn_mfma_f32_16x16x32_bf16(alo, wh, acc[cg], 0, 0, 0);
                acc[cg] = __builtin_amdgcn_mfma_f32_16x16x32_bf16(ahi, wl_, acc[cg], 0, 0, 0);
            }
#undef LN_WLOAD
#pragma unroll
            for (int cg = 0; cg < NCG; ++cg)
#pragma unroll
                for (int j = 0; j < 4; ++j) part[(w * 16 + 4 * q + j) * 48 + 16 * cg + r] = acc[cg][j];
        }
        asm volatile("" ::: "memory");
        if (!GRES) { LN_GLOAD(); asm volatile("" ::: "memory"); }
        if (gi + F.G < NTOK / 16) LN_ISSUE(gi + F.G);
        asm volatile("" ::: "memory");
        LDS_WAIT(); __syncthreads();
        float mean, rstd;
        { float ts = 0.f, tq = 0.f;
#pragma unroll
          for (int ww = 0; ww < 8; ++ww) { ts += red[(ww * 16 + r) * 2]; tq += red[(ww * 16 + r) * 2 + 1]; }
          mean = ts * (1.0f / DM); const float var = tq * (1.0f / DM) - mean * mean; rstd = 1.0f / sqrtf(fmaxf(var, 0.f) + LN_EPS); }
        { float* op = a.hf + (size_t)row * DM + kb; bf16_t* ob = a.hb ? a.hb + (size_t)row * DM + kb : nullptr;
#pragma unroll
          for (int s = 0; s < 8; ++s) {
              f32x4 dg0, dg1, bb0, bb1; LN_UNPK(dg0, s, 0, 0); LN_UNPK(dg1, s, 1, 0); LN_UNPK(bb0, s, 0, 2); LN_UNPK(bb1, s, 1, 2);
              const f32x4 n0 = (z[s][0] - mean) * rstd, n1 = (z[s][1] - mean) * rstd; const f32x4 y0 = n0 + n0 * dg0 + bb0, y1 = n1 + n1 * dg1 + bb1;
              *(f32x4*)(op + 32 * s) = y0; *(f32x4*)(op + 32 * s + 4) = y1;
              if (ob) { u32x4 o; o.x = cvt_pk_bf16(y0[0], y0[1]); o.y = cvt_pk_bf16(y0[2], y0[3]); o.z = cvt_pk_bf16(y1[0], y1[1]); o.w = cvt_pk_bf16(y1[2], y1[3]); *(u32x4*)(ob + 32 * s) = o; }
              if (a.h8) { u32x2 o8; o8.x = pk4_fp8(y0[0], y0[1], y0[2], y0[3]); o8.y = pk4_fp8(y1[0], y1[1], y1[2], y1[3]); *(u32x2*)(a.h8 + (size_t)row * DM + kb + 32 * s) = o8; } } }
        if (PROJ) {
#define LN_LOGIT(t_, s1_, s2_) do { const int t = (t_); if (t < 16 * 16 * NCG) { const int rr = t / (16 * NCG), cc = t % (16 * NCG); float ts = 0.f, tq = 0.f, ps = 0.f; \
                _Pragma("unroll") for (int ww = 0; ww < 8; ++ww) { ts += red[(ww * 16 + rr) * 2]; tq += red[(ww * 16 + rr) * 2 + 1]; ps += part[(ww * 16 + rr) * 48 + cc]; } \
                const float mr = ts * (1.0f / DM), vr = tq * (1.0f / DM) - mr * mr, rs = 1.0f / sqrtf(fmaxf(vr, 0.f) + LN_EPS); \
                lg[rr * 48 + cc] = rs * (ps - mr * (s1_)) + (s2_); } } while (0)
            LN_LOGIT(tid, s1a, s2a); if (16 * 16 * NCG > NWAVES * 64) LN_LOGIT(tid + NWAVES * 64, s1b, s2b);
#undef LN_LOGIT
            LDS_WAIT(); __syncthreads();
            if (tid < 16) {
                const int tok = gi * 16 + tid; const LAS float* L = lg + tid * 48;
                if (MODE != 1) {
                    const int bb = tok / SEQ, ss = tok % SEQ;
#pragma unroll
                    for (int hh = 0; hh < 8; ++hh) { const float xv = L[hh] + tb[hh]; const float lsg = fminf(xv, 0.f) - log1pf(expf(-fabsf(xv))); a.logf[((size_t)bb * 8 + hh) * SEQ + ss] = lsg; }
                } else {
                    float gl[4]; float gmax = -3.0e38f; int gi_ = 0;
#pragma unroll
                    for (int j = 0; j < 4; ++j) { gl[j] = L[j] + tb[16 + j]; if (gl[j] > gmax) { gmax = gl[j]; gi_ = j; } }
                    float den = 0.f;
#pragma unroll
                    for (int j = 0; j < 4; ++j) den += expf(gl[j] - gmax);
                    const float grp_w = 1.0f / den;
                    float e1 = -3.0e38f, e2 = -3.0e38f; int i1 = 0, i2 = 0;
#pragma unroll
                    for (int j = 0; j < 8; ++j) { const float v = L[4 + 8 * gi_ + j] + tb[32 + 8 * gi_ + j];
                        if (v > e1) { e2 = e1; i2 = i1; e1 = v; i1 = j; } else if (v > e2) { e2 = v; i2 = j; } }
                    const float t2 = expf(e2 - e1), w1 = grp_w / (1.0f + t2), w2 = grp_w * t2 / (1.0f + t2);
                    const int x1 = 8 * gi_ + i1, x2 = 8 * gi_ + i2;
                    const int p1 = (int)__hip_atomic_fetch_add(a.cnt + 64 * x1, 1u, RLX_AGENT), p2 = (int)__hip_atomic_fetch_add(a.cnt + 64 * x2, 1u, RLX_AGENT);
                    a.list[x1 * 16384 + p1] = tok; a.wlist[x1 * 16384 + p1] = w1; a.list[x2 * 16384 + p2] = tok; a.wlist[x2 * 16384 + p2] = w2;
                    *(int4*)(a.route_out + tok * 4) = make_int4(x1, p1, x2, p2);
                }
            }
        }
        __syncthreads();
    }
#undef LN_ISSUE
#undef LN_UNPK
#undef LN_GLOAD
}
namespace fox {
constexpr int D = 128, NW = 8, QBLK = 32, KVBLK = 64, QB = NW * QBLK;
constexpr int SHM_V = KVBLK * D * 2, SHM_K = KVBLK * D * 2;
constexpr int OFF_WS = 2 * SHM_V + 2 * SHM_K, OFF_BIAS = OFF_WS + NW * 64 * 4, LDS_BYTES = OFF_BIAS + SEQ * 4;
constexpr float THR = 8.f, LN2 = 0.6931471805599453f;
#define KSWZ(row, colB) ((row) * 256 + ((colB) ^ (((row) & 7) << 4)))
__device__ __forceinline__ int v_st(int k, int c) { const int kk = (k & ~0xC) | ((k & 4) << 1) | ((k & 8) >> 1); return ((kk >> 3) * 4 + (c >> 5)) * 512 + ((kk & 7) * 32 + (c & 31)) * 2; }
__device__ __forceinline__ int v_rd_base(int lane) { return ((lane & 3) << 3) | (((lane >> 2) & 3) << 6) | (((lane >> 4) & 1) << 5) | (((lane >> 5) & 1) << 8); }
constexpr int v_rd_off(int d0, int ks, int half) { return d0 * 512 + ks * 4096 + half * 2048; }
__device__ __forceinline__ int crow(int r, int hi) { return (r & 3) + 8 * (r >> 2) + 4 * hi; }
__device__ __forceinline__ void mask_tile(f32x16& p0, f32x16& p1, int dq) {
    const float NEG = -__builtin_inff();
#pragma unroll
    for (int r = 0; r < 16; ++r) { const int c = (r & 3) + 8 * (r >> 2); if (dq - c < 0) p0[r] = NEG; if (dq - c - 32 < 0) p1[r] = NEG; }
}
__device__ __forceinline__ void partialSM(f32x16& p0, f32x16& p1, float& m_reg, float& mn, float& alpha) {
    float pmax = p0[0];
#pragma unroll
    for (int r = 1; r < 16; ++r) pmax = fmaxf(pmax, p0[r]);
#pragma unroll
    for (int r = 0; r < 16; ++r) pmax = fmaxf(pmax, p1[r]);
    { auto rr = __builtin_amdgcn_permlane32_swap(__float_as_uint(pmax), __float_as_uint(pmax), false, false); pmax = fmaxf(__uint_as_float(rr[0]), __uint_as_float(rr[1])); }
    if (__builtin_expect(__all((pmax - m_reg) * LN2 <= THR), 1)) { mn = m_reg; alpha = 1.f; }
    else { mn = fmaxf(m_reg, pmax); alpha = __builtin_amdgcn_exp2f(m_reg - mn); m_reg = mn; }
#pragma unroll
    for (int r = 0; r < 16; ++r) p0[r] = p0[r] - mn;
#pragma unroll
    for (int r = 0; r < 16; ++r) p1[r] = p1[r] - mn;
#pragma unroll
    for (int r = 0; r < 16; ++r) p0[r] = __builtin_amdgcn_exp2f(p0[r]);
}
__device__ __forceinline__ void finishSM(f32x16& p0, f32x16& p1, float alpha, float& l_reg, bf16x8& pa0, bf16x8& pa1, bf16x8& pa2, bf16x8& pa3) {
#pragma unroll
    for (int r = 0; r < 16; ++r) p1[r] = __builtin_amdgcn_exp2f(p1[r]);
    float ps = 0;
#pragma unroll
    for (int r = 0; r < 16; ++r) ps += p0[r];
#pragma unroll
    for (int r = 0; r < 16; ++r) ps += p1[r];
    { auto rr = __builtin_amdgcn_permlane32_swap(__float_as_uint(ps), __float_as_uint(ps), false, false); ps = __uint_as_float(rr[0]) + __uint_as_float(rr[1]); }
    l_reg = l_reg * alpha + ps;
#define PK4(P, B_, OUT) do { unsigned a0 = cvt_pk_bf16(P[B_+0], P[B_+1]), a1 = cvt_pk_bf16(P[B_+2], P[B_+3]);                          \
        unsigned b0 = cvt_pk_bf16(P[B_+4], P[B_+5]), b1 = cvt_pk_bf16(P[B_+6], P[B_+7]);                                             \
        auto r0 = __builtin_amdgcn_permlane32_swap(a0, b0, false, false); auto r1 = __builtin_amdgcn_permlane32_swap(a1, b1, false, false); \
        u32x4 w = {r0[0], r1[0], r0[1], r1[1]}; OUT = __builtin_bit_cast(bf16x8, w); } while (0)
    PK4(p0, 0, pa0); PK4(p0, 8, pa1); PK4(p1, 0, pa2); PK4(p1, 8, pa3);
#undef PK4
}
template <int KB>
__device__ __forceinline__ void qkt(f32x16& p0, f32x16& p1, const LAS char* K_lds, int r32, int hi, const bf16x8* qr, const LAS float* bl) {
#pragma unroll
    for (int g = 0; g < 4; ++g) { const f32x4 b0 = *(const LAS f32x4*)(bl + 8 * g), b1 = *(const LAS f32x4*)(bl + 32 + 8 * g);
        p0[4 * g] = b0[0]; p0[4 * g + 1] = b0[1]; p0[4 * g + 2] = b0[2]; p0[4 * g + 3] = b0[3]; p1[4 * g] = b1[0]; p1[4 * g + 1] = b1[1]; p1[4 * g + 2] = b1[2]; p1[4 * g + 3] = b1[3]; }
    const LAS char* kb[4];
#pragma unroll
    for (int dd = 0; dd < 4; ++dd) kb[dd] = K_lds + KB * SHM_K + KSWZ(r32, (dd * 16 + hi * 8) * 2);
#pragma unroll
    for (int d0 = 0; d0 < 8; ++d0) { const LAS char* a = kb[d0 & 3] + (d0 >> 2) * 128;
        bf16x8 b0 = *(const LAS bf16x8*)(a);
        bf16x8 b1 = *(const LAS bf16x8*)(a + 32 * 256);
        p0 = __builtin_amdgcn_mfma_f32_32x32x16_bf16(b0, qr[d0], p0, 0, 0, 0);
        p1 = __builtin_amdgcn_mfma_f32_32x32x16_bf16(b1, qr[d0], p1, 0, 0, 0); }
}
template <int VB>
__device__ __forceinline__ void pv_tile(f32x16* o, int vb0, bf16x8 pa0, bf16x8 pa1, bf16x8 pa2, bf16x8 pa3) {
#define TRRD(dst, off) asm volatile("ds_read_b64_tr_b16 %0, %1 offset:%2" : "=&v"(dst) : "v"(vb0), "i"(off) : "memory")
#define PV_D0(d0) do { s16x4 l0, l1, l2, l3, h0, h1, h2, h3; constexpr int b_ = VB * SHM_V + v_rd_off(d0, 0, 0); \
        TRRD(l0, b_); TRRD(h0, b_ + 2048); TRRD(l1, b_ + 4096); TRRD(h1, b_ + 6144); TRRD(l2, b_ + 8192); TRRD(h2, b_ + 10240); TRRD(l3, b_ + 12288); TRRD(h3, b_ + 14336); \
        asm volatile("s_waitcnt lgkmcnt(0)" ::: "memory"); SBAR();   \
        o[d0] = __builtin_amdgcn_mfma_f32_32x32x16_bf16(pa0, (bf16x8){l0[0], l0[1], l0[2], l0[3], h0[0], h0[1], h0[2], h0[3]}, o[d0], 0, 0, 0);   \
        o[d0] = __builtin_amdgcn_mfma_f32_32x32x16_bf16(pa1, (bf16x8){l1[0], l1[1], l1[2], l1[3], h1[0], h1[1], h1[2], h1[3]}, o[d0], 0, 0, 0);   \
        o[d0] = __builtin_amdgcn_mfma_f32_32x32x16_bf16(pa2, (bf16x8){l2[0], l2[1], l2[2], l2[3], h2[0], h2[1], h2[2], h2[3]}, o[d0], 0, 0, 0);   \
        o[d0] = __builtin_amdgcn_mfma_f32_32x32x16_bf16(pa3, (bf16x8){l3[0], l3[1], l3[2], l3[3], h3[0], h3[1], h3[2], h3[3]}, o[d0], 0, 0, 0); } while (0)
    PV_D0(0); PV_D0(1); PV_D0(2); PV_D0(3);
#undef PV_D0
#undef TRRD
}
struct BlockRef { const bf16_t* Q; const bf16_t* K; const bf16_t* V; bf16_t* O; int P0; };
struct Seam { bf16x8 qr[8]; bf16x8 st_v0, st_v1, st_k0, st_k1; };
#define VMW() asm volatile("s_waitcnt vmcnt(0)" ::: "memory")
#define VMWN(n) asm volatile("s_waitcnt vmcnt(%0)" :: "i"(n) : "memory")
#define SLOAD_H(Kp, Vp, k0) do { const char* vb_ = (const char*)(Vp) + (size_t)(k0) * (ld * 2); const char* kb_ = (const char*)(Kp) + (size_t)(k0) * (ld * 2); \
        S.st_v0 = *(const bf16x8*)(vb_ + soff); S.st_v1 = *(const bf16x8*)(vb_ + 32 * ld * 2 + soff); S.st_k0 = *(const bf16x8*)(kb_ + soff); S.st_k1 = *(const bf16x8*)(kb_ + 32 * ld * 2 + soff); } while (0)
#define SWRITE_HK(bf) do { *(LAS bf16x8*)(K_lds + (bf) * SHM_K + kws) = S.st_k0; *(LAS bf16x8*)(K_lds + (bf) * SHM_K + kws + 32 * 256) = S.st_k1; } while (0)
#define SWRITE_HV(bf) do { *(LAS bf16x8*)(V_lds + (bf) * SHM_V + vst0) = S.st_v0; *(LAS bf16x8*)(V_lds + (bf) * SHM_V + vst1) = S.st_v1; } while (0)
#define SWRITE_H(bf) do { SWRITE_HV(bf); SWRITE_HK(bf); } while (0)
template <int ld> __device__ __forceinline__ void prime(const BlockRef& cur, LAS char* lds, Seam& S) {
    const int tid = opaque_tid(), wid = __builtin_amdgcn_readfirstlane(tid >> 6), lane = tid & 63, r32 = lane & 31, hi = lane >> 5;
    const int sr = tid >> 4, sc = (tid & 15) * 8, kws = KSWZ(sr, sc * 2); LAS char* K_lds = lds + 2 * SHM_V;
    const unsigned soff = (unsigned)(sr * ld + sc) * 2u, qoff = (unsigned)((wid * QBLK + r32) * ld + hi * 8) * 2u;
#pragma unroll
    for (int d0 = 0; d0 < 8; ++d0) S.qr[d0] = *(const bf16x8*)((const char*)cur.Q + qoff + d0 * 32);
    SLOAD_H(cur.K, cur.V, 0); VMW(); SWRITE_HK(0);
    __syncthreads();
}
template <int ld, int ldo> __device__ __forceinline__ void block(const BlockRef& cur, const BlockRef& nxt, LAS char* lds, Seam& S) {
    const int tid = opaque_tid(), wid = __builtin_amdgcn_readfirstlane(tid >> 6), lane = tid & 63, r32 = lane & 31, hi = lane >> 5;
    const int NT = (cur.P0 + QB - 1) / KVBLK + 1;
    const int qlo = cur.P0 + wid * QBLK, qm = qlo + r32 - 4 * hi;
    LAS char* V_lds = lds; LAS char* K_lds = lds + 2 * SHM_V;
    LAS float* ws = (LAS float*)(lds + OFF_WS) + wid * 64; LAS float* li_l = ws; LAS float* al_l = ws + 32;
    const LAS float* bias = (const LAS float*)(lds + OFF_BIAS) + 4 * hi;
    float m_reg = -1e30f, l_reg = 0; f32x16 o[4] = {};
    const int sr = tid >> 4, sc = (tid & 15) * 8, vst0 = v_st(sr, sc), vst1 = v_st(32 + sr, sc), kws = KSWZ(sr, sc * 2);
    const unsigned soff = (unsigned)(sr * ld + sc) * 2u;
    const int vb0 = (int)(uintptr_t)V_lds + v_rd_base(lane);
    const bf16_t* Kh = cur.K; const bf16_t* Vh = cur.V;
#define RESC(a) do { if (__any((a) < 1.f)) { if (hi == 0) al_l[r32] = (a); asm volatile("s_waitcnt lgkmcnt(0)" ::: "memory");              \
                     for (int d_ = 0; d_ < 4; ++d_) for (int r = 0; r < 16; ++r) o[d_][r] *= al_l[crow(r, hi)]; } } while (0)
#define KBASE(t) ((t) * KVBLK)
#define MASKT(P0_, P1_, t) do { const int kb_ = KBASE(t); if (kb_ + KVBLK - 1 > qlo) mask_tile(P0_, P1_, qm - kb_); } while (0)
    constexpr int NQL = 8;
#define SEAM_K0() do { VMWN(NQL); SWRITE_HK(0); SBAR(); } while (0)
    f32x16 pA0, pA1, pB0, pB1; float mnA, mnB, alA, alB; bf16x8 pa0, pa1, pa2, pa3;
    SWRITE_HV(0); SBAR();
    if (NT > 1) { SLOAD_H(Kh, Vh, KBASE(1)); }
    SBAR(); qkt<0>(pA0, pA1, K_lds, r32, hi, S.qr, bias + KBASE(0));
    MASKT(pA0, pA1, 0); partialSM(pA0, pA1, m_reg, mnA, alA);
    if (NT > 1) { VMW(); SWRITE_H(1); }
    __syncthreads();
#define HALF_STEP(PX0, PX1, mnX, alX, PY0, PY1, alY, t, KB, VB, SB) do {                                                      \
        SBAR(); qkt<KB>(PX0, PX1, K_lds, r32, hi, S.qr, bias + KBASE(t));                                             \
        finishSM(PY0, PY1, alY, l_reg, pa0, pa1, pa2, pa3); SBAR();                                                           \
        if ((t) + 1 < NT) { SLOAD_H(Kh, Vh, KBASE((t) + 1)); SBAR(); }                                               \
        pv_tile<VB>(o, vb0, pa0, pa1, pa2, pa3); MASKT(PX0, PX1, (t)); partialSM(PX0, PX1, m_reg, mnX, alX);                                        \
        __syncthreads();                                                                                                      \
        if ((t) + 1 < NT) { VMW(); SWRITE_H(SB); }                                                                          \
        RESC(alX); __syncthreads(); } while (0)
    for (int t = 1; t + 1 < NT; t += 2) {
        HALF_STEP(pB0, pB1, mnB, alB, pA0, pA1, alA, t, 1, 0, 0);
        HALF_STEP(pA0, pA1, mnA, alA, pB0, pB1, alB, t + 1, 0, 1, 1);
    }
    const bool even = (NT & 1) == 0;
    if (even) { SBAR(); qkt<1>(pB0, pB1, K_lds, r32, hi, S.qr, bias + KBASE(NT - 1)); SBAR(); }
    int tid2 = tid; asm volatile("" : "+v"(tid2));
    const int r32b = tid2 & 31, hib = (tid2 >> 5) & 1;
    SBAR();
    finishSM(pA0, pA1, alA, l_reg, pa0, pa1, pa2, pa3); SBAR();
    pv_tile<0>(o, vb0, pa0, pa1, pa2, pa3);
    if (even) { MASKT(pB0, pB1, NT - 1); partialSM(pB0, pB1, m_reg, mnB, alB); __syncthreads(); RESC(alB);
        finishSM(pB0, pB1, alB, l_reg, pa0, pa1, pa2, pa3); SBAR(); pv_tile<1>(o, vb0, pa0, pa1, pa2, pa3); }
    SBAR();
    if (hi == 0) li_l[r32] = l_reg; asm volatile("s_waitcnt lgkmcnt(0)" ::: "memory");
    float rli[16];
#pragma unroll
    for (int r = 0; r < 16; ++r) rli[r] = __builtin_amdgcn_rcpf(li_l[crow(r, hi)]);
    char* Ow = (char*)cur.O + (size_t)(wid * QBLK) * (ldo * 2); const unsigned ooff = (unsigned)(4 * hib * ldo + r32b) * 2u;
#pragma unroll
    for (int r = 0; r < 16; ++r) { const int orow0 = (r & 3) + 8 * (r >> 2);
#pragma unroll
        for (int d0 = 0; d0 < 4; ++d0) { const float v = o[d0][r] * rli[r]; const float vn = __shfl_xor(v, 1);
            if ((r32b & 1) == 0) *(unsigned*)(Ow + (size_t)(orow0 * ldo + d0 * 32) * 2 + ooff) = cvt_pk_bf16(v, vn); } }
    __syncthreads();
#undef RESC
#undef KBASE
#undef MASKT
#undef SEAM_K0
#undef HALF_STEP
}
#undef ROW
#undef VMW
#undef VMWN
#undef SLOAD_H
#undef SWRITE_HK
#undef SWRITE_HV
#undef SWRITE_H
#undef KSWZ
}
namespace ret {
constexpr int QS = 288, VS = 544, SS = 144;
constexpr int OFF_Q = 0, OFF_K = 64 * QS, OFF_V = 2 * 64 * QS, OFF_S = OFF_V + 64 * VS, OFF_QD = OFF_S + 64 * SS, OFF_RP = OFF_QD + 256, LDS_BYTES = OFF_RP + 8 * 64 * 4;
#define TRRD(dst, base, off) asm volatile("ds_read_b64_tr_b16 %0, %1 offset:%2" : "=&v"(dst) : "v"(base), "i"(off) : "memory")
__device__ __forceinline__ bf16x8 cat8(s16x4 a, s16x4 b) { return (bf16x8){a[0], a[1], a[2], a[3], b[0], b[1], b[2], b[3]}; }
__device__ __forceinline__ u32x4 scale8(u32x4 v, float s) {
    u32x4 o; o.x = cvt_pk_bf16(bflo(v.x) * s, bfhi(v.x) * s); o.y = cvt_pk_bf16(bflo(v.y) * s, bfhi(v.y) * s); o.z = cvt_pk_bf16(bflo(v.z) * s, bfhi(v.z) * s); o.w = cvt_pk_bf16(bflo(v.w) * s, bfhi(v.w) * s); return o;
}
__device__ __forceinline__ void item(const bf16_t* proj, bf16_t* yret, int b, int h, LAS unsigned char* lds) {
    const int tid = opaque_tid(), w = __builtin_amdgcn_readfirstlane(tid >> 6), lane = tid & 63, c = lane & 15, q = lane >> 4, qq = c >> 2, p = c & 3;
    const float gam = 1.0f - __builtin_amdgcn_exp2f(-5.0f - (float)h);
    const float lg = log2f(gam);
    const float cd = __builtin_amdgcn_exp2f(lg * 64.0f);
    const int srow = tid >> 3, sseg = tid & 7;
    const float kd = __builtin_amdgcn_exp2f(lg * (float)(63 - srow));
    if (tid < 64) ((LAS float*)(lds + OFF_QD))[tid] = __builtin_amdgcn_exp2f(lg * (float)(tid + 1));
    const size_t tok0 = (size_t)b * SEQ;
    const bf16_t* gq = proj + (tok0 + srow) * NPROJ + C_RQ + h * 128 + 16 * sseg;
    const bf16_t* gk = proj + (tok0 + srow) * NPROJ + C_RK + h * 128 + 16 * sseg;
    const bf16_t* gv = proj + (tok0 + srow) * NPROJ + C_RV + h * 256 + 32 * sseg;
    LAS unsigned char* wq = lds + OFF_Q + srow * QS + sseg * 32; LAS unsigned char* wk = lds + OFF_K + srow * QS + sseg * 32; LAS unsigned char* wv = lds + OFF_V + srow * VS + sseg * 64;
    u32x4 pq0, pq1, pk0, pk1, pv0, pv1, pv2, pv3;
#define RET_LOAD(ch) do { const size_t o_ = (size_t)(ch) * 64 * NPROJ; pq0 = *(const u32x4*)(gq + o_); pq1 = *(const u32x4*)(gq + o_ + 8); pk0 = *(const u32x4*)(gk + o_); pk1 = *(const u32x4*)(gk + o_ + 8); \
        pv0 = *(const u32x4*)(gv + o_); pv1 = *(const u32x4*)(gv + o_ + 8); pv2 = *(const u32x4*)(gv + o_ + 16); pv3 = *(const u32x4*)(gv + o_ + 24); } while (0)
#define RET_WRITE() do { *(LAS u32x4*)(wq) = pq0; *(LAS u32x4*)(wq + 16) = pq1; *(LAS u32x4*)(wk) = scale8(pk0, kd); *(LAS u32x4*)(wk + 16) = scale8(pk1, kd); \
        *(LAS u32x4*)(wv) = pv0; *(LAS u32x4*)(wv + 16) = pv1; *(LAS u32x4*)(wv + 32) = pv2; *(LAS u32x4*)(wv + 48) = pv3; } while (0)
    f32x4 st[8][2];
#pragma unroll
    for (int dt = 0; dt < 8; ++dt) { st[dt][0] = (f32x4){0.f, 0.f, 0.f, 0.f}; st[dt][1] = (f32x4){0.f, 0.f, 0.f, 0.f}; }
    RET_LOAD(0); RET_WRITE();
    LDS_WAIT(); __syncthreads();
    const int mt = w & 3, nt0 = 2 * (w >> 2);
    const unsigned vbase = (unsigned)(uintptr_t)(lds + OFF_V) + (unsigned)((4 * q + qq) * VS + (32 * w + 4 * p) * 2);
    const unsigned kbase = (unsigned)(uintptr_t)(lds + OFF_K) + (unsigned)((4 * q + qq) * QS + (4 * p) * 2);
    const LAS unsigned char* qperm = lds + OFF_Q + c * QS + (4 * q) * 2;
    const LAS unsigned char* sperm = lds + OFF_S + c * SS + (4 * q) * 2;
    const LAS float* qd = (const LAS float*)(lds + OFF_QD); LAS float* rp = (LAS float*)(lds + OFF_RP);
    for (int ch = 0; ch < SEQ / 64; ++ch) {
        if (ch + 1 < SEQ / 64) RET_LOAD(ch + 1);
        {
            f32x4 s0 = (f32x4){0.f, 0.f, 0.f, 0.f}, s1 = (f32x4){0.f, 0.f, 0.f, 0.f};
#pragma unroll
            for (int ks = 0; ks < 4; ++ks) { const bf16x8 ak = *(const LAS bf16x8*)(lds + OFF_K + (16 * mt + c) * QS + (32 * ks + 8 * q) * 2);
                const bf16x8 b0 = *(const LAS bf16x8*)(lds + OFF_Q + (16 * nt0 + c) * QS + (32 * ks + 8 * q) * 2), b1 = *(const LAS bf16x8*)(lds + OFF_Q + (16 * nt0 + 16 + c) * QS + (32 * ks + 8 * q) * 2);
                s0 = __builtin_amdgcn_mfma_f32_16x16x32_bf16(ak, b0, s0, 0, 0, 0); s1 = __builtin_amdgcn_mfma_f32_16x16x32_bf16(ak, b1, s1, 0, 0, 0); }
#pragma unroll
            for (int t = 0; t < 2; ++t) { const int n = 16 * (nt0 + t) + c; f32x4 sv = t ? s1 : s0;
#pragma unroll
                for (int j = 0; j < 4; ++j) { const int m = 16 * mt + 4 * q + j; const int d = n > m ? n - m : m - n; sv[j] *= __builtin_amdgcn_exp2f(lg * (float)(d + m - 63)); }
                u32x2 o; o.x = cvt_pk_bf16(sv[0], sv[1]); o.y = cvt_pk_bf16(sv[2], sv[3]); *(LAS u32x2*)(lds + OFF_S + n * SS + (16 * mt + 4 * q) * 2) = o; }
        }
        LDS_WAIT(); __syncthreads();
        f32x4 acc[2][4];
#pragma unroll
        for (int ct = 0; ct < 2; ++ct)
#pragma unroll
            for (int nt = 0; nt < 4; ++nt) acc[ct][nt] = (f32x4){0.f, 0.f, 0.f, 0.f};
#pragma unroll
        for (int ks = 0; ks < 4; ++ks) {
            bf16x8 as[2];
#pragma unroll
            for (int ct = 0; ct < 2; ++ct) { const f32x4 x0 = st[2 * ks][ct], x1 = st[2 * ks + 1][ct]; u32x4 u; u.x = cvt_pk_bf16(x0[0], x0[1]); u.y = cvt_pk_bf16(x0[2], x0[3]); u.z = cvt_pk_bf16(x1[0], x1[1]); u.w = cvt_pk_bf16(x1[2], x1[3]); as[ct] = __builtin_bit_cast(bf16x8, u); }
#pragma unroll
            for (int nt = 0; nt < 4; ++nt) { const u32x2 lo = *(const LAS u32x2*)(qperm + nt * 16 * QS + ks * 64), hi = *(const LAS u32x2*)(qperm + nt * 16 * QS + ks * 64 + 32);
                const u32x4 bu = {lo.x, lo.y, hi.x, hi.y}; const bf16x8 bq = __builtin_bit_cast(bf16x8, bu);
                acc[0][nt] = __builtin_amdgcn_mfma_f32_16x16x32_bf16(as[0], bq, acc[0][nt], 0, 0, 0); acc[1][nt] = __builtin_amdgcn_mfma_f32_16x16x32_bf16(as[1], bq, acc[1][nt], 0, 0, 0); }
        }
#pragma unroll
        for (int nt = 0; nt < 4; ++nt) { const float f = qd[16 * nt + c]; acc[0][nt] = acc[0][nt] * f; acc[1][nt] = acc[1][nt] * f; }
        bf16x8 vt[2][2];
        { s16x4 a0, a1, a2, a3, a4, a5, a6, a7;
          TRRD(a0, vbase, 0); TRRD(a1, vbase, 16 * VS); TRRD(a2, vbase, 32); TRRD(a3, vbase, 16 * VS + 32);
          TRRD(a4, vbase, 32 * VS); TRRD(a5, vbase, 48 * VS); TRRD(a6, vbase, 32 * VS + 32); TRRD(a7, vbase, 48 * VS + 32);
          asm volatile("s_waitcnt lgkmcnt(0)" ::: "memory"); SBAR();
          vt[0][0] = cat8(a0, a1); vt[0][1] = cat8(a2, a3); vt[1][0] = cat8(a4, a5); vt[1][1] = cat8(a6, a7); }
#pragma unroll
        for (int ks2 = 0; ks2 < 2; ++ks2)
#pragma unroll
            for (int nt = 0; nt < 4; ++nt) { const u32x2 lo = *(const LAS u32x2*)(sperm + nt * 16 * SS + ks2 * 64), hi = *(const LAS u32x2*)(sperm + nt * 16 * SS + ks2 * 64 + 32);
                const u32x4 bu = {lo.x, lo.y, hi.x, hi.y}; const bf16x8 bs = __builtin_bit_cast(bf16x8, bu);
                acc[0][nt] = __builtin_amdgcn_mfma_f32_16x16x32_bf16(vt[ks2][0], bs, acc[0][nt], 0, 0, 0); acc[1][nt] = __builtin_amdgcn_mfma_f32_16x16x32_bf16(vt[ks2][1], bs, acc[1][nt], 0, 0, 0); }
#pragma unroll
        for (int dt = 0; dt < 8; ++dt) { s16x4 k0, k1, k2, k3;
            TRRD(k0, kbase, dt * 32); TRRD(k1, kbase, 16 * QS + dt * 32); TRRD(k2, kbase, 32 * QS + dt * 32); TRRD(k3, kbase, 48 * QS + dt * 32);
            asm volatile("s_waitcnt lgkmcnt(0)" ::: "memory"); SBAR();
            const bf16x8 ka = cat8(k0, k1), kb = cat8(k2, k3);
#pragma unroll
            for (int ct = 0; ct < 2; ++ct) { f32x4 s = st[dt][ct] * cd; s = __builtin_amdgcn_mfma_f32_16x16x32_bf16(ka, vt[0][ct], s, 0, 0, 0); s = __builtin_amdgcn_mfma_f32_16x16x32_bf16(kb, vt[1][ct], s, 0, 0, 0); st[dt][ct] = s; } }
#pragma unroll
        for (int nt = 0; nt < 4; ++nt) { float ss = 0.f;
#pragma unroll
            for (int ct = 0; ct < 2; ++ct)
#pragma unroll
                for (int j = 0; j < 4; ++j) ss += acc[ct][nt][j] * acc[ct][nt][j];
            ss += __shfl_xor(ss, 16); ss += __shfl_xor(ss, 32);
            if (q == 0) rp[w * 64 + 16 * nt + c] = ss; }
        LDS_WAIT(); __syncthreads();
        const size_t trow = tok0 + (size_t)ch * 64;
#pragma unroll
        for (int nt = 0; nt < 4; ++nt) { float tot = 0.f;
#pragma unroll
            for (int ww = 0; ww < 8; ++ww) tot += rp[ww * 64 + 16 * nt + c];
            const float rstd = 1.0f / sqrtf(tot * (1.0f / 256.0f) + RMS_EPS); const size_t tk = trow + 16 * nt + c;
#pragma unroll
            for (int ct = 0; ct < 2; ++ct) { const int col = h * 256 + 32 * w + 16 * ct + 4 * q;
                const u32x2 g = *(const u32x2*)(proj + tk * NPROJ + C_RG + col); const f32x4 a = acc[ct][nt] * rstd;
                u32x2 o; o.x = cvt_pk_bf16(a[0] * bflo(g.x), a[1] * bfhi(g.x)); o.y = cvt_pk_bf16(a[2] * bflo(g.y), a[3] * bfhi(g.y));
                *(u32x2*)(yret + tk * DM + col) = o; } }
        if (ch + 1 < SEQ / 64) { RET_WRITE(); }
        LDS_WAIT(); __syncthreads();
    }
#undef RET_LOAD
#undef RET_WRITE
}
#undef TRRD
}
constexpr int N_PHASES = 2 + 8 * NLAYER;
struct Args { const float* in[19]; float* out; unsigned char* ws; int ph_lo, ph_hi; };

__device__ __forceinline__ void moe_tables(Frame& F, int l) {
    LAS int* tab = (LAS int*)(F.lds + MOE_OFF);
    __syncthreads();
    if (F.tid < 32) tab[F.tid] = (int)__hip_atomic_load(F.ctl + CW_CNT + l * 2048 + 64 * F.tid, RLX_AGENT);
    LDS_WAIT(); __syncthreads();
    if (F.tid == 0) { int sa = 0, ta = 0; for (int e = 0; e < 32; ++e) { const int t = (tab[e] + 255) >> 8; tab[32 + e] = sa; tab[64 + e] = ta; sa += t * 256; ta += t; } tab[96] = ta; }
    LDS_WAIT(); __syncthreads();
}

__device__ __forceinline__ void mixer_phase(int l, int mode = 0) {
    for (;;) {
        GAS unsigned char* wsg_ = (GAS unsigned char*)KWS(); asm volatile("" : "+s"(wsg_)); unsigned char* ws = (unsigned char*)wsg_;
        LAS unsigned char* ldsb = (LAS unsigned char*)0; volatile LAS unsigned* MISC = (volatile LAS unsigned*)(ldsb + MISC_OFF);
        const int tid = opaque_tid(), lane = tid & 63, wave = __builtin_amdgcn_readfirstlane(tid >> 6);
        __syncthreads();
        if (tid == 0) MISC[16] = __hip_atomic_fetch_add((gu32*)(ws + WS_CTL) + CW_QUEUE + 64 * l, 1u, RLX_AGENT);
        LDS_WAIT(); __syncthreads();
        const int it = __builtin_amdgcn_readfirstlane((int)MISC[16]);
        if (it >= 576) break;
        if ((mode == 1 && it >= 64) || (mode == 2 && it < 64)) continue;
        const bf16_t* proj = (const bf16_t*)(ws + WS_PROJ);
#ifndef NO_RET
        if (it < 64) { ret::item(proj, (bf16_t*)(ws + WS_YR), it >> 3, it & 7, ldsb); continue; }
#endif
#ifndef NO_FOX
        const int j = it - 64, x = 7 - (j >> 6), bh = j & 63, b = bh >> 3, h = bh & 7;
        { const int n = 256 * (x + 1); LAS float* bias = (LAS float*)(ldsb + fox::OFF_BIAS); LAS float* wt = (LAS float*)(ldsb + fox::OFF_WS);
          const float* logf = (const float*)(ws + WS_LOGF);
          f32x4 v = (f32x4){0.f, 0.f, 0.f, 0.f}; if (4 * tid < n) v = *(const f32x4*)(logf + (size_t)(b * 8 + h) * SEQ + 4 * tid);
          v[1] += v[0]; v[2] += v[1]; v[3] += v[2];
          float run = v[3];
#pragma unroll
          for (int o = 1; o < 64; o <<= 1) { const float t = __shfl_up(run, o); if (lane >= o) run += t; }
          if (lane == 63) wt[wave] = run;
          LDS_WAIT(); __syncthreads();
          float base = run - v[3];
          for (int ww = 0; ww < wave; ++ww) base += wt[ww];
          *(LAS f32x4*)(bias + 4 * tid) = (f32x4){-(v[0] + base) * LOG2E, -(v[1] + base) * LOG2E, -(v[2] + base) * LOG2E, -(v[3] + base) * LOG2E};
          LDS_WAIT(); __syncthreads(); }
        const size_t tok0 = (size_t)b * SEQ;
        fox::BlockRef cur;
        cur.Q = proj + (tok0 + 256 * x) * NPROJ + C_FQ + h * 128; cur.K = proj + tok0 * NPROJ + C_FK + h * 128; cur.V = proj + tok0 * NPROJ + C_FV + h * 128;
        cur.O = (bf16_t*)(ws + WS_YF) + (tok0 + 256 * x) * 1024 + h * 128; cur.P0 = 256 * x;
        fox::Seam S;
        fox::prime<NPROJ>(cur, (LAS char*)ldsb, S);
        fox::block<NPROJ, 1024>(cur, cur, (LAS char*)ldsb, S);
#endif
    }
}

__global__ void __launch_bounds__(NWAVES * 64, 2) hybrid_fwd(Args args) {
    extern __shared__ __attribute__((aligned(16))) unsigned char lds_raw[];
    { LAS unsigned char* l0 = (LAS unsigned char*)lds_raw;
      for (int u = threadIdx.x; u < (LDS_BYTES - LDSCTL_OFF) / 4; u += NWAVES * 64) ((LAS unsigned*)(l0 + LDSCTL_OFF))[u] = 0u;
      __syncthreads(); }
#if MK_N_LAUNCHES == 1
    { GAS unsigned char* wsg_ = (GAS unsigned char*)args.ws; asm volatile("" : "+s"(wsg_)); unsigned char* ws = (unsigned char*)wsg_; (void)xcd_barrier_post((unsigned*)((gu32*)(ws + WS_CTL) + CW_BAR), (volatile LAS unsigned*)((LAS unsigned char*)lds_raw + MISC_OFF) + 8); }
#define GRID_BAR() do { GAS unsigned char* wsg_ = (GAS unsigned char*)args.ws; asm volatile("" : "+s"(wsg_)); unsigned char* ws_ = (unsigned char*)wsg_; XcdBarrier bar_; bar_.bar = (unsigned*)((gu32*)(ws_ + WS_CTL) + CW_BAR); bar_.x = xb_xcc_id(); \
        bar_.st = (volatile LAS unsigned*)((LAS unsigned char*)lds_raw + MISC_OFF) + 8; xcd_barrier(bar_); } while (0)
#else
#define GRID_BAR() do {} while (0)
#endif
    const int lo = args.ph_lo, hi = args.ph_hi;
#define IN(k) (lo <= (k) && (k) < hi)
#define SEAM(k) do { if (IN(k) && IN((k) + 1)) GRID_BAR(); } while (0)
#define PHASE_PTRS() GAS unsigned char* wsg_ = (GAS unsigned char*)args.ws; asm volatile("" : "+s"(wsg_)); unsigned char* ws = (unsigned char*)wsg_; Frame F; F.lds = (LAS unsigned char*)lds_raw; F.MISC = (volatile LAS unsigned*)(F.lds + MISC_OFF); \
    F.tid = opaque_tid(); F.lane = F.tid & 63; F.wave = __builtin_amdgcn_readfirstlane(F.tid >> 6); F.G = gridDim.x; F.bx = blockIdx.x; F.ws = ws; F.ctl = (gu32*)(ws + WS_CTL); F.out = (float*)(GAS float*)args.out; \
    float* hf = (float*)(ws + WS_HF); bf16_t* hb = (bf16_t*)(ws + WS_HB); bf16_t* proj = (bf16_t*)(ws + WS_PROJ); \
    bf16_t* yfox = (bf16_t*)(ws + WS_YF); bf16_t* yret = (bf16_t*)(ws + WS_YR); bf16_t* mg = (bf16_t*)(ws + WS_MG); \
    float* z1 = (float*)(ws + WS_Z1); bf16_t* hid = (bf16_t*)(ws + WS_HID); bf16_t* ffo = (bf16_t*)(ws + WS_FFO); \
    float* logf = (float*)(ws + WS_LOGF); int* route = (int*)(ws + WS_ROUTE); int* list = (int*)(ws + WS_LIST); float* wlist = (float*)(ws + WS_WLIST); \
    const float* cosT = (const float*)(ws + WS_ROPE); const float* sinT = cosT + SEQ * 64; \
    const LAS int* tab = (const LAS int*)(F.lds + MOE_OFF); unsigned char* wl = ws + WS_W; \
    (void)hf; (void)hb; (void)proj; (void)yfox; (void)yret; (void)mg; (void)z1; (void)hid; (void)ffo; (void)logf; (void)route; (void)list; (void)wlist; (void)cosT; (void)sinT; (void)tab; (void)wl
#ifndef PH_MASK
#define PH_MASK 0xFFFF
#endif
#define PHON(k) ((PH_MASK >> (k)) & 1)
#ifndef DUP_MASK
#define DUP_MASK 0
#endif
#define REPS(k) (((DUP_MASK >> (k)) & 1) ? 2 : 1)
    if (PHON(0) && IN(0)) { const int l = 0; PHASE_PTRS(); for (int rep_ = 0; rep_ < REPS(0); ++rep_) p0_weights(F, 0); p0_tables(F); } SEAM(0);
    if (PHON(1) && IN(1)) { const int l = 0; PHASE_PTRS();
        LnArgs a{}; a.zin = INP(0); a.hf = hf; a.hb = hb; a.h8 = ws + WS_HB8; a.g = INP(1); a.b = INP(2);
        a.whi = (const bf16_t*)(ws + WS_SKW); a.wlo = a.whi + 16 * 2048; a.S12 = (const float*)(ws + WS_SKS); a.bfor = INP(4); a.logf = logf;
        for (int rep_ = 0; rep_ < REPS(1); ++rep_) ln_pass<0, 1, true>(F, a);
    } SEAM(1);
    { constexpr int l = 0;
        const int pb = 2 + 8 * l;
        if (PHON(2) && IN(pb + 0)) { PHASE_PTRS();
            gm::SchedDense S{(const char*)hb, (const char*)(wl + WL_WIN), 2048 * 2, 2048 * 2, 32, 64, N_BF16_TILES, F.G, F.bx, 0};
            gm::EpiProj E{proj, cosT, sinT, 1.f};
            for (int rep_ = 0; rep_ < REPS(2); ++rep_) gm::gemm_phase<true, false>(F.lds, S, E);
            gm::SchedDense S8{(const char*)(ws + WS_HB8), (const char*)(wl + WL_WIN8), 2048, 2048, 16, 64, N_FP8_TILES, F.G, F.bx, N_BF16_TILES};
            gm::EpiProj E8{proj, cosT, sinT, 1.f / W8_SCALE};
            for (int rep_ = 0; rep_ < REPS(2); ++rep_) gm::gemm_phase<true, true>(F.lds, S8, E8);
        } SEAM(pb + 0);
        if (PHON(3) && IN(pb + 1)) { for (int rep_ = 0; rep_ < REPS(3); ++rep_) mixer_phase(l + 2 * rep_, rep_ ? ((DUP_MASK >> 10) & 3) : 0); } SEAM(pb + 1);
        if (PHON(4) && IN(pb + 2)) { PHASE_PTRS();
            gm::SchedMerge S{(const char*)yfox, (const char*)(wl + WL_WBF), (const char*)yret, (const char*)(wl + WL_WBR), 64, 8, F.G, F.bx};
            gm::EpiMerge E{proj, mg};
            for (int rep_ = 0; rep_ < REPS(4); ++rep_) gm::gemm_phase<true, false>(F.lds, S, E);
        } SEAM(pb + 2);
        if (PHON(5) && IN(pb + 3)) { PHASE_PTRS();
            gm::SchedDense S{(const char*)mg, (const char*)(wl + WL_WOUT), 2048 * 2, 2048 * 2, 32, 64, 8, F.G, F.bx, 0};
            gm::EpiOut E{hf, z1};
            for (int rep_ = 0; rep_ < REPS(5); ++rep_) gm::gemm_phase<false, false>(F.lds, S, E);
        } SEAM(pb + 3);
        if (PHON(6) && IN(pb + 4)) { PHASE_PTRS();
            LnArgs a{}; a.zin = z1; a.hf = z1; a.hb = nullptr; a.h8 = (unsigned char*)hb; a.g = INP(8) + l * DM; a.b = INP(9) + l * DM;
            a.whi = (const bf16_t*)(ws + WS_SKW + 2 * SKW_FGT_BYTES + (size_t)l * SKW_RTR_BYTES); a.wlo = a.whi + 48 * 2048; a.S12 = (const float*)(ws + WS_SKS + (size_t)(2 + l) * 512);
            a.brg = INP(11) + l * 4; a.bre = INP(13) + l * 32; a.route_out = route; a.list = list; a.wlist = wlist; a.cnt = (unsigned*)(F.ctl + CW_CNT + l * 2048);
            if (REPS(6) == 2) { LnArgs d = a; d.hf = hf; d.hb = mg; d.route_out = (int*)ffo; d.list = (int*)ffo + (1 << 20); d.wlist = (float*)ffo + (2 << 20); d.cnt = (unsigned*)(F.ctl + CW_CNT + 4096 + l * 2048);
                ln_pass<1, 3, true>(F, d); }
            ln_pass<1, 3, true>(F, a);
        } SEAM(pb + 4);
        if (PHON(7) && IN(pb + 5)) { PHASE_PTRS();
            moe_tables(F, l);
            gm::SchedMoe<true> S{tab, (const char*)hb, (const char*)(wl + WL_WGU), list, 4, F.G, F.bx};
            gm::EpiMoe1 E{(unsigned char*)hid, wlist, tab};
            for (int rep_ = 0; rep_ < REPS(7); ++rep_) gm::gemm_phase<true, true>(F.lds, S, E);
        } SEAM(pb + 5);
        if (PHON(8) && IN(pb + 6)) { PHASE_PTRS();
            moe_tables(F, l);
            gm::SchedMoe<false> S{tab, (const char*)hid, (const char*)(wl + WL_WD), list, 8, F.G, F.bx};
            gm::EpiMoe2 E{ffo};
            for (int rep_ = 0; rep_ < REPS(8); ++rep_) gm::gemm_phase<true, true>(F.lds, S, E);
        } SEAM(pb + 6);
        if (PHON(9) && IN(pb + 7)) { PHASE_PTRS();
            if (l + 1 < NLAYER) for (int rep_ = 0; rep_ < REPS(0); ++rep_) p0_weights(F, l + 1);
            moe_tables(F, l);
            LnArgs a{}; a.zin = z1; a.ffo = ffo; a.route = route; a.tab = tab; a.g = INP(17) + l * DM; a.b = INP(18) + l * DM;
            if (l + 1 < NLAYER) { a.hf = hf; a.hb = hb; a.h8 = ws + WS_HB8; a.whi = (const bf16_t*)(ws + WS_SKW + (size_t)(l + 1) * SKW_FGT_BYTES); a.wlo = a.whi + 16 * 2048; a.S12 = (const float*)(ws + WS_SKS + (size_t)(l + 1) * 512);
                a.bfor = INP(4) + (l + 1) * 8; a.logf = logf; for (int rep_ = 0; rep_ < REPS(9); ++rep_) ln_pass<2, 1, true>(F, a); }
            else { a.hf = F.out; a.hb = nullptr; ln_pass<2, 1, false>(F, a); }
        } SEAM(pb + 7);
    }
    { constexpr int l = 1;
        const int pb = 2 + 8 * l;
        if (PHON(2) && IN(pb + 0)) { PHASE_PTRS();
            gm::SchedDense S{(const char*)hb, (const char*)(wl + WL_WIN), 2048 * 2, 2048 * 2, 32, 64, N_BF16_TILES, F.G, F.bx, 0};
            gm::EpiProj E{proj, cosT, sinT, 1.f};
            for (int rep_ = 0; rep_ < REPS(2); ++rep_) gm::gemm_phase<true, false>(F.lds, S, E);
            gm::SchedDense S8{(const char*)(ws + WS_HB8), (const char*)(wl + WL_WIN8), 2048, 2048, 16, 64, N_FP8_TILES, F.G, F.bx, N_BF16_TILES};
            gm::EpiProj E8{proj, cosT, sinT, 1.f / W8_SCALE};
            for (int rep_ = 0; rep_ < REPS(2); ++rep_) gm::gemm_phase<true, true>(F.lds, S8, E8);
        } SEAM(pb + 0);
        if (PHON(3) && IN(pb + 1)) { for (int rep_ = 0; rep_ < REPS(3); ++rep_) mixer_phase(l + 2 * rep_, rep_ ? ((DUP_MASK >> 10) & 3) : 0); } SEAM(pb + 1);
        if (PHON(4) && IN(pb + 2)) { PHASE_PTRS();
            gm::SchedMerge S{(const char*)yfox, (const char*)(wl + WL_WBF), (const char*)yret, (const char*)(wl + WL_WBR), 64, 8, F.G, F.bx};
            gm::EpiMerge E{proj, mg};
            for (int rep_ = 0; rep_ < REPS(4); ++rep_) gm::gemm_phase<true, false>(F.lds, S, E);
        } SEAM(pb + 2);
        if (PHON(5) && IN(pb + 3)) { PHASE_PTRS();
            gm::SchedDense S{(const char*)mg, (const char*)(wl + WL_WOUT), 2048 * 2, 2048 * 2, 32, 64, 8, F.G, F.bx, 0};
            gm::EpiOut E{hf, z1};
            for (int rep_ = 0; rep_ < REPS(5); ++rep_) gm::gemm_phase<false, false>(F.lds, S, E);
        } SEAM(pb + 3);
        if (PHON(6) && IN(pb + 4)) { PHASE_PTRS();
            LnArgs a{}; a.zin = z1; a.hf = z1; a.hb = nullptr; a.h8 = (unsigned char*)hb; a.g = INP(8) + l * DM; a.b = INP(9) + l * DM;
            a.whi = (const bf16_t*)(ws + WS_SKW + 2 * SKW_FGT_BYTES + (size_t)l * SKW_RTR_BYTES); a.wlo = a.whi + 48 * 2048; a.S12 = (const float*)(ws + WS_SKS + (size_t)(2 + l) * 512);
            a.brg = INP(11) + l * 4; a.bre = INP(13) + l * 32; a.route_out = route; a.list = list; a.wlist = wlist; a.cnt = (unsigned*)(F.ctl + CW_CNT + l * 2048);
            if (REPS(6) == 2) { LnArgs d = a; d.hf = hf; d.hb = mg; d.route_out = (int*)ffo; d.list = (int*)ffo + (1 << 20); d.wlist = (float*)ffo + (2 << 20); d.cnt = (unsigned*)(F.ctl + CW_CNT + 4096 + l * 2048);
                ln_pass<1, 3, true>(F, d); }
            ln_pass<1, 3, true>(F, a);
        } SEAM(pb + 4);
        if (PHON(7) && IN(pb + 5)) { PHASE_PTRS();
            moe_tables(F, l);
            gm::SchedMoe<true> S{tab, (const char*)hb, (const char*)(wl + WL_WGU), list, 4, F.G, F.bx};
            gm::EpiMoe1 E{(unsigned char*)hid, wlist, tab};
            for (int rep_ = 0; rep_ < REPS(7); ++rep_) gm::gemm_phase<true, true>(F.lds, S, E);
        } SEAM(pb + 5);
        if (PHON(8) && IN(pb + 6)) { PHASE_PTRS();
            moe_tables(F, l);
            gm::SchedMoe<false> S{tab, (const char*)hid, (const char*)(wl + WL_WD), list, 8, F.G, F.bx};
            gm::EpiMoe2 E{ffo};
            for (int rep_ = 0; rep_ < REPS(8); ++rep_) gm::gemm_phase<true, true>(F.lds, S, E);
        } SEAM(pb + 6);
        if (PHON(9) && IN(pb + 7)) { PHASE_PTRS();
            if (l + 1 < NLAYER) for (int rep_ = 0; rep_ < REPS(0); ++rep_) p0_weights(F, l + 1);
            moe_tables(F, l);
            LnArgs a{}; a.zin = z1; a.ffo = ffo; a.route = route; a.tab = tab; a.g = INP(17) + l * DM; a.b = INP(18) + l * DM;
            if (l + 1 < NLAYER) { a.hf = hf; a.hb = hb; a.h8 = ws + WS_HB8; a.whi = (const bf16_t*)(ws + WS_SKW + (size_t)(l + 1) * SKW_FGT_BYTES); a.wlo = a.whi + 16 * 2048; a.S12 = (const float*)(ws + WS_SKS + (size_t)(l + 1) * 512);
                a.bfor = INP(4) + (l + 1) * 8; a.logf = logf; for (int rep_ = 0; rep_ < REPS(9); ++rep_) ln_pass<2, 1, true>(F, a); }
            else { a.hf = F.out; a.hb = nullptr; ln_pass<2, 1, false>(F, a); }
        } SEAM(pb + 7);
    }
#undef IN
#undef SEAM
#undef GRID_BAR
}

extern "C" void kernel_launch(void* const* d_in, const int* in_sizes, int n_in, void* d_out, int out_size, void* d_ws, size_t ws_size, hipStream_t stream) {
    static int grid = 0;
    if (grid == 0) {
        if (n_in != 19 || out_size != NTOK * DM || ws_size < WS_END) { fprintf(stderr, "kernel_launch: unexpected problem (n_in %d, out %d, ws %zu)\n", n_in, out_size, ws_size); grid = -1; }
        int dev = 0, cus = 0;
        if (grid == 0 && (hipGetDevice(&dev) != hipSuccess || hipDeviceGetAttribute(&cus, hipDeviceAttributeMultiprocessorCount, dev) != hipSuccess)) grid = -1;
        if (grid == 0 && hipFuncSetAttribute((const void*)hybrid_fwd, hipFuncAttributeMaxDynamicSharedMemorySize, LDS_BYTES) != hipSuccess) { fprintf(stderr, "kernel_launch: hipFuncSetAttribute failed\n"); grid = -1; }
        (void)hipGetLastError();
        if (grid == 0) grid = cus;
    }
    if (grid < 0) { (void)hipMemsetAsync(d_out, 0xFF, (size_t)out_size * 4, stream); return; }
    if (hipMemsetAsync((char*)d_ws + WS_CTL, 0, CTL_ZERO_BYTES, stream) != hipSuccess) return;
    Args a{};
    for (int i = 0; i < 19; ++i) a.in[i] = (const float*)d_in[i];
    a.out = (float*)d_out; a.ws = (unsigned char*)d_ws;
#if MK_N_LAUNCHES == 1
    a.ph_lo = 0; a.ph_hi = N_PHASES;
    hipLaunchKernelGGL(hybrid_fwd, dim3(grid), dim3(NWAVES * 64), LDS_BYTES, stream, a);
#else
    for (int ph = 0; ph < N_PHASES; ++ph) { a.ph_lo = ph; a.ph_hi = ph + 1; hipLaunchKernelGGL(hybrid_fwd, dim3(grid), dim3(NWAVES * 64), LDS_BYTES, stream, a); }
#endif
}
```

```cpp
#include <hip/hip_runtime.h>
#include <cstdio>
#include <cstdint>

#ifndef MK_N_LAUNCHES
#define MK_N_LAUNCHES 1
#endif

#define LAS __attribute__((address_space(3)))
#define GAS __attribute__((address_space(1)))
typedef unsigned short bf16_t;
typedef short bf16x8 __attribute__((ext_vector_type(8)));
typedef short s16x4 __attribute__((ext_vector_type(4)));
typedef float f32x4 __attribute__((ext_vector_type(4)));
typedef float f32x2 __attribute__((ext_vector_type(2)));
typedef float f32x16 __attribute__((ext_vector_type(16)));
typedef unsigned u32x4 __attribute__((ext_vector_type(4)));
typedef unsigned u32x2 __attribute__((ext_vector_type(2)));
typedef GAS unsigned gu32;
#define RLX_AGENT __ATOMIC_RELAXED, __HIP_MEMORY_SCOPE_AGENT
#define LDS_WAIT() asm volatile("s_waitcnt lgkmcnt(0)" ::: "memory")
#define VM_WAIT() asm volatile("s_waitcnt vmcnt(0)" ::: "memory")
#define SBAR() __builtin_amdgcn_sched_barrier(0)

constexpr int NTOK = 16384, DM = 2048, SEQ = 2048, NBATCH = 8, NLAYER = 2;
constexpr int NPROJ = 13312;
constexpr int C_FQ = 0, C_FK = 1024, C_FV = 2048, C_RQ = 3072, C_RK = 4096, C_RV = 5120, C_RG = 7168, C_GF = 9216, C_GR = 11264;
constexpr int W_IN_COLS = 13320;
constexpr int NEXP = 32, DEXP = 512;
constexpr int HID_ROWS = 40960;
constexpr float ALPHA = 1.4142135623730951f;
constexpr float LN_EPS = 1e-5f, RMS_EPS = 1e-6f;
constexpr float LOG2E = 1.4426950408889634f;
constexpr float QSCALE = 0.08838834764831845f * LOG2E;
constexpr float KSCALE = 0.08838834764831845f;

constexpr size_t MiB = 1u << 20;
constexpr size_t WS_CTL = 0, CTL_ZERO_BYTES = 1 * MiB;
constexpr size_t WS_ROPE = 1 * MiB;
constexpr size_t WS_SKW = 2 * MiB;
constexpr size_t SKW_FGT_BYTES = 16 * 2048 * 2 * 2, SKW_RTR_BYTES = 48 * 2048 * 2 * 2;
constexpr size_t WS_SKS = 3 * MiB;
constexpr size_t WS_LOGF = 3 * MiB + 512 * 1024;
constexpr size_t WS_ROUTE = 4 * MiB;
constexpr size_t WS_LIST = 5 * MiB;
constexpr size_t WS_WLIST = 7 * MiB;
constexpr size_t WS_W = 16 * MiB;
constexpr size_t WL_WIN = 0, WL_WBF = 52 * MiB, WL_WBR = 56 * MiB, WL_WOUT = 64 * MiB, WL_WGU = 72 * MiB, WL_WD = 200 * MiB, WL_BYTES = 264 * MiB;
constexpr size_t WS_HF = 280 * MiB;
constexpr size_t WS_HB = 408 * MiB;
constexpr size_t WS_YF = 472 * MiB, WS_YR = 504 * MiB, WS_MG = 568 * MiB;
constexpr size_t WS_PROJ = 632 * MiB;
constexpr size_t WS_Z1 = WS_PROJ, WS_HID = WS_PROJ + 128 * MiB, WS_FFO = WS_PROJ + 168 * MiB;
constexpr size_t WS_END = 1048 * MiB;
static_assert(WS_FFO + (size_t)HID_ROWS * 2048 * 2 <= WS_END && WS_HID + (size_t)HID_ROWS * 512 * 2 <= WS_FFO, "overlay map");
constexpr int CW_TMO = 0;
constexpr int CW_BAR = 4096;
constexpr int CW_QUEUE = 8192;
constexpr int CW_CNT = 9216;

constexpr int RING_BYTES = 131072;
constexpr int LDSCTL_OFF = RING_BYTES;
constexpr int MISC_OFF = LDSCTL_OFF;
constexpr int MOE_OFF = LDSCTL_OFF + 256;
constexpr int LNS_OFF = LDSCTL_OFF + 1024;
constexpr int LDS_BYTES = 163840;

__device__ __forceinline__ unsigned cvt_pk_bf16(float lo, float hi) { unsigned r; asm volatile("v_cvt_pk_bf16_f32 %0, %1, %2" : "=v"(r) : "v"(lo), "v"(hi)); return r; }
__device__ __forceinline__ unsigned f2bf(float f) { unsigned u = __builtin_bit_cast(unsigned, f); return (u + 0x7fffu + ((u >> 16) & 1u)) >> 16; }
__device__ __forceinline__ unsigned pk2(float lo, float hi) { return f2bf(lo) | (f2bf(hi) << 16); }
__device__ __forceinline__ float bf2f(unsigned short b) { return __builtin_bit_cast(float, ((unsigned)b) << 16); }
__device__ __forceinline__ float bflo(unsigned w) { return __builtin_bit_cast(float, w << 16); }
__device__ __forceinline__ float bfhi(unsigned w) { return __builtin_bit_cast(float, w & 0xffff0000u); }
__device__ __forceinline__ float fast_sigmoid(float x) { return __builtin_amdgcn_rcpf(1.0f + __builtin_amdgcn_exp2f(-x * LOG2E)); }
__device__ __forceinline__ int opaque_tid() { int t = threadIdx.x; asm volatile("" : "+v"(t)); return t; }
typedef int v4i_t __attribute__((ext_vector_type(4)));
typedef int v8i_t __attribute__((ext_vector_type(8)));
__device__ __forceinline__ unsigned pk4_fp8(float a, float b, float c_, float d) { int w = __builtin_amdgcn_cvt_pk_fp8_f32(a, b, 0, false); w = __builtin_amdgcn_cvt_pk_fp8_f32(c_, d, w, true); return (unsigned)w; }
constexpr float W8_SCALE = 32.f;
constexpr float HID8_SCALE = 64.f;
constexpr int N_BF16_TILES = 36, N_FP8_TILES = 16;
constexpr size_t WL_WIN8 = WL_WIN + (size_t)N_BF16_TILES * 256 * 2048 * 2;
constexpr size_t WS_HB8 = WS_MG;
namespace gm {
constexpr int BM = 256, BK = 64, HALF = 128, HTB = HALF * BK * 2, STAGE_BYTES = 8 * HTB, NXCD = 8, WGM = 8;
__host__ __device__ __forceinline__ int lds_byte(int r, int c) { const int st = (r >> 4) * 2 + (c >> 5), rr = r & 15, cc = c & 31, ob = rr * 64 + cc * 2; return st * 1024 + (ob ^ (((ob >> 9) & 1) << 5)); }
__host__ __device__ __forceinline__ void stage_rc(int b, int& R, int& C) { const int st = b / 1024, sb = b % 1024, swz = sb ^ (((sb >> 9) & 1) << 5); R = (st >> 1) * 16 + swz / 64; C = (st & 1) * 32 + (swz % 64) / 2; }
__host__ __device__ __forceinline__ int perm32(int rho) { const int n = rho >> 4, i = rho & 15; return 8 * (i >> 2) + 4 * n + (i & 3); }

struct Unit {
    const char* A;
    const char* B;
    unsigned lda, ldb;
    int nt;
    int pm, pn;
    int kind;
    int e, rows;
    int keep;
};
__device__ __forceinline__ bool static_tile(int L, int nM, int nN, int& pm, int& pn) {
    const int nwg = nM * nN; if (L >= nwg) return false;
    int wgid = L; { const int q = nwg / NXCD, r = nwg % NXCD, xcd = wgid % NXCD, off = wgid / NXCD; wgid = (xcd < r ? xcd * (q + 1) : r * (q + 1) + (xcd - r) * q) + off; }
    const int nig = WGM * nN, gid = wgid / nig, fm = gid * WGM, gsz = (nM - fm) < WGM ? (nM - fm) : WGM;
    pm = fm + ((wgid % nig) % gsz); pn = (wgid % nig) / gsz; return true;
}

template <bool PERM, bool FP8, class Sched, class Epi>
__device__ __forceinline__ void gemm_phase(LAS unsigned char* lds, const Sched& S, const Epi& E) {
    const int tid = opaque_tid(), wid = __builtin_amdgcn_readfirstlane(tid >> 6), lane = tid & 63, wr = wid >> 2, wc = wid & 3, fr = lane & 15, fq = lane >> 4;
    int Rr[2], Cc[2], Rb[2];
#pragma unroll
    for (int i = 0; i < 2; ++i) { int R, C; stage_rc(tid * 16 + i * 8192, R, C); Rr[i] = R; Cc[i] = C; Rb[i] = PERM ? ((R & ~31) + perm32(R & 31)) : R; }
    const unsigned ldsw = (unsigned)wid * 1024u;
    const int aoff = lds_byte(wr * 64 + fr, fq * 8), boff = lds_byte(wc * 32 + fr, fq * 8);
#define PG8_SA(b, h) (((b) * 2 + (h)) * HTB)
#define PG8_SB(b, h) ((4 + (b) * 2 + (h)) * HTB)
#define PG8_STAGE(bufoff, gbase, voff) do { _Pragma("unroll") for (int _i = 0; _i < 2; ++_i) \
        __builtin_amdgcn_global_load_lds((const unsigned*)((const char*)(gbase) + (voff)[_i]), (LAS unsigned*)(lds + (bufoff) + ldsw + _i * 8192), 16, 0, 0); } while (0)
#define PG8_LDA(dst, b, h) do { _Pragma("unroll") for (int m = 0; m < 4; ++m) _Pragma("unroll") for (int k = 0; k < 2; ++k) dst[m][k] = *(const LAS bf16x8*)(lds + PG8_SA(b, h) + aoff + m * 2048 + k * 1024); } while (0)
#define PG8_LDB(dst, b, h) do { _Pragma("unroll") for (int n = 0; n < 2; ++n) _Pragma("unroll") for (int k = 0; k < 2; ++k) dst[n][k] = *(const LAS bf16x8*)(lds + PG8_SB(b, h) + boff + n * 2048 + k * 1024); } while (0)
#define PG8_MMA(ai, bj, At, Bt) do { __builtin_amdgcn_s_setprio(1); _Pragma("unroll") for (int m = 0; m < 4; ++m) _Pragma("unroll") for (int n = 0; n < 2; ++n) { \
        if constexpr (FP8) { const v8i_t bb_ = __builtin_shufflevector(__builtin_bit_cast(v4i_t, Bt[n][0]), __builtin_bit_cast(v4i_t, Bt[n][1]), 0, 1, 2, 3, 4, 5, 6, 7); \
            const v8i_t aa_ = __builtin_shufflevector(__builtin_bit_cast(v4i_t, At[m][0]), __builtin_bit_cast(v4i_t, At[m][1]), 0, 1, 2, 3, 4, 5, 6, 7); \
            acc[ai][bj][m][n] = __builtin_amdgcn_mfma_scale_f32_16x16x128_f8f6f4(bb_, aa_, acc[ai][bj][m][n], 0, 0, 0, 0x7f7f7f7f, 0, 0x7f7f7f7f); } \
        else { _Pragma("unroll") for (int k = 0; k < 2; ++k) acc[ai][bj][m][n] = __builtin_amdgcn_mfma_f32_16x16x32_bf16(Bt[n][k], At[m][k], acc[ai][bj][m][n], 0, 0, 0); } } \
        __builtin_amdgcn_s_setprio(0); } while (0)
#define PG8_WAIT_V(n) asm volatile("s_waitcnt vmcnt(" #n ")" ::: "memory")
#define PG8_WAIT_L(n) asm volatile("s_waitcnt lgkmcnt(" #n ")" ::: "memory")
#define PG8_BAR __builtin_amdgcn_s_barrier()
#define PG8_SCHED __builtin_amdgcn_sched_barrier(0)
#define PG8_OFFS(u, tk) do { _Pragma("unroll") for (int _i = 0; _i < 2; ++_i) { \
        vA0[_i] = (Sched::GATHER ? (unsigned)tk[_i] : (unsigned)Rr[_i]) * (u).lda + (unsigned)Cc[_i] * 2u; vA1[_i] = (Sched::GATHER ? (unsigned)tk[2 + _i] : (unsigned)(HALF + Rr[_i])) * (u).lda + (unsigned)Cc[_i] * 2u; \
        vB[_i] = (unsigned)Rb[_i] * (u).ldb + (unsigned)Cc[_i] * 2u; } } while (0)
#define PG8_TOKS(u, tk) do { if (Sched::GATHER) { tk[0] = S.tok(u, Rr[0]); tk[1] = S.tok(u, Rr[1]); tk[2] = S.tok(u, HALF + Rr[0]); tk[3] = S.tok(u, HALF + Rr[1]); } } while (0)
    Unit cur, nxt; int ui = 0;
    if (!S.next(0, cur)) return;
    f32x4 acc[2][2][4][2];
#pragma unroll
    for (int a = 0; a < 2; ++a)
#pragma unroll
        for (int b = 0; b < 2; ++b)
#pragma unroll
            for (int m = 0; m < 4; ++m)
#pragma unroll
                for (int n = 0; n < 2; ++n) acc[a][b][m][n] = (f32x4){0.f, 0.f, 0.f, 0.f};
    bf16x8 At[4][2], B0[2][2], B1[2][2];
    unsigned vA0[2], vA1[2], vB[2];
    int tk[4] = {0, 0, 0, 0};
    PG8_TOKS(cur, tk); PG8_OFFS(cur, tk);
    const char* cA = cur.A; const char* cB = cur.B; size_t hB = (size_t)HALF * cur.ldb;
    const size_t kstep = (size_t)(BK * 2);
    PG8_STAGE(PG8_SB(0, 0), cB, vB); PG8_STAGE(PG8_SB(0, 1), cB + hB, vB); PG8_STAGE(PG8_SA(0, 0), cA, vA0); PG8_STAGE(PG8_SA(0, 1), cA, vA1);
    if (wr == 1) PG8_BAR;
    PG8_WAIT_V(2); PG8_BAR;
    PG8_STAGE(PG8_SB(1, 0), cB + kstep, vB); PG8_STAGE(PG8_SA(1, 0), cA + kstep, vA0); PG8_STAGE(PG8_SB(1, 1), cB + hB + kstep, vB);
    PG8_WAIT_V(6); PG8_BAR;
    for (;;) {
        bool has_next = false;
        const char* nAp = cA; const char* nBp = cB; size_t nhB = hB;
        int nt = cur.nt; asm volatile("" : "+s"(nt));
        for (int t = 0; t < nt; t += 2) {
            const bool last = (t == nt - 2);
            asm volatile("" : "+v"(vA0[0]), "+v"(vA0[1]), "+v"(vA1[0]), "+v"(vA1[1]), "+v"(vB[0]), "+v"(vB[1]));
            if (last) { has_next = S.next(ui + 1, nxt); if (has_next) { nAp = nxt.A; nBp = nxt.B; nhB = (size_t)HALF * nxt.ldb; } }
            const char* a1 = cA + (size_t)(t + 1) * kstep;
            const char* a2 = last ? nAp : cA + (size_t)(t + 2) * kstep; const char* b2 = last ? nBp : cB + (size_t)(t + 2) * kstep;
            const char* a3 = a2 + kstep; const char* b3 = b2 + kstep;
            const size_t h2 = last ? nhB : hB;
            PG8_LDB(B0, 0, 0); PG8_LDB(B1, 0, 1); PG8_SCHED; PG8_LDA(At, 0, 0); PG8_STAGE(PG8_SA(1, 1), a1, vA1);
            if (last && has_next) { PG8_TOKS(nxt, tk); PG8_OFFS(nxt, tk); }
            PG8_WAIT_V(8); PG8_WAIT_L(0); PG8_BAR; PG8_MMA(0, 0, At, B0); PG8_MMA(0, 1, At, B1); PG8_BAR; PG8_SCHED;
            PG8_LDA(At, 0, 1); PG8_STAGE(PG8_SB(0, 0), b2, vB); PG8_STAGE(PG8_SB(0, 1), b2 + h2, vB); PG8_STAGE(PG8_SA(0, 0), a2, vA0);
            PG8_WAIT_V(8); PG8_WAIT_L(0); PG8_BAR; PG8_MMA(1, 0, At, B0); PG8_MMA(1, 1, At, B1); PG8_BAR; PG8_SCHED;
            PG8_LDB(B0, 1, 0); PG8_LDB(B1, 1, 1); PG8_SCHED; PG8_LDA(At, 1, 0); PG8_STAGE(PG8_SA(0, 1), a2, vA1);
            PG8_WAIT_V(8); PG8_WAIT_L(0); PG8_BAR; PG8_MMA(0, 0, At, B0); PG8_MMA(0, 1, At, B1); PG8_BAR; PG8_SCHED;
            PG8_LDA(At, 1, 1); PG8_STAGE(PG8_SB(1, 0), b3, vB); PG8_STAGE(PG8_SB(1, 1), b3 + h2, vB); PG8_STAGE(PG8_SA(1, 0), a3, vA0);
            PG8_WAIT_V(8); PG8_WAIT_L(0); PG8_BAR; PG8_MMA(1, 0, At, B0); PG8_MMA(1, 1, At, B1); PG8_BAR; PG8_SCHED;
        }
        if (wr == 0) PG8_BAR;
        { const int tz = opaque_tid() & 63; E(acc, cur, wr, wc, tz & 15, tz >> 4); }
        if (!has_next) break;
        if (!cur.keep) {
#pragma unroll
            for (int a = 0; a < 2; ++a)
#pragma unroll
                for (int b = 0; b < 2; ++b)
#pragma unroll
                    for (int m = 0; m < 4; ++m)
#pragma unroll
                        for (int n = 0; n < 2; ++n) acc[a][b][m][n] = (f32x4){0.f, 0.f, 0.f, 0.f};
        }
        cur = nxt; cA = nAp; cB = nBp; hB = nhB; ++ui;
        if (wr == 1) PG8_BAR;
    }
    PG8_WAIT_V(0);
    PG8_BAR;
#undef PG8_SA
#undef PG8_SB
#undef PG8_STAGE
#undef PG8_LDA
#undef PG8_LDB
#undef PG8_MMA
#undef PG8_WAIT_V
#undef PG8_WAIT_L
#undef PG8_BAR
#undef PG8_SCHED
#undef PG8_OFFS
#undef PG8_TOKS
}
}
namespace gm {
struct SchedDense {
    const char* A; const char* B; unsigned lda, ldb; int nt, nM, nN, G, c, pn0;
    __device__ __forceinline__ bool next(int i, Unit& u) const {
        int pm, pn; if (!static_tile(i * G + c, nM, nN, pm, pn)) return false;
        u.A = A + (size_t)pm * BM * lda; u.B = B + (size_t)pn * BM * ldb; u.lda = lda; u.ldb = ldb; u.nt = nt; u.pm = pm; u.pn = pn + pn0; u.kind = 0; u.e = 0; u.rows = BM; u.keep = 0; return true;
    }
    static constexpr bool GATHER = false;
    __device__ __forceinline__ int tok(const Unit&, int) const { return 0; }
};
struct SchedMerge {
    const char* Af; const char* Bf; const char* Ar; const char* Br; int nM, nN, G, c;
    __device__ __forceinline__ bool next(int i, Unit& u) const {
        int pm, pn; if (!static_tile((i >> 1) * G + c, nM, nN, pm, pn)) return false;
        if ((i & 1) == 0) { u.lda = 1024 * 2; u.ldb = 1024 * 2; u.A = Af + (size_t)pm * BM * u.lda; u.B = Bf + (size_t)pn * BM * u.ldb; u.nt = 16; u.kind = 0; u.keep = 1; }
        else { u.lda = 2048 * 2; u.ldb = 2048 * 2; u.A = Ar + (size_t)pm * BM * u.lda; u.B = Br + (size_t)pn * BM * u.ldb; u.nt = 32; u.kind = 1; u.keep = 0; }
        u.pm = pm; u.pn = pn; u.e = 0; u.rows = BM; return true;
    }
    static constexpr bool GATHER = false;
    __device__ __forceinline__ int tok(const Unit&, int) const { return 0; }
};
template <bool GATHER_> struct SchedMoe {
    static constexpr bool GATHER = GATHER_;
    const LAS int* tab;
    const char* A; const char* W;
    const int* list;
    int NCT, G, c;
    __device__ __forceinline__ bool next(int i, Unit& u) const {
        const int L = i * G + c, ntile = __builtin_amdgcn_readfirstlane(tab[96]); if (L >= ntile * NCT) return false;
        const int rt = L / NCT, ct = L % NCT; const int ln = opaque_tid() & 63;
        const int tbv = tab[64 + (ln & 31)];
        const int e = __builtin_amdgcn_readfirstlane(__popcll(__ballot(ln >= 1 && ln < 32 && tbv <= rt)));
        const int tl = rt - __builtin_amdgcn_readfirstlane(tab[64 + e]), rows = __builtin_amdgcn_readfirstlane(tab[e]) - tl * BM;
        u.e = e; u.rows = rows < BM ? rows : BM; u.pn = ct; u.kind = 0; u.keep = 0;
        if (GATHER) { u.lda = 2048; u.ldb = 2048; u.nt = 16; u.A = A; u.B = W + ((size_t)e * 1024 + (size_t)ct * BM) * u.ldb; u.pm = tl; }
        else { u.lda = 512; u.ldb = 512; u.nt = 4; u.pm = __builtin_amdgcn_readfirstlane(tab[32 + e]) / BM + tl; u.A = A + (size_t)u.pm * BM * u.lda; u.B = W + ((size_t)e * 2048 + (size_t)ct * BM) * u.ldb; }
        return true;
    }
    __device__ __forceinline__ int tok(const Unit& u, int r) const { return (r < u.rows) ? list[u.e * 16384 + u.pm * BM + r] : 0; }
};

struct EpiProj {
    bf16_t* proj; const float* cosT; const float* sinT; float accs;
    __device__ __forceinline__ void operator()(const f32x4 (&acc)[2][2][4][2], const Unit& u, int wr, int wc, int fr, int fq) const {
        const int colt = u.pn * BM; const int row0 = u.pm * BM + wr * 64 + fr, col0 = colt + wc * 32 + 8 * fq;
        int kind; float sc = 1.f;
        if (colt < C_FK) { kind = 0; sc = QSCALE; } else if (colt < C_RQ) kind = 0; else if (colt < C_RV) { kind = 1; sc = (colt >= C_RK) ? KSCALE : 1.f; } else if (colt < C_RG) kind = 0; else if (colt < C_GF) kind = 2; else kind = 3;
        const int j0 = 16 * wc + 4 * fq;
#pragma unroll
        for (int ai = 0; ai < 2; ++ai)
#pragma unroll
            for (int m = 0; m < 4; ++m) { const int row = row0 + ai * HALF + m * 16; bf16_t* rowp = proj + (size_t)row * NPROJ + col0;
                f32x4 cs = (f32x4){1.f, 1.f, 1.f, 1.f}, sn = (f32x4){0.f, 0.f, 0.f, 0.f};
                if (kind == 1) { const int pos = row & (SEQ - 1); cs = *(const f32x4*)(cosT + pos * 64 + j0); sn = *(const f32x4*)(sinT + pos * 64 + j0); }
#pragma unroll
                for (int bj = 0; bj < 2; ++bj) { f32x4 v0 = acc[ai][bj][m][0] * accs, v1 = acc[ai][bj][m][1] * accs;
                    if (kind == 1) { const f32x4 y1 = v0 * cs - v1 * sn, y2 = v0 * sn + v1 * cs; v0 = y1 * sc; v1 = y2 * sc; }
                    else if (kind == 2) {
#pragma unroll
                        for (int j = 0; j < 4; ++j) { v0[j] = v0[j] * fast_sigmoid(v0[j]); v1[j] = v1[j] * fast_sigmoid(v1[j]); } }
                    else if (kind == 3) {
#pragma unroll
                        for (int j = 0; j < 4; ++j) { v0[j] = fast_sigmoid(v0[j]); v1[j] = fast_sigmoid(v1[j]); } }
                    else { v0 = v0 * sc; v1 = v1 * sc; }
                    u32x4 w; w.x = cvt_pk_bf16(v0[0], v0[1]); w.y = cvt_pk_bf16(v0[2], v0[3]); w.z = cvt_pk_bf16(v1[0], v1[1]); w.w = cvt_pk_bf16(v1[2], v1[3]);
                    *(u32x4*)(rowp + bj * HALF) = w; } }
    }
};
struct EpiMerge {
    const bf16_t* proj; bf16_t* mg;
    __device__ __forceinline__ void operator()(f32x4 (&acc)[2][2][4][2], const Unit& u, int wr, int wc, int fr, int fq) const {
        const int row0 = u.pm * BM + wr * 64 + fr, col0 = u.pn * BM + wc * 32 + 8 * fq;
#pragma unroll
        for (int ai = 0; ai < 2; ++ai)
#pragma unroll
            for (int m = 0; m < 4; ++m) { const int row = row0 + ai * HALF + m * 16; const bf16_t* pr = proj + (size_t)row * NPROJ + col0;
#pragma unroll
                for (int bj = 0; bj < 2; ++bj) {
                    const u32x4 gr = *(const u32x4*)(pr + C_GR + bj * HALF);
                    f32x4 r0 = (f32x4){bflo(gr.x), bfhi(gr.x), bflo(gr.y), bfhi(gr.y)}, r1 = (f32x4){bflo(gr.z), bfhi(gr.z), bflo(gr.w), bfhi(gr.w)};
                    if (u.kind == 0) { const u32x4 gf = *(const u32x4*)(pr + C_GF + bj * HALF);
                        const f32x4 f0 = (f32x4){bflo(gf.x), bfhi(gf.x), bflo(gf.y), bfhi(gf.y)}, f1 = (f32x4){bflo(gf.z), bfhi(gf.z), bflo(gf.w), bfhi(gf.w)};
#pragma unroll
                        for (int j = 0; j < 4; ++j) { acc[ai][bj][m][0][j] *= f0[j] * __builtin_amdgcn_rcpf(r0[j]); acc[ai][bj][m][1][j] *= f1[j] * __builtin_amdgcn_rcpf(r1[j]); } }
                    else { const f32x4 v0 = acc[ai][bj][m][0] * r0, v1 = acc[ai][bj][m][1] * r1;
                        u32x4 w; w.x = cvt_pk_bf16(v0[0], v0[1]); w.y = cvt_pk_bf16(v0[2], v0[3]); w.z = cvt_pk_bf16(v1[0], v1[1]); w.w = cvt_pk_bf16(v1[2], v1[3]);
                        *(u32x4*)(mg + (size_t)row * DM + col0 + bj * HALF) = w; } } }
    }
};
struct EpiMix {
    bf16_t* mix;
    __device__ __forceinline__ void operator()(const f32x4 (&acc)[2][2][4][2], const Unit& u, int wr, int wc, int fr, int fq) const {
        const int row0 = u.pm * BM + wr * 64 + fr, col0 = u.pn * BM + wc * 32 + 8 * fq;
#pragma unroll
        for (int ai = 0; ai < 2; ++ai)
#pragma unroll
            for (int m = 0; m < 4; ++m) { bf16_t* rowp = mix + (size_t)(row0 + ai * HALF + m * 16) * DM + col0;
#pragma unroll
                for (int bj = 0; bj < 2; ++bj) { const f32x4 v0 = acc[ai][bj][m][0], v1 = acc[ai][bj][m][1];
                    u32x4 w; w.x = cvt_pk_bf16(v0[0], v0[1]); w.y = cvt_pk_bf16(v0[2], v0[3]); w.z = cvt_pk_bf16(v1[0], v1[1]); w.w = cvt_pk_bf16(v1[2], v1[3]);
                    *(u32x4*)(rowp + bj * HALF) = w; } }
    }
};
struct EpiMoe1 {
    unsigned char* hid; const float* wlist; const LAS int* tab;
    __device__ __forceinline__ void operator()(const f32x4 (&acc)[2][2][4][2], const Unit& u, int wr, int wc, int fr, int fq) const {
        const int r0 = wr * 64 + fr, hc0 = u.pn * 128 + wc * 16 + 4 * fq; const int slot0 = __builtin_amdgcn_readfirstlane(tab[32 + u.e]) + u.pm * BM;
#pragma unroll
        for (int ai = 0; ai < 2; ++ai)
#pragma unroll
            for (int m = 0; m < 4; ++m) { const int r = r0 + ai * HALF + m * 16; if (r < u.rows) {
                const float w = wlist[u.e * 16384 + u.pm * BM + r] * HID8_SCALE; unsigned char* rowp = hid + (size_t)(slot0 + r) * DEXP + hc0;
#pragma unroll
                for (int bj = 0; bj < 2; ++bj) { const f32x4 g = acc[ai][bj][m][0] * (1.f / W8_SCALE), up = acc[ai][bj][m][1] * (1.f / W8_SCALE); f32x4 h;
#pragma unroll
                    for (int j = 0; j < 4; ++j) h[j] = g[j] * fast_sigmoid(g[j]) * up[j] * w;
                    *(unsigned*)(rowp + bj * 64) = pk4_fp8(h[0], h[1], h[2], h[3]); } } }
    }
};
struct EpiMoe2 {
    bf16_t* ffo;
    __device__ __forceinline__ void operator()(const f32x4 (&acc)[2][2][4][2], const Unit& u, int wr, int wc, int fr, int fq) const {
        const int r0 = wr * 64 + fr, col0 = u.pn * BM + wc * 32 + 8 * fq;
#pragma unroll
        for (int ai = 0; ai < 2; ++ai)
#pragma unroll
            for (int m = 0; m < 4; ++m) { const int r = r0 + ai * HALF + m * 16; if (r < u.rows) { bf16_t* rowp = ffo + (size_t)(u.pm * BM + r) * DM + col0;
#pragma unroll
                for (int bj = 0; bj < 2; ++bj) { const f32x4 v0 = acc[ai][bj][m][0] * (1.f / (W8_SCALE * HID8_SCALE)), v1 = acc[ai][bj][m][1] * (1.f / (W8_SCALE * HID8_SCALE));
                    u32x4 w; w.x = cvt_pk_bf16(v0[0], v0[1]); w.y = cvt_pk_bf16(v0[2], v0[3]); w.z = cvt_pk_bf16(v1[0], v1[1]); w.w = cvt_pk_bf16(v1[2], v1[3]);
                    *(u32x4*)(rowp + bj * HALF) = w; } } }
    }
};
}
#define XB_TMO      128
#define XB_XCNT(j)  (256  + 64 * (j))
#define XB_XSUB(j)  (1280 + 64 * (j))
#define XB_XGEN(j)  (2304 + 64 * (j))
#define XB_TOP      3328
#define XB_TOPGEN   3392
#define XCD_BAR_WORDS 3456
#define XB_SPIN_CAP (1u << 18)
__device__ __forceinline__ unsigned xb_ld(unsigned* p)              { return __hip_atomic_load(p, __ATOMIC_RELAXED, __HIP_MEMORY_SCOPE_AGENT); }
__device__ __forceinline__ unsigned xb_add(unsigned* p, unsigned v) { return __hip_atomic_fetch_add(p, v, __ATOMIC_RELAXED, __HIP_MEMORY_SCOPE_AGENT); }
__device__ __forceinline__ unsigned xb_xcc_id() { return (unsigned)__builtin_amdgcn_s_getreg((3 << 11) | 20) & 0xFu; }
#define XB_SPIN(cond, bar) do { unsigned _sp = 0; while (cond) { __builtin_amdgcn_s_sleep(1); \
    if ((++_sp & 255u) == 0u) { if (xb_ld(&(bar)[XB_TMO])) break; if (_sp > XB_SPIN_CAP) { atomicAdd(&(bar)[XB_TMO], 1u); break; } } } } while (0)
struct XcdBarrier { unsigned* bar; unsigned x; volatile LAS unsigned* st; };
__device__ __forceinline__ XcdBarrier xcd_barrier_post(unsigned* bar, volatile LAS unsigned* st) {
    XcdBarrier b; b.bar = bar; b.x = xb_xcc_id(); b.st = st;
    if (threadIdx.x == 0) (void)xb_add(&bar[XB_XCNT(b.x)], 1u);
    return b;
}
__device__ __forceinline__ void xcd_barrier_complete(unsigned* bar, unsigned x, unsigned& nloc, unsigned& nx) {
    const unsigned G = gridDim.x * gridDim.y * gridDim.z;
    unsigned sum, cnt, mine, sp = 0u;
    for (;;) {
        sum = 0u; cnt = 0u; mine = 0u;
#pragma unroll
        for (unsigned j = 0; j < 16; ++j) { const unsigned c = xb_ld(&bar[XB_XCNT(j)]); sum += c; cnt += (c > 0u) ? 1u : 0u; mine = (j == x) ? c : mine; }
        if (sum == G) break;
        __builtin_amdgcn_s_sleep(1);
        if ((++sp & 255u) == 0u) { if (xb_ld(&bar[XB_TMO])) break; if (sp > XB_SPIN_CAP) { atomicAdd(&bar[XB_TMO], 1u); break; } }
    }
    nloc = mine > 0u ? mine : 1u; nx = cnt > 0u ? cnt : 1u;
}
__device__ __forceinline__ void xcd_barrier(const XcdBarrier& b) {
    asm volatile("s_waitcnt vmcnt(0)" ::: "memory");
    __syncthreads();
    if (threadIdx.x == 0) {
        unsigned* bar = b.bar;
        __builtin_amdgcn_s_waitcnt(0);
        unsigned nloc = b.st[0], nx = b.st[1];
        if (nloc == 0u) { xcd_barrier_complete(bar, b.x, nloc, nx); b.st[0] = nloc; b.st[1] = nx; }
        const unsigned old = xb_add(&bar[XB_XSUB(b.x)], 1u);
        const unsigned gen = old / nloc;
        if (old + 1u == (gen + 1u) * nloc) {
            __builtin_amdgcn_fence(__ATOMIC_RELEASE, "agent");
            asm volatile("s_waitcnt vmcnt(0)" ::: "memory");
            const unsigned og = xb_add(&bar[XB_TOP], 1u);
            const unsigned tg = og / nx;
            if (og + 1u == (tg + 1u) * nx) xb_add(&bar[XB_TOPGEN], 1u);
            else XB_SPIN(xb_ld(&bar[XB_TOPGEN]) == tg, bar);
            __builtin_amdgcn_fence(__ATOMIC_ACQUIRE, "agent");
            xb_add(&bar[XB_XGEN(b.x)], 1u);
            asm volatile("s_waitcnt vmcnt(0)" ::: "memory");
        } else {
            XB_SPIN(xb_ld(&bar[XB_XGEN(b.x)]) == gen, bar);
            __builtin_amdgcn_fence(__ATOMIC_ACQUIRE, "agent");
            asm volatile("s_waitcnt vmcnt(0)" ::: "memory");
        }
    }
    __syncthreads();
}

constexpr int NWAVES = 8;
struct Frame {
    LAS unsigned char* lds; volatile LAS unsigned* MISC; gu32* ctl;
    int tid, lane, wave, G, bx;
    unsigned char* ws;
    float* out;
};
#define INP(i) ((const float*)(const GAS float*)(((const float* const*)__builtin_amdgcn_kernarg_segment_ptr())[i]))
#define KWS() ((unsigned char*)(GAS unsigned char*)(((unsigned char* const*)__builtin_amdgcn_kernarg_segment_ptr())[20]))
__device__ __forceinline__ float wave_sum(float v) {
#pragma unroll
    for (int o = 1; o < 64; o <<= 1) v += __shfl_xor(v, o);
    return v;
}

__device__ __forceinline__ void p0_transpose_item(const float* colp, size_t pitch, bf16_t* WT, int K, int n0, int k0, LAS float* scr, int lane) {
    float tv[32];
#pragma unroll
    for (int i = 0; i < 32; ++i) { const int kk = 2 * i + (lane >> 5); tv[i] = colp[(size_t)(k0 + kk) * pitch]; }
#pragma unroll
    for (int i = 0; i < 32; ++i) { const int kk = 2 * i + (lane >> 5); scr[kk * 33 + (lane & 31)] = tv[i]; }
    LDS_WAIT(); asm volatile("" ::: "memory");
    const int c = lane & 7;
#pragma unroll
    for (int j = 0; j < 4; ++j) { const int n = (lane >> 3) + 8 * j; const LAS float* s = scr + (8 * c) * 33 + n;
        u32x4 o; o.x = pk2(s[0 * 33], s[1 * 33]); o.y = pk2(s[2 * 33], s[3 * 33]); o.z = pk2(s[4 * 33], s[5 * 33]); o.w = pk2(s[6 * 33], s[7 * 33]);
        *(GAS u32x4*)(WT + (size_t)(n0 + n) * K + k0 + 8 * c) = o; }
    LDS_WAIT(); asm volatile("" ::: "memory");
}
__device__ __forceinline__ void p0_transpose_item8(const float* colp, size_t pitch, unsigned char* WT8, int K, int n0, int k0, float scale, LAS float* scr, int lane) {
    float tv[32];
#pragma unroll
    for (int i = 0; i < 32; ++i) { const int kk = 2 * i + (lane >> 5); tv[i] = colp[(size_t)(k0 + kk) * pitch]; }
#pragma unroll
    for (int i = 0; i < 32; ++i) { const int kk = 2 * i + (lane >> 5); scr[kk * 33 + (lane & 31)] = tv[i] * scale; }
    LDS_WAIT(); asm volatile("" ::: "memory");
    const int c = lane & 7;
#pragma unroll
    for (int j = 0; j < 4; ++j) { const int n = (lane >> 3) + 8 * j; const LAS float* s = scr + (8 * c) * 33 + n;
        u32x2 o; o.x = pk4_fp8(s[0 * 33], s[1 * 33], s[2 * 33], s[3 * 33]); o.y = pk4_fp8(s[4 * 33], s[5 * 33], s[6 * 33], s[7 * 33]);
        *(GAS u32x2*)(WT8 + (size_t)(n0 + n) * K + k0 + 8 * c) = o; }
    LDS_WAIT(); asm volatile("" ::: "memory");
}
__device__ __forceinline__ int win_srccol(int n) {
    if (n < C_RQ) return n;
    if (n < C_RV) { const int hh = (n - C_RQ) >> 7, p = (n - C_RQ) & 127; return 3080 + hh * 128 + 4 * (p >> 3) + (p & 3) + 64 * ((p >> 2) & 1); }
    return n + 8;
}
constexpr int IT_WIN = 32 * 416, IT_BF = 16 * 64, IT_BR = 32 * 64, IT_OUT = 32 * 64, IT_GU = 32 * 32 * 32, IT_D = 32 * 8 * 64, IT_LAYER = IT_WIN + IT_BF + IT_BR + IT_OUT + IT_GU + IT_D;
__device__ __forceinline__ void p0_weights(Frame& F, int l) {
    LAS float* scr = (LAS float*)(F.lds + F.wave * 16384);
    const int gw = F.bx * NWAVES + F.wave, NGW = F.G * NWAVES, lane = F.lane, nl = lane & 31;
    for (int it = gw; it < IT_LAYER; it += NGW) {
        int r = it; unsigned char* wl = F.ws + WS_W;
        if (r < IT_WIN) { const int kb = r / 416, nb = r % 416; const float* src = INP(3) + (size_t)l * DM * W_IN_COLS + win_srccol(32 * nb + nl);
            if (32 * nb < N_BF16_TILES * 256) p0_transpose_item(src, W_IN_COLS, (bf16_t*)(wl + WL_WIN), 2048, 32 * nb, 64 * kb, scr, lane);
            else p0_transpose_item8(src, W_IN_COLS, wl + WL_WIN8, 2048, 32 * nb - N_BF16_TILES * 256, 64 * kb, W8_SCALE, scr, lane);
            continue; } r -= IT_WIN;
        if (r < IT_BF) { const int kb = r / 64, nb = r % 64; p0_transpose_item(INP(5) + (size_t)l * 1024 * DM + 32 * nb + nl, DM, (bf16_t*)(wl + WL_WBF), 1024, 32 * nb, 64 * kb, scr, lane); continue; } r -= IT_BF;
        if (r < IT_BR) { const int kb = r / 64, nb = r % 64; p0_transpose_item(INP(6) + (size_t)l * 2048 * DM + 32 * nb + nl, DM, (bf16_t*)(wl + WL_WBR), 2048, 32 * nb, 64 * kb, scr, lane); continue; } r -= IT_BR;
        if (r < IT_OUT) { const int kb = r / 64, nb = r % 64; p0_transpose_item(INP(7) + (size_t)l * 2048 * DM + 32 * nb + nl, DM, (bf16_t*)(wl + WL_WOUT), 2048, 32 * nb, 64 * kb, scr, lane); continue; } r -= IT_OUT;
        if (r < IT_GU) { const int e = r / 1024, q = r % 1024, kb = q / 32, nb = q % 32; const int row = 32 * nb + nl, col = 4 * (row >> 3) + (row & 3);
            const float* src = (((row >> 2) & 1) ? INP(15) : INP(14)) + (size_t)(l * NEXP + e) * DM * DEXP + col;
            p0_transpose_item8(src, DEXP, wl + WL_WGU + (size_t)e * 1024 * 2048, 2048, 32 * nb, 64 * kb, W8_SCALE, scr, lane); continue; } r -= IT_GU;
        { const int e = r / 512, q = r % 512, kb = q / 64, nb = q % 64;
            p0_transpose_item8(INP(16) + (size_t)(l * NEXP + e) * DEXP * DM + 32 * nb + nl, DM, wl + WL_WD + (size_t)e * 2048 * 512, 512, 32 * nb, 64 * kb, W8_SCALE, scr, lane); }
    }
}
__device__ __forceinline__ void p0_tables(Frame& F) {
    const int gw = F.bx * NWAVES + F.wave, NGW = F.G * NWAVES, lane = F.lane;
    { float* cosT = (float*)(F.ws + WS_ROPE); float* sinT = cosT + SEQ * 64;
      for (int i = (F.bx * NWAVES + F.wave) * 64 + lane; i < SEQ * 64; i += NGW * 64) { const int pos = i >> 6, j = i & 63;
          double pw = 1.0; for (int t = 0; t < j; ++t) pw *= 0.8659643233600653;
          const float inv = (float)pw; const double ang = (double)((float)pos * inv);
          const double qd = __builtin_rint(ang * 0.6366197723675814); const double r = ang - qd * 1.5707963267948966, r2 = r * r; const int qi = (int)qd & 3;
          const double sr = r * (1.0 + r2 * (-1.0 / 6 + r2 * (1.0 / 120 + r2 * (-1.0 / 5040 + r2 * (1.0 / 362880 + r2 * (-1.0 / 39916800))))));
          const double cr = 1.0 + r2 * (-0.5 + r2 * (1.0 / 24 + r2 * (-1.0 / 720 + r2 * (1.0 / 40320 + r2 * (-1.0 / 3628800 + r2 * (1.0 / 479001600))))));
          const double sv = (qi == 0) ? sr : (qi == 1) ? cr : (qi == 2) ? -sr : -cr, cv = (qi == 0) ? cr : (qi == 1) ? -sr : (qi == 2) ? -cr : sr;
          cosT[i] = (float)cv; sinT[i] = (float)sv; } }
    for (int job = gw; job < 2 * 16 + 2 * 48; job += NGW) {
        int t, c; if (job < 32) { t = job >> 4; c = job & 15; } else { t = 2 + (job - 32) / 48; c = (job - 32) % 48; }
        const int l = t & 1; const float *g, *b; const float* W = nullptr; size_t pitch = 0;
        if (t < 2) { g = l ? INP(17) : INP(1); b = l ? INP(18) : INP(2); if (c < 8) { W = INP(3) + (size_t)l * DM * W_IN_COLS + 3072 + c; pitch = W_IN_COLS; } }
        else { g = INP(8) + l * DM; b = INP(9) + l * DM; if (c < 4) { W = INP(10) + (size_t)l * DM * 4 + c; pitch = 4; } else if (c < 36) { W = INP(12) + (size_t)l * DM * 32 + (c - 4); pitch = 32; } }
        bf16_t* hi = (bf16_t*)(F.ws + WS_SKW + (t < 2 ? (size_t)t * SKW_FGT_BYTES : 2 * SKW_FGT_BYTES + (size_t)(t - 2) * SKW_RTR_BYTES)); const int ncol = t < 2 ? 16 : 48; bf16_t* lo = hi + ncol * 2048;
        float s1 = 0.f, s2 = 0.f;
        for (int k = lane; k < DM; k += 64) { const float w = W ? W[(size_t)k * pitch] : 0.f; const float gw_ = g[k] * w; const unsigned h16 = f2bf(gw_); const float hf_ = __builtin_bit_cast(float, h16 << 16); const unsigned l16 = f2bf(gw_ - hf_);
            hi[c * 2048 + k] = (bf16_t)h16; lo[c * 2048 + k] = (bf16_t)l16; s1 += hf_ + __builtin_bit_cast(float, l16 << 16); s2 += b[k] * w; }
        s1 = wave_sum(s1); s2 = wave_sum(s2);
        if (lane == 0) { float* S = (float*)(F.ws + WS_SKS + (size_t)t * 512); S[c] = s1; S[64 + c] = s2; }
    }
}
struct LnArgs {
    const float* zin;
    float* hf; bf16_t* hb;
    unsigned char* h8;
    const float* g; const float* b;
    const bf16_t* whi; const bf16_t* wlo; const float* S12;
    const bf16_t* ffo; const int* route;
    const bf16_t* mix;
    const LAS int* tab;
    const float* bfor; float* logf;
    const float* brg; const float* bre; int* route_out; int* list; float* wlist; unsigned* cnt;
};
template <int MODE, int NCG, bool PROJ>
__device__ __forceinline__ void ln_pass(Frame& F, const LnArgs& a) {
    const int lane = F.lane, w = F.wave, r = lane & 15, q = lane >> 4, tid = F.tid;
    LAS float* red = (LAS float*)(F.lds + LNS_OFF);
    LAS float* part = (LAS float*)(F.lds + LNS_OFF + 1024);
    LAS float* lg = (LAS float*)(F.lds + LNS_OFF + 1024 + 24576);
    LAS unsigned char* stash = F.lds + w * 16384;
#define LN_ISSUE(g_) do { const int row_ = (g_) * 16 + r; const int kb_ = 256 * w + 8 * q; \
        if (MODE == 2) { const int4 rt = *(const int4*)(a.route + row_ * 4); \
            const size_t sa = (size_t)(a.tab[32 + rt.x] + rt.y), sb = (size_t)(a.tab[32 + rt.z] + rt.w); \
            const bf16_t* pa = a.ffo + sa * DM + kb_; const bf16_t* pb = a.ffo + sb * DM + kb_; \
            _Pragma("unroll") for (int s = 0; s < 8; ++s) { __builtin_amdgcn_global_load_lds((const unsigned*)(pa + 32 * s), (LAS unsigned*)(stash + (2 * s) * 1024), 16, 0, 0); \
                __builtin_amdgcn_global_load_lds((const unsigned*)(pb + 32 * s), (LAS unsigned*)(stash + (2 * s + 1) * 1024), 16, 0, 0); } } \
        else { const float* zp_ = a.zin + (size_t)row_ * DM + kb_; \
            _Pragma("unroll") for (int s = 0; s < 8; ++s) { __builtin_amdgcn_global_load_lds((const unsigned*)(zp_ + 32 * s), (LAS unsigned*)(stash + (2 * s) * 1024), 16, 0, 0); \
                __builtin_amdgcn_global_load_lds((const unsigned*)(zp_ + 32 * s + 4), (LAS unsigned*)(stash + (2 * s + 1) * 1024), 16, 0, 0); } } } while (0)
    const int kb = 256 * w + 8 * q;
    unsigned gq[8][2][4];
#define LN_GLOAD() do { _Pragma("unroll") for (int s = 0; s < 8; ++s) _Pragma("unroll") for (int hh = 0; hh < 2; ++hh) { \
            const f32x4 gv = *(const f32x4*)(a.g + kb + 32 * s + 4 * hh), bv = *(const f32x4*)(a.b + kb + 32 * s + 4 * hh); \
            gq[s][hh][0] = __builtin_bit_cast(unsigned, __builtin_amdgcn_cvt_pkrtz(gv[0] - 1.f, gv[1] - 1.f)); gq[s][hh][1] = __builtin_bit_cast(unsigned, __builtin_amdgcn_cvt_pkrtz(gv[2] - 1.f, gv[3] - 1.f)); \
            gq[s][hh][2] = __builtin_bit_cast(unsigned, __builtin_amdgcn_cvt_pkrtz(bv[0], bv[1])); gq[s][hh][3] = __builtin_bit_cast(unsigned, __builtin_amdgcn_cvt_pkrtz(bv[2], bv[3])); } } while (0)
    constexpr bool GRES = (MODE != 1);
    if (GRES) LN_GLOAD();
    typedef _Float16 h16x2 __attribute__((ext_vector_type(2)));
#define LN_UNPK(dst, s_, hh_, i_) do { unsigned u0_ = gq[s_][hh_][i_], u1_ = gq[s_][hh_][(i_) + 1]; asm volatile("" : "+v"(u0_), "+v"(u1_)); const h16x2 h0_ = __builtin_bit_cast(h16x2, u0_), h1_ = __builtin_bit_cast(h16x2, u1_); \
        dst = (f32x4){(float)h0_[0], (float)h0_[1], (float)h1_[0], (float)h1_[1]}; } while (0)
    LAS float* tb = (LAS float*)(F.lds + LNS_OFF + 1024 + 24576 + 3072);
    LAS int* rrec = (LAS int*)(F.lds + LNS_OFF + 1024 + 24576 + 3072 + 256);
    LAS int* lcnt = rrec + 64 * 8;
    if (MODE == 1 && tid < 64) lcnt[tid] = 0;
    int nrec = 0;
    float s1a = 0.f, s2a = 0.f, s1b = 0.f, s2b = 0.f;
    if (PROJ) {
        if (MODE != 1) { if (tid < 8) tb[tid] = a.bfor[tid]; } else { if (tid < 4) tb[16 + tid] = a.brg[tid]; if (tid >= 32 && tid < 64) tb[tid] = a.bre[tid - 32]; }
        if (tid < 16 * 16 * NCG) { const int cc = tid % (16 * NCG); s1a = a.S12[cc]; s2a = a.S12[64 + cc]; }
        if (tid + NWAVES * 64 < 16 * 16 * NCG) { const int cc = (tid + NWAVES * 64) % (16 * NCG); s1b = a.S12[cc]; s2b = a.S12[64 + cc]; }
    }
    asm volatile("s_waitcnt vmcnt(0)" ::: "memory");
    if (F.bx < NTOK / 16) LN_ISSUE(F.bx);
    for (int gi = F.bx; gi < NTOK / 16; gi += F.G) {
        const int row = gi * 16 + r;
        f32x4 z[8][2];
        if (MODE == 2) {
            f32x4 rh[8][2];
            { const float* zp_ = a.zin + (size_t)row * DM + kb;
#pragma unroll
              for (int s = 0; s < 8; ++s) { rh[s][0] = *(const f32x4*)(zp_ + 32 * s); rh[s][1] = *(const f32x4*)(zp_ + 32 * s + 4); } }
            asm volatile("s_waitcnt vmcnt(0)" ::: "memory");
#pragma unroll
            for (int s = 0; s < 8; ++s) { const u32x4 ua = *(const LAS u32x4*)(stash + (2 * s) * 1024 + lane * 16), ub = *(const LAS u32x4*)(stash + (2 * s + 1) * 1024 + lane * 16);
                z[s][0] = rh[s][0] * ALPHA + ((f32x4){bflo(ua.x), bfhi(ua.x), bflo(ua.y), bfhi(ua.y)} + (f32x4){bflo(ub.x), bfhi(ub.x), bflo(ub.y), bfhi(ub.y)});
                z[s][1] = rh[s][1] * ALPHA + ((f32x4){bflo(ua.z), bfhi(ua.z), bflo(ua.w), bfhi(ua.w)} + (f32x4){bflo(ub.z), bfhi(ub.z), bflo(ub.w), bfhi(ub.w)}); }
        } else if (MODE == 1) {
            u32x4 rm[8];
            { const bf16_t* mp_ = a.mix + (size_t)row * DM + kb;
#pragma unroll
              for (int s = 0; s < 8; ++s) rm[s] = *(const u32x4*)(mp_ + 32 * s); }
            asm volatile("s_waitcnt vmcnt(0)" ::: "memory");
#pragma unroll
            for (int s = 0; s < 8; ++s) { const u32x4 um = rm[s];
                z[s][0] = *(const LAS f32x4*)(stash + (2 * s) * 1024 + lane * 16) * ALPHA + (f32x4){bflo(um.x), bfhi(um.x), bflo(um.y), bfhi(um.y)};
                z[s][1] = *(const LAS f32x4*)(stash + (2 * s + 1) * 1024 + lane * 16) * ALPHA + (f32x4){bflo(um.z), bfhi(um.z), bflo(um.w), bfhi(um.w)}; }
        } else {
            asm volatile("s_waitcnt vmcnt(0)" ::: "memory");
#pragma unroll
            for (int s = 0; s < 8; ++s) { z[s][0] = *(const LAS f32x4*)(stash + (2 * s) * 1024 + lane * 16); z[s][1] = *(const LAS f32x4*)(stash + (2 * s + 1) * 1024 + lane * 16); }
        }
        LDS_WAIT();
        float sm = 0.f, sq = 0.f;
#pragma unroll
        for (int s = 0; s < 8; ++s)
#pragma unroll
            for (int hh = 0; hh < 2; ++hh)
#pragma unroll
                for (int j = 0; j < 4; ++j) { const float v = z[s][hh][j]; sm += v; sq += v * v; }
        sm += __shfl_xor(sm, 16); sm += __shfl_xor(sm, 32); sq += __shfl_xor(sq, 16); sq += __shfl_xor(sq, 32);
        if (q == 0) { red[(w * 16 + r) * 2] = sm; red[(w * 16 + r) * 2 + 1] = sq; }
        if (PROJ) {
            f32x4 acc[NCG];
#pragma unroll
            for (int cg = 0; cg < NCG; ++cg) acc[cg] = (f32x4){0.f, 0.f, 0.f, 0.f};
            bf16x8 bh[2], bl[2];
            unsigned wof[NCG];
#pragma unroll
            for (int cg = 0; cg < NCG; ++cg) { wof[cg] = (unsigned)((16 * cg + r) * DM + kb) * 2u; asm volatile("" : "+v"(wof[cg])); }
#define LN_WLOAD(i_, bf_) do { const int cg_ = (i_) % NCG, s_ = (i_) / NCG; bh[bf_] = *(const bf16x8*)((const char*)a.whi + wof[cg_] + 64 * s_); bl[bf_] = *(const bf16x8*)((const char*)a.wlo + wof[cg_] + 64 * s_); } while (0)
            LN_WLOAD(0, 0);
#pragma unroll
            for (int i = 0; i < 8 * NCG; ++i) { const int cg = i % NCG, s = i / NCG;
                asm volatile("" ::: "memory");
                if (i + 1 < 8 * NCG) LN_WLOAD(i + 1, (i + 1) & 1);
                asm volatile("" ::: "memory");
                u32x4 hi, lo;
                { const f32x4 v0 = z[s][0], v1 = z[s][1];
                  hi.x = cvt_pk_bf16(v0[0], v0[1]); hi.y = cvt_pk_bf16(v0[2], v0[3]); hi.z = cvt_pk_bf16(v1[0], v1[1]); hi.w = cvt_pk_bf16(v1[2], v1[3]);
                  lo.x = cvt_pk_bf16(v0[0] - bflo(hi.x), v0[1] - bfhi(hi.x)); lo.y = cvt_pk_bf16(v0[2] - bflo(hi.y), v0[3] - bfhi(hi.y));
                  lo.z = cvt_pk_bf16(v1[0] - bflo(hi.z), v1[1] - bfhi(hi.z)); lo.w = cvt_pk_bf16(v1[2] - bflo(hi.w), v1[3] - bfhi(hi.w)); }
                const bf16x8 ahi = __builtin_bit_cast(bf16x8, hi), alo = __builtin_bit_cast(bf16x8, lo);
                const bf16x8 wh = bh[i & 1], wl_ = bl[i & 1];
                acc[cg] = __builtin_amdgcn_mfma_f32_16x16x32_bf16(ahi, wh, acc[cg], 0, 0, 0);
                acc[cg] = __builtin_amdgcn_mfma_f32_16x16x32_bf16(alo, wh, acc[cg], 0, 0, 0);
                acc[cg] = __builtin_amdgcn_mfma_f32_16x16x32_bf16(ahi, wl_, acc[cg], 0, 0, 0);
            }
#undef LN_WLOAD
#pragma unroll
            for (int cg = 0; cg < NCG; ++cg)
#pragma unroll
                for (int j = 0; j < 4; ++j) part[(w * 16 + 4 * q + j) * 48 + 16 * cg + r] = acc[cg][j];
        }
        asm volatile("" ::: "memory");
        if (!GRES) { LN_GLOAD(); asm volatile("" ::: "memory"); }
        if (gi + F.G < NTOK / 16) LN_ISSUE(gi + F.G);
        asm volatile("" ::: "memory");
        LDS_WAIT(); __syncthreads();
        float mean, rstd;
        { float ts = 0.f, tq = 0.f;
#pragma unroll
          for (int ww = 0; ww < 8; ++ww) { ts += red[(ww * 16 + r) * 2]; tq += red[(ww * 16 + r) * 2 + 1]; }
          mean = ts * (1.0f / DM); const float var = tq * (1.0f / DM) - mean * mean; rstd = 1.0f / sqrtf(fmaxf(var, 0.f) + LN_EPS); }
        { float* op = a.hf + (size_t)row * DM + kb; bf16_t* ob = a.hb ? a.hb + (size_t)row * DM + kb : nullptr;
#pragma unroll
          for (int s = 0; s < 8; ++s) {
              f32x4 dg0, dg1, bb0, bb1; LN_UNPK(dg0, s, 0, 0); LN_UNPK(dg1, s, 1, 0); LN_UNPK(bb0, s, 0, 2); LN_UNPK(bb1, s, 1, 2);
              const f32x4 n0 = (z[s][0] - mean) * rstd, n1 = (z[s][1] - mean) * rstd; const f32x4 y0 = n0 + n0 * dg0 + bb0, y1 = n1 + n1 * dg1 + bb1;
              *(f32x4*)(op + 32 * s) = y0; *(f32x4*)(op + 32 * s + 4) = y1;
              if (ob) { u32x4 o; o.x = cvt_pk_bf16(y0[0], y0[1]); o.y = cvt_pk_bf16(y0[2], y0[3]); o.z = cvt_pk_bf16(y1[0], y1[1]); o.w = cvt_pk_bf16(y1[2], y1[3]); *(u32x4*)(ob + 32 * s) = o; }
              if (a.h8) { u32x2 o8; o8.x = pk4_fp8(y0[0], y0[1], y0[2], y0[3]); o8.y = pk4_fp8(y1[0], y1[1], y1[2], y1[3]); *(u32x2*)(a.h8 + (size_t)row * DM + kb + 32 * s) = o8; } } }
        if (PROJ) {
#define LN_LOGIT(t_, s1_, s2_) do { const int t = (t_); if (t < 16 * 16 * NCG) { const int rr = t / (16 * NCG), cc = t % (16 * NCG); float ts = 0.f, tq = 0.f, ps = 0.f; \
                _Pragma("unroll") for (int ww = 0; ww < 8; ++ww) { ts += red[(ww * 16 + rr) * 2]; tq += red[(ww * 16 + rr) * 2 + 1]; ps += part[(ww * 16 + rr) * 48 + cc]; } \
                const float mr = ts * (1.0f / DM), vr = tq * (1.0f / DM) - mr * mr, rs = 1.0f / sqrtf(fmaxf(vr, 0.f) + LN_EPS); \
                lg[rr * 48 + cc] = rs * (ps - mr * (s1_)) + (s2_); } } while (0)
            LN_LOGIT(tid, s1a, s2a); if (16 * 16 * NCG > NWAVES * 64) LN_LOGIT(tid + NWAVES * 64, s1b, s2b);
#undef LN_LOGIT
            LDS_WAIT(); __syncthreads();
            if (tid < 16) {
                const int tok = gi * 16 + tid; const LAS float* L = lg + tid * 48;
                if (MODE != 1) {
                    const int bb = tok / SEQ, ss = tok % SEQ;
#pragma unroll
                    for (int hh = 0; hh < 8; ++hh) { const float xv = L[hh] + tb[hh]; const float lsg = fminf(xv, 0.f) - log1pf(expf(-fabsf(xv))); a.logf[((size_t)bb * 8 + hh) * SEQ + ss] = lsg; }
                } else {
                    float gl[4]; float gmax = -3.0e38f; int gi_ = 0;
#pragma unroll
                    for (int j = 0; j < 4; ++j) { gl[j] = L[j] + tb[16 + j]; if (gl[j] > gmax) { gmax = gl[j]; gi_ = j; } }
                    float den = 0.f;
#pragma unroll
                    for (int j = 0; j < 4; ++j) den += expf(gl[j] - gmax);
                    const float grp_w = 1.0f / den;
                    float e1 = -3.0e38f, e2 = -3.0e38f; int i1 = 0, i2 = 0;
#pragma unroll
                    for (int j = 0; j < 8; ++j) { const float v = L[4 + 8 * gi_ + j] + tb[32 + 8 * gi_ + j];
                        if (v > e1) { e2 = e1; i2 = i1; e1 = v; i1 = j; } else if (v > e2) { e2 = v; i2 = j; } }
                    const float t2 = expf(e2 - e1), w1 = grp_w / (1.0f + t2), w2 = grp_w * t2 / (1.0f + t2);
                    const int x1 = 8 * gi_ + i1, x2 = 8 * gi_ + i2;
                    const int r1 = __hip_atomic_fetch_add(lcnt + x1, 1, __ATOMIC_RELAXED, __HIP_MEMORY_SCOPE_WORKGROUP), r2 = __hip_atomic_fetch_add(lcnt + x2, 1, __ATOMIC_RELAXED, __HIP_MEMORY_SCOPE_WORKGROUP);
                    LAS int* rc = rrec + (nrec + tid) * 8; rc[0] = tok; rc[1] = x1; rc[2] = r1; rc[3] = __float_as_int(w1); rc[4] = x2; rc[5] = r2; rc[6] = __float_as_int(w2);
                }
            }
        }
        __syncthreads();
        if (MODE == 1) {
            nrec += 16;
            if (nrec == 64 || gi + F.G >= NTOK / 16) {
                const int tf = opaque_tid();
                if (tf < 32) { const int cn = lcnt[tf]; lcnt[32 + tf] = cn ? (int)__hip_atomic_fetch_add(a.cnt + 64 * tf, (unsigned)cn, RLX_AGENT) : 0; lcnt[tf] = 0; }
                LDS_WAIT(); __syncthreads();
                if (tf < nrec) { const LAS int* rc = rrec + tf * 8; const int tok = rc[0], x1 = rc[1], x2 = rc[4]; const int p1 = lcnt[32 + x1] + rc[2], p2 = lcnt[32 + x2] + rc[5];
                    a.list[x1 * 16384 + p1] = tok; a.wlist[x1 * 16384 + p1] = __int_as_float(rc[3]); a.list[x2 * 16384 + p2] = tok; a.wlist[x2 * 16384 + p2] = __int_as_float(rc[6]);
                    *(int4*)(a.route_out + tok * 4) = make_int4(x1, p1, x2, p2); }
                nrec = 0;
                LDS_WAIT(); __syncthreads();
            }
        }
    }
#undef LN_ISSUE
#undef LN_UNPK
#undef LN_GLOAD
}
namespace fox {
constexpr int D = 128, NW = 8, QBLK = 32, KVBLK = 64, QB = NW * QBLK;
constexpr int SHM_V = KVBLK * D * 2, SHM_K = KVBLK * D * 2;
constexpr int OFF_WS = 2 * SHM_V + 2 * SHM_K, OFF_BIAS = OFF_WS + NW * 64 * 4, LDS_BYTES = OFF_BIAS + SEQ * 4;
constexpr float THR = 8.f, LN2 = 0.6931471805599453f;
#define KSWZ(row, colB) ((row) * 256 + ((colB) ^ (((row) & 7) << 4)))
__device__ __forceinline__ int v_st(int k, int c) { const int kk = (k & ~0xC) | ((k & 4) << 1) | ((k & 8) >> 1); return ((kk >> 3) * 4 + (c >> 5)) * 512 + ((kk & 7) * 32 + (c & 31)) * 2; }
__device__ __forceinline__ int v_rd_base(int lane) { return ((lane & 3) << 3) | (((lane >> 2) & 3) << 6) | (((lane >> 4) & 1) << 5) | (((lane >> 5) & 1) << 8); }
constexpr int v_rd_off(int d0, int ks, int half) { return d0 * 512 + ks * 4096 + half * 2048; }
__device__ __forceinline__ int crow(int r, int hi) { return (r & 3) + 8 * (r >> 2) + 4 * hi; }
__device__ __forceinline__ void mask_tile(f32x16& p0, f32x16& p1, int dq) {
    const float NEG = -__builtin_inff();
#pragma unroll
    for (int r = 0; r < 16; ++r) { const int c = (r & 3) + 8 * (r >> 2); if (dq - c < 0) p0[r] = NEG; if (dq - c - 32 < 0) p1[r] = NEG; }
}
__device__ __forceinline__ void partialSM(f32x16& p0, f32x16& p1, float& m_reg, float& mn, float& alpha) {
    float pmax = p0[0];
#pragma unroll
    for (int r = 1; r < 16; ++r) pmax = fmaxf(pmax, p0[r]);
#pragma unroll
    for (int r = 0; r < 16; ++r) pmax = fmaxf(pmax, p1[r]);
    { auto rr = __builtin_amdgcn_permlane32_swap(__float_as_uint(pmax), __float_as_uint(pmax), false, false); pmax = fmaxf(__uint_as_float(rr[0]), __uint_as_float(rr[1])); }
    if (__builtin_expect(__all((pmax - m_reg) * LN2 <= THR), 1)) { mn = m_reg; alpha = 1.f; }
    else { mn = fmaxf(m_reg, pmax); alpha = __builtin_amdgcn_exp2f(m_reg - mn); m_reg = mn; }
#pragma unroll
    for (int r = 0; r < 16; ++r) p0[r] = p0[r] - mn;
#pragma unroll
    for (int r = 0; r < 16; ++r) p1[r] = p1[r] - mn;
#pragma unroll
    for (int r = 0; r < 16; ++r) p0[r] = __builtin_amdgcn_exp2f(p0[r]);
}
__device__ __forceinline__ void finishSM(f32x16& p0, f32x16& p1, float alpha, float& l_reg, bf16x8& pa0, bf16x8& pa1, bf16x8& pa2, bf16x8& pa3) {
#pragma unroll
    for (int r = 0; r < 16; ++r) p1[r] = __builtin_amdgcn_exp2f(p1[r]);
    float ps = 0;
#pragma unroll
    for (int r = 0; r < 16; ++r) ps += p0[r];
#pragma unroll
    for (int r = 0; r < 16; ++r) ps += p1[r];
    { auto rr = __builtin_amdgcn_permlane32_swap(__float_as_uint(ps), __float_as_uint(ps), false, false); ps = __uint_as_float(rr[0]) + __uint_as_float(rr[1]); }
    l_reg = l_reg * alpha + ps;
#define PK4(P, B_, OUT) do { unsigned a0 = cvt_pk_bf16(P[B_+0], P[B_+1]), a1 = cvt_pk_bf16(P[B_+2], P[B_+3]);                          \
        unsigned b0 = cvt_pk_bf16(P[B_+4], P[B_+5]), b1 = cvt_pk_bf16(P[B_+6], P[B_+7]);                                             \
        auto r0 = __builtin_amdgcn_permlane32_swap(a0, b0, false, false); auto r1 = __builtin_amdgcn_permlane32_swap(a1, b1, false, false); \
        u32x4 w = {r0[0], r1[0], r0[1], r1[1]}; OUT = __builtin_bit_cast(bf16x8, w); } while (0)
    PK4(p0, 0, pa0); PK4(p0, 8, pa1); PK4(p1, 0, pa2); PK4(p1, 8, pa3);
#undef PK4
}
template <int KB>
__device__ __forceinline__ void qkt(f32x16& p0, f32x16& p1, const LAS char* K_lds, int r32, int hi, const bf16x8* qr, const LAS float* bl) {
#pragma unroll
    for (int g = 0; g < 4; ++g) { const f32x4 b0 = *(const LAS f32x4*)(bl + 8 * g), b1 = *(const LAS f32x4*)(bl + 32 + 8 * g);
        p0[4 * g] = b0[0]; p0[4 * g + 1] = b0[1]; p0[4 * g + 2] = b0[2]; p0[4 * g + 3] = b0[3]; p1[4 * g] = b1[0]; p1[4 * g + 1] = b1[1]; p1[4 * g + 2] = b1[2]; p1[4 * g + 3] = b1[3]; }
    const LAS char* kb[4];
#pragma unroll
    for (int dd = 0; dd < 4; ++dd) kb[dd] = K_lds + KB * SHM_K + KSWZ(r32, (dd * 16 + hi * 8) * 2);
#pragma unroll
    for (int d0 = 0; d0 < 8; ++d0) { const LAS char* a = kb[d0 & 3] + (d0 >> 2) * 128;
        bf16x8 b0 = *(const LAS bf16x8*)(a);
        bf16x8 b1 = *(const LAS bf16x8*)(a + 32 * 256);
        p0 = __builtin_amdgcn_mfma_f32_32x32x16_bf16(b0, qr[d0], p0, 0, 0, 0);
        p1 = __builtin_amdgcn_mfma_f32_32x32x16_bf16(b1, qr[d0], p1, 0, 0, 0); }
}
template <int VB>
__device__ __forceinline__ void pv_tile(f32x16* o, int vb0, bf16x8 pa0, bf16x8 pa1, bf16x8 pa2, bf16x8 pa3) {
#define TRRD(dst, off) asm volatile("ds_read_b64_tr_b16 %0, %1 offset:%2" : "=&v"(dst) : "v"(vb0), "i"(off) : "memory")
#define PV_D0(d0) do { s16x4 l0, l1, l2, l3, h0, h1, h2, h3; constexpr int b_ = VB * SHM_V + v_rd_off(d0, 0, 0); \
        TRRD(l0, b_); TRRD(h0, b_ + 2048); TRRD(l1, b_ + 4096); TRRD(h1, b_ + 6144); TRRD(l2, b_ + 8192); TRRD(h2, b_ + 10240); TRRD(l3, b_ + 12288); TRRD(h3, b_ + 14336); \
        asm volatile("s_waitcnt lgkmcnt(0)" ::: "memory"); SBAR();   \
        o[d0] = __builtin_amdgcn_mfma_f32_32x32x16_bf16(pa0, (bf16x8){l0[0], l0[1], l0[2], l0[3], h0[0], h0[1], h0[2], h0[3]}, o[d0], 0, 0, 0);   \
        o[d0] = __builtin_amdgcn_mfma_f32_32x32x16_bf16(pa1, (bf16x8){l1[0], l1[1], l1[2], l1[3], h1[0], h1[1], h1[2], h1[3]}, o[d0], 0, 0, 0);   \
        o[d0] = __builtin_amdgcn_mfma_f32_32x32x16_bf16(pa2, (bf16x8){l2[0], l2[1], l2[2], l2[3], h2[0], h2[1], h2[2], h2[3]}, o[d0], 0, 0, 0);   \
        o[d0] = __builtin_amdgcn_mfma_f32_32x32x16_bf16(pa3, (bf16x8){l3[0], l3[1], l3[2], l3[3], h3[0], h3[1], h3[2], h3[3]}, o[d0], 0, 0, 0); } while (0)
    PV_D0(0); PV_D0(1); PV_D0(2); PV_D0(3);
#undef PV_D0
#undef TRRD
}
struct BlockRef { const bf16_t* Q; const bf16_t* K; const bf16_t* V; bf16_t* O; int P0; };
struct Seam { bf16x8 qr[8]; bf16x8 st_v0, st_v1, st_k0, st_k1; };
#define VMW() asm volatile("s_waitcnt vmcnt(0)" ::: "memory")
#define VMWN(n) asm volatile("s_waitcnt vmcnt(%0)" :: "i"(n) : "memory")
#define SLOAD_H(Kp, Vp, k0) do { const char* vb_ = (const char*)(Vp) + (size_t)(k0) * (ld * 2); const char* kb_ = (const char*)(Kp) + (size_t)(k0) * (ld * 2); \
        S.st_v0 = *(const bf16x8*)(vb_ + soff); S.st_v1 = *(const bf16x8*)(vb_ + 32 * ld * 2 + soff); S.st_k0 = *(const bf16x8*)(kb_ + soff); S.st_k1 = *(const bf16x8*)(kb_ + 32 * ld * 2 + soff); } while (0)
#define SWRITE_HK(bf) do { *(LAS bf16x8*)(K_lds + (bf) * SHM_K + kws) = S.st_k0; *(LAS bf16x8*)(K_lds + (bf) * SHM_K + kws + 32 * 256) = S.st_k1; } while (0)
#define SWRITE_HV(bf) do { *(LAS bf16x8*)(V_lds + (bf) * SHM_V + vst0) = S.st_v0; *(LAS bf16x8*)(V_lds + (bf) * SHM_V + vst1) = S.st_v1; } while (0)
#define SWRITE_H(bf) do { SWRITE_HV(bf); SWRITE_HK(bf); } while (0)
template <int ld> __device__ __forceinline__ void prime(const BlockRef& cur, LAS char* lds, Seam& S) {
    const int tid = opaque_tid(), wid = __builtin_amdgcn_readfirstlane(tid >> 6), lane = tid & 63, r32 = lane & 31, hi = lane >> 5;
    const int sr = tid >> 4, sc = (tid & 15) * 8, kws = KSWZ(sr, sc * 2); LAS char* K_lds = lds + 2 * SHM_V;
    const unsigned soff = (unsigned)(sr * ld + sc) * 2u, qoff = (unsigned)((wid * QBLK + r32) * ld + hi * 8) * 2u;
#pragma unroll
    for (int d0 = 0; d0 < 8; ++d0) S.qr[d0] = *(const bf16x8*)((const char*)cur.Q + qoff + d0 * 32);
    SLOAD_H(cur.K, cur.V, 0); VMW(); SWRITE_HK(0);
    __syncthreads();
}
template <int ld, int ldo> __device__ __forceinline__ void block(const BlockRef& cur, const BlockRef& nxt, LAS char* lds, Seam& S) {
    const int tid = opaque_tid(), wid = __builtin_amdgcn_readfirstlane(tid >> 6), lane = tid & 63, r32 = lane & 31, hi = lane >> 5;
    const int NT = (cur.P0 + QB - 1) / KVBLK + 1;
    const int qlo = cur.P0 + wid * QBLK, qm = qlo + r32 - 4 * hi;
    LAS char* V_lds = lds; LAS char* K_lds = lds + 2 * SHM_V;
    LAS float* ws = (LAS float*)(lds + OFF_WS) + wid * 64; LAS float* li_l = ws; LAS float* al_l = ws + 32;
    const LAS float* bias = (const LAS float*)(lds + OFF_BIAS) + 4 * hi;
    float m_reg = -1e30f, l_reg = 0; f32x16 o[4] = {};
    const int sr = tid >> 4, sc = (tid & 15) * 8, vst0 = v_st(sr, sc), vst1 = v_st(32 + sr, sc), kws = KSWZ(sr, sc * 2);
    const unsigned soff = (unsigned)(sr * ld + sc) * 2u;
    const int vb0 = (int)(uintptr_t)V_lds + v_rd_base(lane);
    const bf16_t* Kh = cur.K; const bf16_t* Vh = cur.V;
#define RESC(a) do { if (__any((a) < 1.f)) { if (hi == 0) al_l[r32] = (a); asm volatile("s_waitcnt lgkmcnt(0)" ::: "memory");              \
                     for (int d_ = 0; d_ < 4; ++d_) for (int r = 0; r < 16; ++r) o[d_][r] *= al_l[crow(r, hi)]; } } while (0)
#define KBASE(t) ((t) * KVBLK)
#define MASKT(P0_, P1_, t) do { const int kb_ = KBASE(t); if (kb_ + KVBLK - 1 > qlo) mask_tile(P0_, P1_, qm - kb_); } while (0)
    constexpr int NQL = 8;
#define SEAM_K0() do { VMWN(NQL); SWRITE_HK(0); SBAR(); } while (0)
    f32x16 pA0, pA1, pB0, pB1; float mnA, mnB, alA, alB; bf16x8 pa0, pa1, pa2, pa3;
    SWRITE_HV(0); SBAR();
    if (NT > 1) { SLOAD_H(Kh, Vh, KBASE(1)); }
    SBAR(); qkt<0>(pA0, pA1, K_lds, r32, hi, S.qr, bias + KBASE(0));
    MASKT(pA0, pA1, 0); partialSM(pA0, pA1, m_reg, mnA, alA);
    if (NT > 1) { VMW(); SWRITE_H(1); }
    __syncthreads();
#define HALF_STEP(PX0, PX1, mnX, alX, PY0, PY1, alY, t, KB, VB, SB) do {                                                      \
        SBAR(); qkt<KB>(PX0, PX1, K_lds, r32, hi, S.qr, bias + KBASE(t));                                             \
        finishSM(PY0, PY1, alY, l_reg, pa0, pa1, pa2, pa3); SBAR();                                                           \
        if ((t) + 1 < NT) { SLOAD_H(Kh, Vh, KBASE((t) + 1)); SBAR(); }                                               \
        pv_tile<VB>(o, vb0, pa0, pa1, pa2, pa3); MASKT(PX0, PX1, (t)); partialSM(PX0, PX1, m_reg, mnX, alX);                                        \
        __syncthreads();                                                                                                      \
        if ((t) + 1 < NT) { VMW(); SWRITE_H(SB); }                                                                          \
        RESC(alX); __syncthreads(); } while (0)
    for (int t = 1; t + 1 < NT; t += 2) {
        HALF_STEP(pB0, pB1, mnB, alB, pA0, pA1, alA, t, 1, 0, 0);
        HALF_STEP(pA0, pA1, mnA, alA, pB0, pB1, alB, t + 1, 0, 1, 1);
    }
    const bool even = (NT & 1) == 0;
    if (even) { SBAR(); qkt<1>(pB0, pB1, K_lds, r32, hi, S.qr, bias + KBASE(NT - 1)); SBAR(); }
    int tid2 = tid; asm volatile("" : "+v"(tid2));
    const int r32b = tid2 & 31, hib = (tid2 >> 5) & 1;
    SBAR();
    finishSM(pA0, pA1, alA, l_reg, pa0, pa1, pa2, pa3); SBAR();
    pv_tile<0>(o, vb0, pa0, pa1, pa2, pa3);
    if (even) { MASKT(pB0, pB1, NT - 1); partialSM(pB0, pB1, m_reg, mnB, alB); __syncthreads(); RESC(alB);
        finishSM(pB0, pB1, alB, l_reg, pa0, pa1, pa2, pa3); SBAR(); pv_tile<1>(o, vb0, pa0, pa1, pa2, pa3); }
    SBAR();
    if (hi == 0) li_l[r32] = l_reg; asm volatile("s_waitcnt lgkmcnt(0)" ::: "memory");
    float rli[16];
#pragma unroll
    for (int r = 0; r < 16; ++r) rli[r] = __builtin_amdgcn_rcpf(li_l[crow(r, hi)]);
    char* Ow = (char*)cur.O + (size_t)(wid * QBLK) * (ldo * 2); const unsigned ooff = (unsigned)(4 * hib * ldo + r32b) * 2u;
#pragma unroll
    for (int r = 0; r < 16; ++r) { const int orow0 = (r & 3) + 8 * (r >> 2);
#pragma unroll
        for (int d0 = 0; d0 < 4; ++d0) { const float v = o[d0][r] * rli[r]; const float vn = __shfl_xor(v, 1);
            if ((r32b & 1) == 0) *(unsigned*)(Ow + (size_t)(orow0 * ldo + d0 * 32) * 2 + ooff) = cvt_pk_bf16(v, vn); } }
    __syncthreads();
#undef RESC
#undef KBASE
#undef MASKT
#undef SEAM_K0
#undef HALF_STEP
}
#undef ROW
#undef VMW
#undef VMWN
#undef SLOAD_H
#undef SWRITE_HK
#undef SWRITE_HV
#undef SWRITE_H
#undef KSWZ
}
namespace ret {
constexpr int QS = 288, VS = 544, SS = 144;
constexpr int OFF_Q = 0, OFF_K = 64 * QS, OFF_V = 2 * 64 * QS, OFF_S = OFF_V + 64 * VS, OFF_QD = OFF_S + 64 * SS, OFF_RP = OFF_QD + 256, LDS_BYTES = OFF_RP + 8 * 64 * 4;
#define TRRD(dst, base, off) asm volatile("ds_read_b64_tr_b16 %0, %1 offset:%2" : "=&v"(dst) : "v"(base), "i"(off) : "memory")
__device__ __forceinline__ bf16x8 cat8(s16x4 a, s16x4 b) { return (bf16x8){a[0], a[1], a[2], a[3], b[0], b[1], b[2], b[3]}; }
__device__ __forceinline__ u32x4 scale8(u32x4 v, float s) {
    u32x4 o; o.x = cvt_pk_bf16(bflo(v.x) * s, bfhi(v.x) * s); o.y = cvt_pk_bf16(bflo(v.y) * s, bfhi(v.y) * s); o.z = cvt_pk_bf16(bflo(v.z) * s, bfhi(v.z) * s); o.w = cvt_pk_bf16(bflo(v.w) * s, bfhi(v.w) * s); return o;
}
__device__ __forceinline__ void item(const bf16_t* proj, bf16_t* yret, int b, int h, LAS unsigned char* lds) {
    const int tid = opaque_tid(), w = __builtin_amdgcn_readfirstlane(tid >> 6), lane = tid & 63, c = lane & 15, q = lane >> 4, qq = c >> 2, p = c & 3;
    const float gam = 1.0f - __builtin_amdgcn_exp2f(-5.0f - (float)h);
    const float lg = log2f(gam);
    const float cd = __builtin_amdgcn_exp2f(lg * 64.0f);
    const int srow = tid >> 3, sseg = tid & 7;
    const float kd = __builtin_amdgcn_exp2f(lg * (float)(63 - srow));
    if (tid < 64) ((LAS float*)(lds + OFF_QD))[tid] = __builtin_amdgcn_exp2f(lg * (float)(tid + 1));
    const size_t tok0 = (size_t)b * SEQ;
    const bf16_t* gq = proj + (tok0 + srow) * NPROJ + C_RQ + h * 128 + 16 * sseg;
    const bf16_t* gk = proj + (tok0 + srow) * NPROJ + C_RK + h * 128 + 16 * sseg;
    const bf16_t* gv = proj + (tok0 + srow) * NPROJ + C_RV + h * 256 + 32 * sseg;
    LAS unsigned char* wq = lds + OFF_Q + srow * QS + sseg * 32; LAS unsigned char* wk = lds + OFF_K + srow * QS + sseg * 32; LAS unsigned char* wv = lds + OFF_V + srow * VS + sseg * 64;
    u32x4 pq0, pq1, pk0, pk1, pv0, pv1, pv2, pv3;
#define RET_LOAD(ch) do { const size_t o_ = (size_t)(ch) * 64 * NPROJ; pq0 = *(const u32x4*)(gq + o_); pq1 = *(const u32x4*)(gq + o_ + 8); pk0 = *(const u32x4*)(gk + o_); pk1 = *(const u32x4*)(gk + o_ + 8); \
        pv0 = *(const u32x4*)(gv + o_); pv1 = *(const u32x4*)(gv + o_ + 8); pv2 = *(const u32x4*)(gv + o_ + 16); pv3 = *(const u32x4*)(gv + o_ + 24); } while (0)
#define RET_WRITE() do { *(LAS u32x4*)(wq) = pq0; *(LAS u32x4*)(wq + 16) = pq1; *(LAS u32x4*)(wk) = scale8(pk0, kd); *(LAS u32x4*)(wk + 16) = scale8(pk1, kd); \
        *(LAS u32x4*)(wv) = pv0; *(LAS u32x4*)(wv + 16) = pv1; *(LAS u32x4*)(wv + 32) = pv2; *(LAS u32x4*)(wv + 48) = pv3; } while (0)
    f32x4 st[8][2];
#pragma unroll
    for (int dt = 0; dt < 8; ++dt) { st[dt][0] = (f32x4){0.f, 0.f, 0.f, 0.f}; st[dt][1] = (f32x4){0.f, 0.f, 0.f, 0.f}; }
    RET_LOAD(0); RET_WRITE();
    LDS_WAIT(); __syncthreads();
    const int mt = w & 3, nt0 = 2 * (w >> 2);
    const unsigned vbase = (unsigned)(uintptr_t)(lds + OFF_V) + (unsigned)((4 * q + qq) * VS + (32 * w + 4 * p) * 2);
    const unsigned kbase = (unsigned)(uintptr_t)(lds + OFF_K) + (unsigned)((4 * q + qq) * QS + (4 * p) * 2);
    const LAS unsigned char* qperm = lds + OFF_Q + c * QS + (4 * q) * 2;
    const LAS unsigned char* sperm = lds + OFF_S + c * SS + (4 * q) * 2;
    const LAS float* qd = (const LAS float*)(lds + OFF_QD); LAS float* rp = (LAS float*)(lds + OFF_RP);
    for (int ch = 0; ch < SEQ / 64; ++ch) {
        if (ch + 1 < SEQ / 64) RET_LOAD(ch + 1);
        {
            f32x4 s0 = (f32x4){0.f, 0.f, 0.f, 0.f}, s1 = (f32x4){0.f, 0.f, 0.f, 0.f};
#pragma unroll
            for (int ks = 0; ks < 4; ++ks) { const bf16x8 ak = *(const LAS bf16x8*)(lds + OFF_K + (16 * mt + c) * QS + (32 * ks + 8 * q) * 2);
                const bf16x8 b0 = *(const LAS bf16x8*)(lds + OFF_Q + (16 * nt0 + c) * QS + (32 * ks + 8 * q) * 2), b1 = *(const LAS bf16x8*)(lds + OFF_Q + (16 * nt0 + 16 + c) * QS + (32 * ks + 8 * q) * 2);
                s0 = __builtin_amdgcn_mfma_f32_16x16x32_bf16(ak, b0, s0, 0, 0, 0); s1 = __builtin_amdgcn_mfma_f32_16x16x32_bf16(ak, b1, s1, 0, 0, 0); }
#pragma unroll
            for (int t = 0; t < 2; ++t) { const int n = 16 * (nt0 + t) + c; f32x4 sv = t ? s1 : s0;
#pragma unroll
                for (int j = 0; j < 4; ++j) { const int m = 16 * mt + 4 * q + j; const int d = n > m ? n - m : m - n; sv[j] *= __builtin_amdgcn_exp2f(lg * (float)(d + m - 63)); }
                u32x2 o; o.x = cvt_pk_bf16(sv[0], sv[1]); o.y = cvt_pk_bf16(sv[2], sv[3]); *(LAS u32x2*)(lds + OFF_S + n * SS + (16 * mt + 4 * q) * 2) = o; }
        }
        LDS_WAIT(); __syncthreads();
        f32x4 acc[2][4];
#pragma unroll
        for (int ct = 0; ct < 2; ++ct)
#pragma unroll
            for (int nt = 0; nt < 4; ++nt) acc[ct][nt] = (f32x4){0.f, 0.f, 0.f, 0.f};
#pragma unroll
        for (int ks = 0; ks < 4; ++ks) {
            bf16x8 as[2];
#pragma unroll
            for (int ct = 0; ct < 2; ++ct) { const f32x4 x0 = st[2 * ks][ct], x1 = st[2 * ks + 1][ct]; u32x4 u; u.x = cvt_pk_bf16(x0[0], x0[1]); u.y = cvt_pk_bf16(x0[2], x0[3]); u.z = cvt_pk_bf16(x1[0], x1[1]); u.w = cvt_pk_bf16(x1[2], x1[3]); as[ct] = __builtin_bit_cast(bf16x8, u); }
#pragma unroll
            for (int nt = 0; nt < 4; ++nt) { const u32x2 lo = *(const LAS u32x2*)(qperm + nt * 16 * QS + ks * 64), hi = *(const LAS u32x2*)(qperm + nt * 16 * QS + ks * 64 + 32);
                const u32x4 bu = {lo.x, lo.y, hi.x, hi.y}; const bf16x8 bq = __builtin_bit_cast(bf16x8, bu);
                acc[0][nt] = __builtin_amdgcn_mfma_f32_16x16x32_bf16(as[0], bq, acc[0][nt], 0, 0, 0); acc[1][nt] = __builtin_amdgcn_mfma_f32_16x16x32_bf16(as[1], bq, acc[1][nt], 0, 0, 0); }
        }
#pragma unroll
        for (int nt = 0; nt < 4; ++nt) { const float f = qd[16 * nt + c]; acc[0][nt] = acc[0][nt] * f; acc[1][nt] = acc[1][nt] * f; }
        bf16x8 vt[2][2];
        { s16x4 a0, a1, a2, a3, a4, a5, a6, a7;
          TRRD(a0, vbase, 0); TRRD(a1, vbase, 16 * VS); TRRD(a2, vbase, 32); TRRD(a3, vbase, 16 * VS + 32);
          TRRD(a4, vbase, 32 * VS); TRRD(a5, vbase, 48 * VS); TRRD(a6, vbase, 32 * VS + 32); TRRD(a7, vbase, 48 * VS + 32);
          asm volatile("s_waitcnt lgkmcnt(0)" ::: "memory"); SBAR();
          vt[0][0] = cat8(a0, a1); vt[0][1] = cat8(a2, a3); vt[1][0] = cat8(a4, a5); vt[1][1] = cat8(a6, a7); }
#pragma unroll
        for (int ks2 = 0; ks2 < 2; ++ks2)
#pragma unroll
            for (int nt = 0; nt < 4; ++nt) { const u32x2 lo = *(const LAS u32x2*)(sperm + nt * 16 * SS + ks2 * 64), hi = *(const LAS u32x2*)(sperm + nt * 16 * SS + ks2 * 64 + 32);
                const u32x4 bu = {lo.x, lo.y, hi.x, hi.y}; const bf16x8 bs = __builtin_bit_cast(bf16x8, bu);
                acc[0][nt] = __builtin_amdgcn_mfma_f32_16x16x32_bf16(vt[ks2][0], bs, acc[0][nt], 0, 0, 0); acc[1][nt] = __builtin_amdgcn_mfma_f32_16x16x32_bf16(vt[ks2][1], bs, acc[1][nt], 0, 0, 0); }
#pragma unroll
        for (int dt = 0; dt < 8; ++dt) { s16x4 k0, k1, k2, k3;
            TRRD(k0, kbase, dt * 32); TRRD(k1, kbase, 16 * QS + dt * 32); TRRD(k2, kbase, 32 * QS + dt * 32); TRRD(k3, kbase, 48 * QS + dt * 32);
            asm volatile("s_waitcnt lgkmcnt(0)" ::: "memory"); SBAR();
            const bf16x8 ka = cat8(k0, k1), kb = cat8(k2, k3);
#pragma unroll
            for (int ct = 0; ct < 2; ++ct) { f32x4 s = st[dt][ct] * cd; s = __builtin_amdgcn_mfma_f32_16x16x32_bf16(ka, vt[0][ct], s, 0, 0, 0); s = __builtin_amdgcn_mfma_f32_16x16x32_bf16(kb, vt[1][ct], s, 0, 0, 0); st[dt][ct] = s; } }
#pragma unroll
        for (int nt = 0; nt < 4; ++nt) { float ss = 0.f;
#pragma unroll
            for (int ct = 0; ct < 2; ++ct)
#pragma unroll
                for (int j = 0; j < 4; ++j) ss += acc[ct][nt][j] * acc[ct][nt][j];
            ss += __shfl_xor(ss, 16); ss += __shfl_xor(ss, 32);
            if (q == 0) rp[w * 64 + 16 * nt + c] = ss; }
        LDS_WAIT(); __syncthreads();
        const size_t trow = tok0 + (size_t)ch * 64;
#pragma unroll
        for (int nt = 0; nt < 4; ++nt) { float tot = 0.f;
#pragma unroll
            for (int ww = 0; ww < 8; ++ww) tot += rp[ww * 64 + 16 * nt + c];
            const float rstd = 1.0f / sqrtf(tot * (1.0f / 256.0f) + RMS_EPS); const size_t tk = trow + 16 * nt + c;
#pragma unroll
            for (int ct = 0; ct < 2; ++ct) { const int col = h * 256 + 32 * w + 16 * ct + 4 * q;
                const u32x2 g = *(const u32x2*)(proj + tk * NPROJ + C_RG + col); const f32x4 a = acc[ct][nt] * rstd;
                u32x2 o; o.x = cvt_pk_bf16(a[0] * bflo(g.x), a[1] * bfhi(g.x)); o.y = cvt_pk_bf16(a[2] * bflo(g.y), a[3] * bfhi(g.y));
                *(u32x2*)(yret + tk * DM + col) = o; } }
        if (ch + 1 < SEQ / 64) { RET_WRITE(); }
        LDS_WAIT(); __syncthreads();
    }
#undef RET_LOAD
#undef RET_WRITE
}
#undef TRRD
}
constexpr int N_PHASES = 2 + 8 * NLAYER;
struct Args { const float* in[19]; float* out; unsigned char* ws; int ph_lo, ph_hi; };

__device__ __forceinline__ void moe_tables(Frame& F, int l) {
    LAS int* tab = (LAS int*)(F.lds + MOE_OFF);
    __syncthreads();
    if (F.tid < 32) tab[F.tid] = (int)__hip_atomic_load(F.ctl + CW_CNT + l * 2048 + 64 * F.tid, RLX_AGENT);
    LDS_WAIT(); __syncthreads();
    if (F.tid == 0) { int sa = 0, ta = 0; for (int e = 0; e < 32; ++e) { const int t = (tab[e] + 255) >> 8; tab[32 + e] = sa; tab[64 + e] = ta; sa += t * 256; ta += t; } tab[96] = ta; }
    LDS_WAIT(); __syncthreads();
}

__device__ __forceinline__ void mixer_phase(int l, int mode = 0) {
    for (;;) {
        GAS unsigned char* wsg_ = (GAS unsigned char*)KWS(); asm volatile("" : "+s"(wsg_)); unsigned char* ws = (unsigned char*)wsg_;
        LAS unsigned char* ldsb = (LAS unsigned char*)0; volatile LAS unsigned* MISC = (volatile LAS unsigned*)(ldsb + MISC_OFF);
        const int tid = opaque_tid(), lane = tid & 63, wave = __builtin_amdgcn_readfirstlane(tid >> 6);
        __syncthreads();
        if (tid == 0) MISC[16] = __hip_atomic_fetch_add((gu32*)(ws + WS_CTL) + CW_QUEUE + 64 * l, 1u, RLX_AGENT);
        LDS_WAIT(); __syncthreads();
        const int it = __builtin_amdgcn_readfirstlane((int)MISC[16]);
        if (it >= 576) break;
        if ((mode == 1 && it >= 64) || (mode == 2 && it < 64)) continue;
        const bf16_t* proj = (const bf16_t*)(ws + WS_PROJ);
#ifndef NO_RET
        if (it < 64) { ret::item(proj, (bf16_t*)(ws + WS_YR), it >> 3, it & 7, ldsb); continue; }
#endif
#ifndef NO_FOX
        const int j = it - 64, x = 7 - (j >> 6), bh = j & 63, b = bh >> 3, h = bh & 7;
        { const int n = 256 * (x + 1); LAS float* bias = (LAS float*)(ldsb + fox::OFF_BIAS); LAS float* wt = (LAS float*)(ldsb + fox::OFF_WS);
          const float* logf = (const float*)(ws + WS_LOGF);
          f32x4 v = (f32x4){0.f, 0.f, 0.f, 0.f}; if (4 * tid < n) v = *(const f32x4*)(logf + (size_t)(b * 8 + h) * SEQ + 4 * tid);
          v[1] += v[0]; v[2] += v[1]; v[3] += v[2];
          float run = v[3];
#pragma unroll
          for (int o = 1; o < 64; o <<= 1) { const float t = __shfl_up(run, o); if (lane >= o) run += t; }
          if (lane == 63) wt[wave] = run;
          LDS_WAIT(); __syncthreads();
          float base = run - v[3];
          for (int ww = 0; ww < wave; ++ww) base += wt[ww];
          *(LAS f32x4*)(bias + 4 * tid) = (f32x4){-(v[0] + base) * LOG2E, -(v[1] + base) * LOG2E, -(v[2] + base) * LOG2E, -(v[3] + base) * LOG2E};
          LDS_WAIT(); __syncthreads(); }
        const size_t tok0 = (size_t)b * SEQ;
        fox::BlockRef cur;
        cur.Q = proj + (tok0 + 256 * x) * NPROJ + C_FQ + h * 128; cur.K = proj + tok0 * NPROJ + C_FK + h * 128; cur.V = proj + tok0 * NPROJ + C_FV + h * 128;
        cur.O = (bf16_t*)(ws + WS_YF) + (tok0 + 256 * x) * 1024 + h * 128; cur.P0 = 256 * x;
        fox::Seam S;
        fox::prime<NPROJ>(cur, (LAS char*)ldsb, S);
        fox::block<NPROJ, 1024>(cur, cur, (LAS char*)ldsb, S);
#endif
    }
}

__global__ void __launch_bounds__(NWAVES * 64, 2) hybrid_fwd(Args args) {
    extern __shared__ __attribute__((aligned(16))) unsigned char lds_raw[];
    { LAS unsigned char* l0 = (LAS unsigned char*)lds_raw;
      for (int u = threadIdx.x; u < (LDS_BYTES - LDSCTL_OFF) / 4; u += NWAVES * 64) ((LAS unsigned*)(l0 + LDSCTL_OFF))[u] = 0u;
      __syncthreads(); }
#if MK_N_LAUNCHES == 1
    { GAS unsigned char* wsg_ = (GAS unsigned char*)args.ws; asm volatile("" : "+s"(wsg_)); unsigned char* ws = (unsigned char*)wsg_; (void)xcd_barrier_post((unsigned*)((gu32*)(ws + WS_CTL) + CW_BAR), (volatile LAS unsigned*)((LAS unsigned char*)lds_raw + MISC_OFF) + 8); }
#define GRID_BAR() do { GAS unsigned char* wsg_ = (GAS unsigned char*)args.ws; asm volatile("" : "+s"(wsg_)); unsigned char* ws_ = (unsigned char*)wsg_; XcdBarrier bar_; bar_.bar = (unsigned*)((gu32*)(ws_ + WS_CTL) + CW_BAR); bar_.x = xb_xcc_id(); \
        bar_.st = (volatile LAS unsigned*)((LAS unsigned char*)lds_raw + MISC_OFF) + 8; xcd_barrier(bar_); } while (0)
#else
#define GRID_BAR() do {} while (0)
#endif
    const int lo = args.ph_lo, hi = args.ph_hi;
#define IN(k) (lo <= (k) && (k) < hi)
#define SEAM(k) do { if (IN(k) && IN((k) + 1)) GRID_BAR(); } while (0)
#define PHASE_PTRS() GAS unsigned char* wsg_ = (GAS unsigned char*)args.ws; asm volatile("" : "+s"(wsg_)); unsigned char* ws = (unsigned char*)wsg_; Frame F; F.lds = (LAS unsigned char*)lds_raw; F.MISC = (volatile LAS unsigned*)(F.lds + MISC_OFF); \
    F.tid = opaque_tid(); F.lane = F.tid & 63; F.wave = __builtin_amdgcn_readfirstlane(F.tid >> 6); F.G = gridDim.x; F.bx = blockIdx.x; F.ws = ws; F.ctl = (gu32*)(ws + WS_CTL); F.out = (float*)(GAS float*)args.out; \
    float* hf = (float*)(ws + WS_HF); bf16_t* hb = (bf16_t*)(ws + WS_HB); bf16_t* proj = (bf16_t*)(ws + WS_PROJ); \
    bf16_t* yfox = (bf16_t*)(ws + WS_YF); bf16_t* yret = (bf16_t*)(ws + WS_YR); bf16_t* mg = (bf16_t*)(ws + WS_MG); \
    float* z1 = (float*)(ws + WS_Z1); bf16_t* hid = (bf16_t*)(ws + WS_HID); bf16_t* ffo = (bf16_t*)(ws + WS_FFO); \
    float* logf = (float*)(ws + WS_LOGF); int* route = (int*)(ws + WS_ROUTE); int* list = (int*)(ws + WS_LIST); float* wlist = (float*)(ws + WS_WLIST); \
    const float* cosT = (const float*)(ws + WS_ROPE); const float* sinT = cosT + SEQ * 64; \
    const LAS int* tab = (const LAS int*)(F.lds + MOE_OFF); unsigned char* wl = ws + WS_W; \
    (void)hf; (void)hb; (void)proj; (void)yfox; (void)yret; (void)mg; (void)z1; (void)hid; (void)ffo; (void)logf; (void)route; (void)list; (void)wlist; (void)cosT; (void)sinT; (void)tab; (void)wl
#ifndef PH_MASK
#define PH_MASK 0xFFFF
#endif
#define PHON(k) ((PH_MASK >> (k)) & 1)
#ifndef DUP_MASK
#define DUP_MASK 0
#endif
#define REPS(k) (((DUP_MASK >> (k)) & 1) ? 2 : 1)
    if (PHON(0) && IN(0)) { const int l = 0; PHASE_PTRS(); for (int rep_ = 0; rep_ < REPS(0); ++rep_) p0_weights(F, 0); p0_tables(F); } SEAM(0);
    if (PHON(1) && IN(1)) { const int l = 0; PHASE_PTRS();
        LnArgs a{}; a.zin = INP(0); a.hf = hf; a.hb = hb; a.h8 = ws + WS_HB8; a.g = INP(1); a.b = INP(2);
        a.whi = (const bf16_t*)(ws + WS_SKW); a.wlo = a.whi + 16 * 2048; a.S12 = (const float*)(ws + WS_SKS); a.bfor = INP(4); a.logf = logf;
        for (int rep_ = 0; rep_ < REPS(1); ++rep_) ln_pass<0, 1, true>(F, a);
    } SEAM(1);
    if ((DUP_MASK >> 12) & 1) { for (int xb = 0; xb < 20; ++xb) GRID_BAR(); }

    { constexpr int l = 0;
        const int pb = 2 + 8 * l;
        if (PHON(2) && IN(pb + 0)) { PHASE_PTRS();
            gm::SchedDense S{(const char*)hb, (const char*)(wl + WL_WIN), 2048 * 2, 2048 * 2, 32, 64, N_BF16_TILES, F.G, F.bx, 0};
            gm::EpiProj E{proj, cosT, sinT, 1.f};
            for (int rep_ = 0; rep_ < REPS(2); ++rep_) gm::gemm_phase<true, false>(F.lds, S, E);
            gm::SchedDense S8{(const char*)(ws + WS_HB8), (const char*)(wl + WL_WIN8), 2048, 2048, 16, 64, N_FP8_TILES, F.G, F.bx, N_BF16_TILES};
            gm::EpiProj E8{proj, cosT, sinT, 1.f / W8_SCALE};
            for (int rep_ = 0; rep_ < REPS(2); ++rep_) gm::gemm_phase<true, true>(F.lds, S8, E8);
        } SEAM(pb + 0);
        if (PHON(3) && IN(pb + 1)) { for (int rep_ = 0; rep_ < REPS(3); ++rep_) mixer_phase(l + 2 * rep_, rep_ ? ((DUP_MASK >> 10) & 3) : 0); } SEAM(pb + 1);
        if (PHON(4) && IN(pb + 2)) { PHASE_PTRS();
            gm::SchedMerge S{(const char*)yfox, (const char*)(wl + WL_WBF), (const char*)yret, (const char*)(wl + WL_WBR), 64, 8, F.G, F.bx};
            gm::EpiMerge E{proj, mg};
            for (int rep_ = 0; rep_ < REPS(4); ++rep_) gm::gemm_phase<true, false>(F.lds, S, E);
        } SEAM(pb + 2);
        if (PHON(5) && IN(pb + 3)) { PHASE_PTRS();
            gm::SchedDense S{(const char*)mg, (const char*)(wl + WL_WOUT), 2048 * 2, 2048 * 2, 32, 64, 8, F.G, F.bx, 0};
            gm::EpiMix E{yret};
            for (int rep_ = 0; rep_ < REPS(5); ++rep_) gm::gemm_phase<true, false>(F.lds, S, E);
        } SEAM(pb + 3);
        if (PHON(6) && IN(pb + 4)) { PHASE_PTRS();
            LnArgs a{}; a.zin = hf; a.mix = yret; a.hf = z1; a.hb = nullptr; a.h8 = (unsigned char*)hb; a.g = INP(8) + l * DM; a.b = INP(9) + l * DM;
            a.whi = (const bf16_t*)(ws + WS_SKW + 2 * SKW_FGT_BYTES + (size_t)l * SKW_RTR_BYTES); a.wlo = a.whi + 48 * 2048; a.S12 = (const float*)(ws + WS_SKS + (size_t)(2 + l) * 512);
            a.brg = INP(11) + l * 4; a.bre = INP(13) + l * 32; a.route_out = route; a.list = list; a.wlist = wlist; a.cnt = (unsigned*)(F.ctl + CW_CNT + l * 2048);
            ln_pass<1, 3, true>(F, a);
        } SEAM(pb + 4);
        if (PHON(7) && IN(pb + 5)) { PHASE_PTRS();
            moe_tables(F, l);
            gm::SchedMoe<true> S{tab, (const char*)hb, (const char*)(wl + WL_WGU), list, 4, F.G, F.bx};
            gm::EpiMoe1 E{(unsigned char*)hid, wlist, tab};
            for (int rep_ = 0; rep_ < REPS(7); ++rep_) gm::gemm_phase<true, true>(F.lds, S, E);
        } SEAM(pb + 5);
        if (PHON(8) && IN(pb + 6)) { PHASE_PTRS();
            moe_tables(F, l);
            gm::SchedMoe<false> S{tab, (const char*)hid, (const char*)(wl + WL_WD), list, 8, F.G, F.bx};
            gm::EpiMoe2 E{ffo};
            for (int rep_ = 0; rep_ < REPS(8); ++rep_) gm::gemm_phase<true, true>(F.lds, S, E);
        } SEAM(pb + 6);
        if (PHON(9) && IN(pb + 7)) { PHASE_PTRS();
            if (l + 1 < NLAYER) for (int rep_ = 0; rep_ < REPS(0); ++rep_) p0_weights(F, l + 1);
            moe_tables(F, l);
            LnArgs a{}; a.zin = z1; a.ffo = ffo; a.route = route; a.tab = tab; a.g = INP(17) + l * DM; a.b = INP(18) + l * DM;
            if (l + 1 < NLAYER) { a.hf = hf; a.hb = hb; a.h8 = ws + WS_HB8; a.whi = (const bf16_t*)(ws + WS_SKW + (size_t)(l + 1) * SKW_FGT_BYTES); a.wlo = a.whi + 16 * 2048; a.S12 = (const float*)(ws + WS_SKS + (size_t)(l + 1) * 512);
                a.bfor = INP(4) + (l + 1) * 8; a.logf = logf; for (int rep_ = 0; rep_ < REPS(9); ++rep_) ln_pass<2, 1, true>(F, a); }
            else { a.hf = F.out; a.hb = nullptr; ln_pass<2, 1, false>(F, a); }
        } SEAM(pb + 7);
    }
    { constexpr int l = 1;
        const int pb = 2 + 8 * l;
        if (PHON(2) && IN(pb + 0)) { PHASE_PTRS();
            gm::SchedDense S{(const char*)hb, (const char*)(wl + WL_WIN), 2048 * 2, 2048 * 2, 32, 64, N_BF16_TILES, F.G, F.bx, 0};
            gm::EpiProj E{proj, cosT, sinT, 1.f};
            for (int rep_ = 0; rep_ < REPS(2); ++rep_) gm::gemm_phase<true, false>(F.lds, S, E);
            gm::SchedDense S8{(const char*)(ws + WS_HB8), (const char*)(wl + WL_WIN8), 2048, 2048, 16, 64, N_FP8_TILES, F.G, F.bx, N_BF16_TILES};
            gm::EpiProj E8{proj, cosT, sinT, 1.f / W8_SCALE};
            for (int rep_ = 0; rep_ < REPS(2); ++rep_) gm::gemm_phase<true, true>(F.lds, S8, E8);
        } SEAM(pb + 0);
        if (PHON(3) && IN(pb + 1)) { for (int rep_ = 0; rep_ < REPS(3); ++rep_) mixer_phase(l + 2 * rep_, rep_ ? ((DUP_MASK >> 10) & 3) : 0); } SEAM(pb + 1);
        if (PHON(4) && IN(pb + 2)) { PHASE_PTRS();
            gm::SchedMerge S{(const char*)yfox, (const char*)(wl + WL_WBF), (const char*)yret, (const char*)(wl + WL_WBR), 64, 8, F.G, F.bx};
            gm::EpiMerge E{proj, mg};
            for (int rep_ = 0; rep_ < REPS(4); ++rep_) gm::gemm_phase<true, false>(F.lds, S, E);
        } SEAM(pb + 2);
        if (PHON(5) && IN(pb + 3)) { PHASE_PTRS();
            gm::SchedDense S{(const char*)mg, (const char*)(wl + WL_WOUT), 2048 * 2, 2048 * 2, 32, 64, 8, F.G, F.bx, 0};
            gm::EpiMix E{yret};
            for (int rep_ = 0; rep_ < REPS(5); ++rep_) gm::gemm_phase<true, false>(F.lds, S, E);
        } SEAM(pb + 3);
        if (PHON(6) && IN(pb + 4)) { PHASE_PTRS();
            LnArgs a{}; a.zin = hf; a.mix = yret; a.hf = z1; a.hb = nullptr; a.h8 = (unsigned char*)hb; a.g = INP(8) + l * DM; a.b = INP(9) + l * DM;
            a.whi = (const bf16_t*)(ws + WS_SKW + 2 * SKW_FGT_BYTES + (size_t)l * SKW_RTR_BYTES); a.wlo = a.whi + 48 * 2048; a.S12 = (const float*)(ws + WS_SKS + (size_t)(2 + l) * 512);
            a.brg = INP(11) + l * 4; a.bre = INP(13) + l * 32; a.route_out = route; a.list = list; a.wlist = wlist; a.cnt = (unsigned*)(F.ctl + CW_CNT + l * 2048);
            ln_pass<1, 3, true>(F, a);
        } SEAM(pb + 4);
        if (PHON(7) && IN(pb + 5)) { PHASE_PTRS();
            moe_tables(F, l);
            gm::SchedMoe<true> S{tab, (const char*)hb, (const char*)(wl + WL_WGU), list, 4, F.G, F.bx};
            gm::EpiMoe1 E{(unsigned char*)hid, wlist, tab};
            for (int rep_ = 0; rep_ < REPS(7); ++rep_) gm::gemm_phase<true, true>(F.lds, S, E);
        } SEAM(pb + 5);
        if (PHON(8) && IN(pb + 6)) { PHASE_PTRS();
            moe_tables(F, l);
            gm::SchedMoe<false> S{tab, (const char*)hid, (const char*)(wl + WL_WD), list, 8, F.G, F.bx};
            gm::EpiMoe2 E{ffo};
            for (int rep_ = 0; rep_ < REPS(8); ++rep_) gm::gemm_phase<true, true>(F.lds, S, E);
        } SEAM(pb + 6);
        if (PHON(9) && IN(pb + 7)) { PHASE_PTRS();
            if (l + 1 < NLAYER) for (int rep_ = 0; rep_ < REPS(0); ++rep_) p0_weights(F, l + 1);
            moe_tables(F, l);
            LnArgs a{}; a.zin = z1; a.ffo = ffo; a.route = route; a.tab = tab; a.g = INP(17) + l * DM; a.b = INP(18) + l * DM;
            if (l + 1 < NLAYER) { a.hf = hf; a.hb = hb; a.h8 = ws + WS_HB8; a.whi = (const bf16_t*)(ws + WS_SKW + (size_t)(l + 1) * SKW_FGT_BYTES); a.wlo = a.whi + 16 * 2048; a.S12 = (const float*)(ws + WS_SKS + (size_t)(l + 1) * 512);
                a.bfor = INP(4) + (l + 1) * 8; a.logf = logf; for (int rep_ = 0; rep_ < REPS(9); ++rep_) ln_pass<2, 1, true>(F, a); }
            else { a.hf = F.out; a.hb = nullptr; ln_pass<2, 1, false>(F, a); }
        } SEAM(pb + 7);
    }
#undef IN
#undef SEAM
#undef GRID_BAR
}

extern "C" void kernel_launch(void* const* d_in, const int* in_sizes, int n_in, void* d_out, int out_size, void* d_ws, size_t ws_size, hipStream_t stream) {
    static int grid = 0;
    if (grid == 0) {
        if (n_in != 19 || out_size != NTOK * DM || ws_size < WS_END) { fprintf(stderr, "kernel_launch: unexpected problem (n_in %d, out %d, ws %zu)\n", n_in, out_size, ws_size); grid = -1; }
        int dev = 0, cus = 0;
        if (grid == 0 && (hipGetDevice(&dev) != hipSuccess || hipDeviceGetAttribute(&cus, hipDeviceAttributeMultiprocessorCount, dev) != hipSuccess)) grid = -1;
        if (grid == 0 && hipFuncSetAttribute((const void*)hybrid_fwd, hipFuncAttributeMaxDynamicSharedMemorySize, LDS_BYTES) != hipSuccess) { fprintf(stderr, "kernel_launch: hipFuncSetAttribute failed\n"); grid = -1; }
        (void)hipGetLastError();
        if (grid == 0) grid = cus;
    }
    if (grid < 0) { (void)hipMemsetAsync(d_out, 0xFF, (size_t)out_size * 4, stream); return; }
    if (hipMemsetAsync((char*)d_ws + WS_CTL, 0, CTL_ZERO_BYTES, stream) != hipSuccess) return;
    Args a{};
    for (int i = 0; i < 19; ++i) a.in[i] = (const float*)d_in[i];
    a.out = (float*)d_out; a.ws = (unsigned char*)d_ws;
#if MK_N_LAUNCHES == 1
    a.ph_lo = 0; a.ph_hi = N_PHASES;
    hipLaunchKernelGGL(hybrid_fwd, dim3(grid), dim3(NWAVES * 64), LDS_BYTES, stream, a);
#else
    for (int ph = 0; ph < N_PHASES; ++ph) { a.ph_lo = ph; a.ph_hi = ph + 1; hipLaunchKernelGGL(hybrid_fwd, dim3(grid), dim3(NWAVES * 64), LDS_BYTES, stream, a); }
#endif
}
```

```cpp
#include <hip/hip_runtime.h>
#include <cstdio>
#include <cstdint>
#include <type_traits>

#ifndef MK_N_LAUNCHES
#define MK_N_LAUNCHES 1
#endif

#define LAS __attribute__((address_space(3)))
#define GAS __attribute__((address_space(1)))
typedef unsigned short bf16_t;
typedef short bf16x8 __attribute__((ext_vector_type(8)));
typedef short s16x4 __attribute__((ext_vector_type(4)));
typedef float f32x4 __attribute__((ext_vector_type(4)));
typedef float f32x2 __attribute__((ext_vector_type(2)));
typedef float f32x16 __attribute__((ext_vector_type(16)));
typedef unsigned u32x4 __attribute__((ext_vector_type(4)));
typedef unsigned u32x2 __attribute__((ext_vector_type(2)));
typedef GAS unsigned gu32;
#define RLX_AGENT __ATOMIC_RELAXED, __HIP_MEMORY_SCOPE_AGENT
#define LDS_WAIT() asm volatile("s_waitcnt lgkmcnt(0)" ::: "memory")
#define VM_WAIT() asm volatile("s_waitcnt vmcnt(0)" ::: "memory")
#define SBAR() __builtin_amdgcn_sched_barrier(0)

constexpr int NTOK = 16384, DM = 2048, SEQ = 2048, NBATCH = 8, NLAYER = 2;
constexpr int NPROJ = 13312;
constexpr int C_FQ = 0, C_FK = 1024, C_FV = 2048, C_RQ = 3072, C_RK = 4096, C_RV = 5120, C_RG = 7168, C_GF = 9216, C_GR = 11264;
constexpr int W_IN_COLS = 13320;
constexpr int NEXP = 32, DEXP = 512;
constexpr int HID_ROWS = 40960;
constexpr float ALPHA = 1.4142135623730951f;
constexpr float LN_EPS = 1e-5f, RMS_EPS = 1e-6f;
constexpr float LOG2E = 1.4426950408889634f;
constexpr float QSCALE = 0.08838834764831845f * LOG2E;
constexpr float KSCALE = 0.08838834764831845f;

constexpr size_t MiB = 1u << 20;
constexpr size_t WS_CTL = 0, CTL_ZERO_BYTES = 1 * MiB;
constexpr size_t WS_ROPE = 1 * MiB;
constexpr size_t WS_SKW = 2 * MiB;
constexpr size_t SKW_FGT_BYTES = 16 * 2048 * 2 * 2, SKW_RTR_BYTES = 48 * 2048 * 2 * 2;
constexpr size_t WS_SKS = 3 * MiB;
constexpr size_t WS_LOGF = 3 * MiB + 512 * 1024;
constexpr size_t WS_ROUTE = 4 * MiB;
constexpr size_t WS_LIST = 5 * MiB;
constexpr size_t WS_WLIST = 7 * MiB;
constexpr size_t WS_W = 16 * MiB;
constexpr size_t WL_WIN = 0, WL_WBF = 52 * MiB, WL_WBR = 56 * MiB, WL_WOUT = 64 * MiB, WL_WGU = 72 * MiB, WL_WD = 200 * MiB, WL_BYTES = 264 * MiB;
constexpr size_t WS_HF = 280 * MiB;
constexpr size_t WS_HB = 408 * MiB;
constexpr size_t WS_YF = 472 * MiB, WS_YR = 504 * MiB, WS_MG = 568 * MiB;
constexpr size_t WS_PROJ = 632 * MiB;
constexpr size_t WS_Z1 = WS_PROJ, WS_HID = WS_PROJ + 128 * MiB, WS_FFO = WS_PROJ + 168 * MiB;
constexpr size_t WS_END = 1048 * MiB;
static_assert(WS_FFO + (size_t)HID_ROWS * 2048 * 2 <= WS_END && WS_HID + (size_t)HID_ROWS * 512 * 2 <= WS_FFO, "overlay map");
constexpr int CW_TMO = 0;
constexpr int CW_BAR = 4096;
constexpr int CW_QUEUE = 8192;
constexpr int CW_MFLAG = 49152;
constexpr int CW_CNT = 9216;

constexpr int RING_BYTES = 131072;
constexpr int LDSCTL_OFF = RING_BYTES;
constexpr int MISC_OFF = LDSCTL_OFF;
constexpr int MOE_OFF = LDSCTL_OFF + 256;
constexpr int LNS_OFF = LDSCTL_OFF + 1024;
constexpr int LDS_BYTES = 163840;

__device__ __forceinline__ unsigned cvt_pk_bf16(float lo, float hi) { unsigned r; asm volatile("v_cvt_pk_bf16_f32 %0, %1, %2" : "=v"(r) : "v"(lo), "v"(hi)); return r; }
__device__ __forceinline__ unsigned f2bf(float f) { unsigned u = __builtin_bit_cast(unsigned, f); return (u + 0x7fffu + ((u >> 16) & 1u)) >> 16; }
__device__ __forceinline__ unsigned pk2(float lo, float hi) { return f2bf(lo) | (f2bf(hi) << 16); }
__device__ __forceinline__ float bf2f(unsigned short b) { return __builtin_bit_cast(float, ((unsigned)b) << 16); }
__device__ __forceinline__ float bflo(unsigned w) { return __builtin_bit_cast(float, w << 16); }
__device__ __forceinline__ float bfhi(unsigned w) { return __builtin_bit_cast(float, w & 0xffff0000u); }
__device__ __forceinline__ float fast_sigmoid(float x) { return __builtin_amdgcn_rcpf(1.0f + __builtin_amdgcn_exp2f(-x * LOG2E)); }
__device__ __forceinline__ int opaque_tid() { int t = threadIdx.x; asm volatile("" : "+v"(t)); return t; }
typedef int v4i_t __attribute__((ext_vector_type(4)));
typedef int v8i_t __attribute__((ext_vector_type(8)));
__device__ __forceinline__ unsigned pk4_fp8(float a, float b, float c_, float d) { int w = __builtin_amdgcn_cvt_pk_fp8_f32(a, b, 0, false); w = __builtin_amdgcn_cvt_pk_fp8_f32(c_, d, w, true); return (unsigned)w; }
constexpr float W8_SCALE = 32.f;
constexpr float HID8_SCALE = 64.f;
constexpr int N_BF16_TILES = 24, N_FP8_TILES = 28;
__host__ __device__ constexpr int tile_of_bf16(int i) { return 12 + i; }
__host__ __device__ constexpr int tile_of_fp8(int i) { return i < 12 ? i : 36 + (i - 12); }
__host__ __device__ constexpr int slot_of_tile(int t) { return t < 12 ? ~t : t < 36 ? t - 12 : ~(12 + (t - 36)); }
constexpr size_t WL_WIN8 = WL_WIN + (size_t)N_BF16_TILES * 256 * 2048 * 2;
constexpr size_t WS_HB8 = WS_MG;
constexpr size_t PJ_M = (size_t)1 << 20;
constexpr size_t PJ_FQ = 0, PJ_FK = 16 * PJ_M, PJ_FV = 32 * PJ_M, PJ_RQ = 48 * PJ_M, PJ_RK = 64 * PJ_M, PJ_RV = 80 * PJ_M, PJ_RG = 112 * PJ_M, PJ_GF = 144 * PJ_M, PJ_GR = 176 * PJ_M;
static_assert((PJ_GR + 32 * PJ_M) * 2 == (size_t)NTOK * NPROJ * 2, "proj region map");
constexpr int RSEG = 4, RCPS = (SEQ / 64) / RSEG;
constexpr size_t WS_RLOC = WS_MG;
constexpr int CW_RFLAG = 32768;
constexpr float Y8_SCALE = 16.f;
namespace gm {
constexpr int BM = 256, BK = 64, HALF = 128, HTB = HALF * BK * 2, STAGE_BYTES = 8 * HTB, NXCD = 8, WGM = 8;
__host__ __device__ __forceinline__ int lds_byte(int r, int c) { const int st = (r >> 4) * 2 + (c >> 5), rr = r & 15, cc = c & 31, ob = rr * 64 + cc * 2; return st * 1024 + (ob ^ (((ob >> 9) & 1) << 5)); }
__host__ __device__ __forceinline__ void stage_rc(int b, int& R, int& C) { const int st = b / 1024, sb = b % 1024, swz = sb ^ (((sb >> 9) & 1) << 5); R = (st >> 1) * 16 + swz / 64; C = (st & 1) * 32 + (swz % 64) / 2; }
__host__ __device__ __forceinline__ int perm32(int rho) { const int n = rho >> 4, i = rho & 15; return 8 * (i >> 2) + 4 * n + (i & 3); }

struct Unit {
    const char* A;
    const char* B;
    unsigned lda, ldb;
    int nt;
    int pm, pn;
    int kind;
    int e, rows;
    int keep;
    int f8;
};
__device__ __forceinline__ bool static_tile(int L, int nM, int nN, int& pm, int& pn) {
    const int nwg = nM * nN; if (L >= nwg) return false;
    int wgid = L; { const int q = nwg / NXCD, r = nwg % NXCD, xcd = wgid % NXCD, off = wgid / NXCD; wgid = (xcd < r ? xcd * (q + 1) : r * (q + 1) + (xcd - r) * q) + off; }
    const int nig = WGM * nN, gid = wgid / nig, fm = gid * WGM, gsz = (nM - fm) < WGM ? (nM - fm) : WGM;
    pm = fm + ((wgid % nig) % gsz); pn = (wgid % nig) / gsz; return true;
}

template <class E, class = void> struct has_publish : std::false_type {};
template <class E> struct has_publish<E, std::void_t<decltype(&E::publish)>> : std::true_type {};
template <bool PERM, int FP8, class Sched, class Epi>
__device__ __forceinline__ void gemm_phase(LAS unsigned char* lds, const Sched& S, const Epi& E) {
    const int tid = opaque_tid(), wid = __builtin_amdgcn_readfirstlane(tid >> 6), lane = tid & 63, wr = wid >> 2, wc = wid & 3, fr = lane & 15, fq = lane >> 4;
    int Rr[2], Cc[2], Rb[2];
#pragma unroll
    for (int i = 0; i < 2; ++i) { int R, C; stage_rc(tid * 16 + i * 8192, R, C); Rr[i] = R; Cc[i] = C; Rb[i] = PERM ? ((R & ~31) + perm32(R & 31)) : R; }
    const unsigned ldsw = (unsigned)wid * 1024u;
    const int aoff = lds_byte(wr * 64 + fr, fq * 8), boff = lds_byte(wc * 32 + fr, fq * 8);
#define PG8_SA(b, h) (((b) * 2 + (h)) * HTB)
#define PG8_SB(b, h) ((4 + (b) * 2 + (h)) * HTB)
#define PG8_STAGE(bufoff, gbase, voff) do { _Pragma("unroll") for (int _i = 0; _i < 2; ++_i) \
        __builtin_amdgcn_global_load_lds((const unsigned*)((const char*)(gbase) + (voff)[_i]), (LAS unsigned*)(lds + (bufoff) + ldsw + _i * 8192), 16, 0, 0); } while (0)
#define PG8_LD8(p_) __builtin_shufflevector(*(const LAS v4i_t*)(p_), *(const LAS v4i_t*)((p_) + 1024), 0, 1, 2, 3, 4, 5, 6, 7)
#define PG8_LDA(dst, b, h) do { _Pragma("unroll") for (int m = 0; m < 4; ++m) dst[m] = PG8_LD8(lds + PG8_SA(b, h) + aoff + m * 2048); } while (0)
#define PG8_LDB(dst, b, h) do { _Pragma("unroll") for (int n = 0; n < 2; ++n) dst[n] = PG8_LD8(lds + PG8_SB(b, h) + boff + n * 2048); } while (0)
#define PG8_LO(v_) __builtin_bit_cast(bf16x8, __builtin_shufflevector(v_, v_, 0, 1, 2, 3))
#define PG8_HI(v_) __builtin_bit_cast(bf16x8, __builtin_shufflevector(v_, v_, 4, 5, 6, 7))
#define PG8_MMA8(ai, bj, At, Bt) do { _Pragma("unroll") for (int m = 0; m < 4; ++m) _Pragma("unroll") for (int n = 0; n < 2; ++n) \
            acc[ai][bj][m][n] = __builtin_amdgcn_mfma_scale_f32_16x16x128_f8f6f4(Bt[n], At[m], acc[ai][bj][m][n], 0, 0, 0, 0x7f7f7f7f, 0, 0x7f7f7f7f); } while (0)
#define PG8_MMA16(ai, bj, At, Bt) do { _Pragma("unroll") for (int m = 0; m < 4; ++m) _Pragma("unroll") for (int n = 0; n < 2; ++n) { \
            acc[ai][bj][m][n] = __builtin_amdgcn_mfma_f32_16x16x32_bf16(PG8_LO(Bt[n]), PG8_LO(At[m]), acc[ai][bj][m][n], 0, 0, 0); \
            acc[ai][bj][m][n] = __builtin_amdgcn_mfma_f32_16x16x32_bf16(PG8_HI(Bt[n]), PG8_HI(At[m]), acc[ai][bj][m][n], 0, 0, 0); } } while (0)
#define PG8_MMAF8(ai, bj, At, Bt) do { __builtin_amdgcn_s_setprio(1); PG8_MMA8(ai, bj, At, Bt); __builtin_amdgcn_s_setprio(0); } while (0)
#define PG8_MMAF16(ai, bj, At, Bt) do { __builtin_amdgcn_s_setprio(1); PG8_MMA16(ai, bj, At, Bt); __builtin_amdgcn_s_setprio(0); } while (0)
#define PG8_WAIT_V(n) asm volatile("s_waitcnt vmcnt(" #n ")" ::: "memory")
#define PG8_WAIT_L(n) asm volatile("s_waitcnt lgkmcnt(" #n ")" ::: "memory")
#define PG8_BAR __builtin_amdgcn_s_barrier()
#define PG8_SCHED __builtin_amdgcn_sched_barrier(0)
#define PG8_OFFS(u, tk) do { _Pragma("unroll") for (int _i = 0; _i < 2; ++_i) { \
        vA0[_i] = (Sched::GATHER ? (unsigned)tk[_i] : (unsigned)Rr[_i]) * (u).lda + (unsigned)Cc[_i] * 2u; vA1[_i] = (Sched::GATHER ? (unsigned)tk[2 + _i] : (unsigned)(HALF + Rr[_i])) * (u).lda + (unsigned)Cc[_i] * 2u; \
        vB[_i] = (unsigned)Rb[_i] * (u).ldb + (unsigned)Cc[_i] * 2u; } } while (0)
#define PG8_TOKS(u, tk) do { if (Sched::GATHER) { tk[0] = S.tok(u, Rr[0]); tk[1] = S.tok(u, Rr[1]); tk[2] = S.tok(u, HALF + Rr[0]); tk[3] = S.tok(u, HALF + Rr[1]); } } while (0)
    Unit cur, nxt; int ui = 0;
    if (!S.next(0, cur)) return;
    f32x4 acc[2][2][4][2];
#pragma unroll
    for (int a = 0; a < 2; ++a)
#pragma unroll
        for (int b = 0; b < 2; ++b)
#pragma unroll
            for (int m = 0; m < 4; ++m)
#pragma unroll
                for (int n = 0; n < 2; ++n) acc[a][b][m][n] = (f32x4){0.f, 0.f, 0.f, 0.f};
    v8i_t At[4], B0[2], B1[2];
    unsigned vA0[2], vA1[2], vB[2];
    int tk[4] = {0, 0, 0, 0};
    PG8_TOKS(cur, tk); PG8_OFFS(cur, tk);
    const char* cA = cur.A; const char* cB = cur.B; size_t hB = (size_t)HALF * cur.ldb;
    const size_t kstep = (size_t)(BK * 2);
    PG8_STAGE(PG8_SB(0, 0), cB, vB); PG8_STAGE(PG8_SB(0, 1), cB + hB, vB); PG8_STAGE(PG8_SA(0, 0), cA, vA0); PG8_STAGE(PG8_SA(0, 1), cA, vA1);
    if (wr == 1) PG8_BAR;
    PG8_WAIT_V(2); PG8_BAR;
    PG8_STAGE(PG8_SB(1, 0), cB + kstep, vB); PG8_STAGE(PG8_SA(1, 0), cA + kstep, vA0); PG8_STAGE(PG8_SB(1, 1), cB + hB + kstep, vB);
    PG8_WAIT_V(6); PG8_BAR;
#define PG8_UNIT(MMX_) do { \
        bool has_next = false; \
        const char* nAp = cA; const char* nBp = cB; size_t nhB = hB; \
        int nt = cur.nt; asm volatile("" : "+s"(nt)); \
        for (int t = 0; t < nt; t += 2) { \
            const bool last = (t == nt - 2); \
            asm volatile("" : "+v"(vA0[0]), "+v"(vA0[1]), "+v"(vA1[0]), "+v"(vA1[1]), "+v"(vB[0]), "+v"(vB[1])); \
            if (last) { has_next = S.next(ui + 1, nxt); if (has_next) { nAp = nxt.A; nBp = nxt.B; nhB = (size_t)HALF * nxt.ldb; } } \
            const char* a1 = cA + (size_t)(t + 1) * kstep; \
            const char* a2 = last ? nAp : cA + (size_t)(t + 2) * kstep; const char* b2 = last ? nBp : cB + (size_t)(t + 2) * kstep; \
            const char* a3 = a2 + kstep; const char* b3 = b2 + kstep; \
            const size_t h2 = last ? nhB : hB; \
            PG8_LDB(B0, 0, 0); PG8_LDB(B1, 0, 1); PG8_SCHED; PG8_LDA(At, 0, 0); PG8_STAGE(PG8_SA(1, 1), a1, vA1); \
            if (last && has_next) { PG8_TOKS(nxt, tk); PG8_OFFS(nxt, tk); } \
            PG8_WAIT_V(8); PG8_WAIT_L(0); PG8_BAR; MMX_(0, 0, At, B0); MMX_(0, 1, At, B1); PG8_BAR; PG8_SCHED; \
            PG8_LDA(At, 0, 1); PG8_STAGE(PG8_SB(0, 0), b2, vB); PG8_STAGE(PG8_SB(0, 1), b2 + h2, vB); PG8_STAGE(PG8_SA(0, 0), a2, vA0); \
            PG8_WAIT_V(8); PG8_WAIT_L(0); PG8_BAR; MMX_(1, 0, At, B0); MMX_(1, 1, At, B1); PG8_BAR; PG8_SCHED; \
            PG8_LDB(B0, 1, 0); PG8_LDB(B1, 1, 1); PG8_SCHED; PG8_LDA(At, 1, 0); PG8_STAGE(PG8_SA(0, 1), a2, vA1); \
            PG8_WAIT_V(8); PG8_WAIT_L(0); PG8_BAR; MMX_(0, 0, At, B0); MMX_(0, 1, At, B1); PG8_BAR; PG8_SCHED; \
            PG8_LDA(At, 1, 1); PG8_STAGE(PG8_SB(1, 0), b3, vB); PG8_STAGE(PG8_SB(1, 1), b3 + h2, vB); PG8_STAGE(PG8_SA(1, 0), a3, vA0); \
            PG8_WAIT_V(8); PG8_WAIT_L(0); PG8_BAR; MMX_(1, 0, At, B0); MMX_(1, 1, At, B1); PG8_BAR; PG8_SCHED; \
        } \
        if (wr == 0) PG8_BAR; \
        { const int tz = opaque_tid() & 63; E(acc, cur, wr, wc, tz & 15, tz >> 4); } \
        if constexpr (has_publish<Epi>::value) E.publish(cur); \
        if (!has_next) { done = true; } else { \
        if (!cur.keep) { \
        _Pragma("unroll") \
            for (int a = 0; a < 2; ++a) \
        _Pragma("unroll") \
                for (int b = 0; b < 2; ++b) \
        _Pragma("unroll") \
                    for (int m = 0; m < 4; ++m) \
        _Pragma("unroll") \
                        for (int n = 0; n < 2; ++n) acc[a][b][m][n] = (f32x4){0.f, 0.f, 0.f, 0.f}; \
        } \
        cur = nxt; cA = nAp; cB = nBp; hB = nhB; ++ui; \
        if (wr == 1) PG8_BAR; } \
    } while (0)
    bool done = false;
    for (;;) {
        if constexpr (FP8 == 2) { PG8_UNIT(PG8_MMAF8); if (done) break; PG8_UNIT(PG8_MMAF16); if (done) break; }
        else if constexpr (FP8 == 1) { PG8_UNIT(PG8_MMAF8); if (done) break; }
        else { PG8_UNIT(PG8_MMAF16); if (done) break; }
    }
#undef PG8_UNIT
    PG8_WAIT_V(0);
    PG8_BAR;
#undef PG8_SA
#undef PG8_SB
#undef PG8_STAGE
#undef PG8_LDA
#undef PG8_LD8
#undef PG8_LO
#undef PG8_HI
#undef PG8_LDB
#undef PG8_MMAF8
#undef PG8_MMAF16
#undef PG8_MMA8
#undef PG8_MMA16
#undef PG8_WAIT_V
#undef PG8_WAIT_L
#undef PG8_BAR
#undef PG8_SCHED
#undef PG8_OFFS
#undef PG8_TOKS
}
}
namespace gm {
struct SchedDense {
    const char* A; const char* B; unsigned lda, ldb; int nt, nM, nN, G, c, pmap;
    __device__ __forceinline__ bool next(int i, Unit& u) const {
        int pm, pn; if (!static_tile(i * G + c, nM, nN, pm, pn)) return false;
        u.A = A + (size_t)pm * BM * lda; u.B = B + (size_t)pn * BM * ldb; u.lda = lda; u.ldb = ldb; u.nt = nt; u.pm = pm; u.pn = pmap == 0 ? pn : (pmap == 1 ? tile_of_bf16(pn) : tile_of_fp8(pn)); u.kind = 0; u.e = 0; u.rows = BM; u.keep = 0; u.f8 = 0; return true;
    }
    static constexpr bool GATHER = false;
    __device__ __forceinline__ int tok(const Unit&, int) const { return 0; }
};
struct SchedMerge {
    const char* Af; const char* Bf; const char* Ar; const char* Br; int nM, nN, G, c;
    __device__ __forceinline__ bool next(int i, Unit& u) const {
        int pm, pn; if (!static_tile((i >> 1) * G + c, nM, nN, pm, pn)) return false;
        if ((i & 1) == 0) { u.lda = 1024; u.ldb = 1024; u.A = Af + (size_t)pm * BM * u.lda; u.B = Bf + (size_t)pn * BM * u.ldb; u.nt = 8; u.kind = 0; u.keep = 1; u.f8 = 1; }
        else { u.lda = 2048 * 2; u.ldb = 2048 * 2; u.A = Ar + (size_t)pm * BM * u.lda; u.B = Br + (size_t)pn * BM * u.ldb; u.nt = 32; u.kind = 1; u.keep = 0; u.f8 = 0; }
        u.pm = pm; u.pn = pn; u.e = 0; u.rows = BM; return true;
    }
    static constexpr bool GATHER = false;
    __device__ __forceinline__ int tok(const Unit&, int) const { return 0; }
};
template <bool GATHER_> struct SchedMoe {
    static constexpr bool GATHER = GATHER_;
    const LAS int* tab;
    const char* A; const char* W;
    const int* list;
    int NCT, G, c;
    const gu32* flags;
    __device__ __forceinline__ bool next(int i, Unit& u) const {
        const int ntile = __builtin_amdgcn_readfirstlane(tab[96]); int L = i * G + c;
        if (!GATHER && flags) {
            const int nu1 = ntile * 4, n3 = nu1 - (nu1 / G) * G, P = 3;
            if (c < n3) L = P * (G - n3) + i * G + c; else L = i < P ? i * (G - n3) + (c - n3) : P * (G - n3) + (i - P) * G + c; }
        if (L >= ntile * NCT) return false;
        const int rt = L / NCT, ct = L % NCT; const int ln = opaque_tid() & 63;
        const int tbv = tab[64 + (ln & 31)];
        const int e = __builtin_amdgcn_readfirstlane(__popcll(__ballot(ln >= 1 && ln < 32 && tbv <= rt)));
        const int tl = rt - __builtin_amdgcn_readfirstlane(tab[64 + e]), rows = __builtin_amdgcn_readfirstlane(tab[e]) - tl * BM;
        u.e = e; u.rows = rows < BM ? rows : BM; u.pn = ct; u.kind = 0; u.keep = 0; u.f8 = 1;
        if (GATHER) { u.lda = 2048; u.ldb = 2048; u.nt = 16; u.A = A; u.B = W + ((size_t)e * 1024 + (size_t)ct * BM) * u.ldb; u.pm = tl; }
        else { u.lda = 512; u.ldb = 512; u.nt = 4; u.pm = __builtin_amdgcn_readfirstlane(tab[32 + e]) / BM + tl; u.A = A + (size_t)u.pm * BM * u.lda; u.B = W + ((size_t)e * 2048 + (size_t)ct * BM) * u.ldb;
            if (flags) { const gu32* fp = flags + rt * 16; int spins = 0;
                while (__hip_atomic_load(fp, __ATOMIC_RELAXED, __HIP_MEMORY_SCOPE_AGENT) < 32u && ++spins < (1 << 22)) __builtin_amdgcn_s_sleep(2);
                asm volatile("" ::: "memory"); } }
        return true;
    }
    __device__ __forceinline__ int tok(const Unit& u, int r) const { return (r < u.rows) ? list[u.e * 16384 + u.pm * BM + r] : 0; }
};

struct EpiProj {
    bf16_t* proj; const float* cosT; const float* sinT; float accs;
    __device__ __forceinline__ void operator()(const f32x4 (&acc)[2][2][4][2], const Unit& u, int wr, int wc, int fr, int fq) const {
        const int colt = u.pn * BM; const int row0 = u.pm * BM + wr * 64 + fr, col0 = colt + wc * 32 + 8 * fq;
        int kind; float sc = 1.f;
        if (colt < C_FK) { kind = 0; sc = QSCALE; } else if (colt < C_RQ) kind = 0; else if (colt < C_RV) { kind = 1; sc = (colt >= C_RK) ? KSCALE : 1.f; } else if (colt < C_RG) kind = 0; else if (colt < C_GF) kind = 2; else kind = 3;
        const int j0 = 16 * wc + 4 * fq;
#pragma unroll
        for (int ai = 0; ai < 2; ++ai)
#pragma unroll
            for (int m = 0; m < 4; ++m) { const int row = row0 + ai * HALF + m * 16; const int bb = row >> 11, ss = row & (SEQ - 1);
                size_t rb; int bjstep;
                if (colt < C_RV) { const int si = colt >> 10, h0 = (colt & 1023) >> 7; rb = (size_t)si * (16 * PJ_M) + ((size_t)(bb * 8 + h0) * SEQ + ss) * 128 + wc * 32 + 8 * fq; bjstep = SEQ * 128; }
                else if (colt < C_RG) { const int hh = (colt - C_RV) >> 8; rb = PJ_RV + ((size_t)(bb * 8 + hh) * SEQ + ss) * 256 + wc * 32 + 8 * fq; bjstep = 128; }
                else { const int si2 = (colt - C_RG) >> 11; rb = PJ_RG + (size_t)si2 * (32 * PJ_M) + (size_t)row * 2048 + ((colt - C_RG) & 2047) + wc * 32 + 8 * fq; bjstep = 128; }
                bf16_t* rowp = proj + rb;
                f32x4 cs = (f32x4){1.f, 1.f, 1.f, 1.f}, sn = (f32x4){0.f, 0.f, 0.f, 0.f};
                if (kind == 1) { const int pos = row & (SEQ - 1); cs = *(const f32x4*)(cosT + pos * 64 + j0); sn = *(const f32x4*)(sinT + pos * 64 + j0); }
#pragma unroll
                for (int bj = 0; bj < 2; ++bj) { f32x4 v0 = acc[ai][bj][m][0] * accs, v1 = acc[ai][bj][m][1] * accs;
                    if (kind == 1) { const f32x4 y1 = v0 * cs - v1 * sn, y2 = v0 * sn + v1 * cs; v0 = y1 * sc; v1 = y2 * sc; }
                    else if (kind == 2) {
#pragma unroll
                        for (int j = 0; j < 4; ++j) { v0[j] = v0[j] * fast_sigmoid(v0[j]); v1[j] = v1[j] * fast_sigmoid(v1[j]); } }
                    else if (kind == 3) {
#pragma unroll
                        for (int j = 0; j < 4; ++j) { v0[j] = fast_sigmoid(v0[j]); v1[j] = fast_sigmoid(v1[j]); } }
                    else { v0 = v0 * sc; v1 = v1 * sc; }
                    u32x4 w; w.x = cvt_pk_bf16(v0[0], v0[1]); w.y = cvt_pk_bf16(v0[2], v0[3]); w.z = cvt_pk_bf16(v1[0], v1[1]); w.w = cvt_pk_bf16(v1[2], v1[3]);
                    *(u32x4*)(rowp + bj * bjstep) = w; } }
    }
};
struct EpiMerge {
    const bf16_t* proj; bf16_t* mg;
    __device__ __forceinline__ void operator()(f32x4 (&acc)[2][2][4][2], const Unit& u, int wr, int wc, int fr, int fq) const {
        const int row0 = u.pm * BM + wr * 64 + fr, col0 = u.pn * BM + wc * 32 + 8 * fq;
#pragma unroll
        for (int ai = 0; ai < 2; ++ai)
#pragma unroll
            for (int m = 0; m < 4; ++m) { const int row = row0 + ai * HALF + m * 16; const bf16_t* pr = proj + (size_t)row * 2048 + col0;
#pragma unroll
                for (int bj = 0; bj < 2; ++bj) {
                    const u32x4 gr = *(const u32x4*)(pr + PJ_GR + bj * HALF);
                    f32x4 r0 = (f32x4){bflo(gr.x), bfhi(gr.x), bflo(gr.y), bfhi(gr.y)}, r1 = (f32x4){bflo(gr.z), bfhi(gr.z), bflo(gr.w), bfhi(gr.w)};
                    if (u.kind == 0) { const u32x4 gf = *(const u32x4*)(pr + PJ_GF + bj * HALF);
                        const f32x4 f0 = (f32x4){bflo(gf.x), bfhi(gf.x), bflo(gf.y), bfhi(gf.y)}, f1 = (f32x4){bflo(gf.z), bfhi(gf.z), bflo(gf.w), bfhi(gf.w)};
#pragma unroll
                        for (int j = 0; j < 4; ++j) { acc[ai][bj][m][0][j] *= f0[j] * __builtin_amdgcn_rcpf(r0[j]) * (1.f / (W8_SCALE * Y8_SCALE)); acc[ai][bj][m][1][j] *= f1[j] * __builtin_amdgcn_rcpf(r1[j]) * (1.f / (W8_SCALE * Y8_SCALE)); } }
                    else { const f32x4 v0 = acc[ai][bj][m][0] * r0, v1 = acc[ai][bj][m][1] * r1;
                        u32x4 w; w.x = cvt_pk_bf16(v0[0], v0[1]); w.y = cvt_pk_bf16(v0[2], v0[3]); w.z = cvt_pk_bf16(v1[0], v1[1]); w.w = cvt_pk_bf16(v1[2], v1[3]);
                        *(u32x4*)(mg + (size_t)row * DM + col0 + bj * HALF) = w; } } }
    }
};
struct EpiMix {
    bf16_t* mix;
    __device__ __forceinline__ void operator()(const f32x4 (&acc)[2][2][4][2], const Unit& u, int wr, int wc, int fr, int fq) const {
        const int row0 = u.pm * BM + wr * 64 + fr, col0 = u.pn * BM + wc * 32 + 8 * fq;
#pragma unroll
        for (int ai = 0; ai < 2; ++ai)
#pragma unroll
            for (int m = 0; m < 4; ++m) { bf16_t* rowp = mix + (size_t)(row0 + ai * HALF + m * 16) * DM + col0;
#pragma unroll
                for (int bj = 0; bj < 2; ++bj) { const f32x4 v0 = acc[ai][bj][m][0], v1 = acc[ai][bj][m][1];
                    u32x4 w; w.x = cvt_pk_bf16(v0[0], v0[1]); w.y = cvt_pk_bf16(v0[2], v0[3]); w.z = cvt_pk_bf16(v1[0], v1[1]); w.w = cvt_pk_bf16(v1[2], v1[3]);
                    *(u32x4*)(rowp + bj * HALF) = w; } }
    }
};
struct EpiMoe1 {
    unsigned char* hid; const float* wlist; const LAS int* tab;
    gu32* flags;
    __device__ __forceinline__ void publish(const Unit& u) const {
        asm volatile("s_waitcnt vmcnt(0)" ::: "memory");
        if ((opaque_tid() & 63) == 0) __hip_atomic_fetch_add(flags + (__builtin_amdgcn_readfirstlane(tab[64 + u.e]) + u.pm) * 16, 1u, __ATOMIC_RELAXED, __HIP_MEMORY_SCOPE_AGENT);
    }
    __device__ __forceinline__ void operator()(const f32x4 (&acc)[2][2][4][2], const Unit& u, int wr, int wc, int fr, int fq) const {
        const int r0 = wr * 64 + fr, hc0 = u.pn * 128 + wc * 16 + 4 * fq; const int slot0 = __builtin_amdgcn_readfirstlane(tab[32 + u.e]) + u.pm * BM;
#pragma unroll
        for (int ai = 0; ai < 2; ++ai)
#pragma unroll
            for (int m = 0; m < 4; ++m) { const int r = r0 + ai * HALF + m * 16; if (r < u.rows) {
                const float w = wlist[u.e * 16384 + u.pm * BM + r] * HID8_SCALE; unsigned char* rowp = hid + (size_t)(slot0 + r) * DEXP + hc0;
#pragma unroll
                for (int bj = 0; bj < 2; ++bj) { const f32x4 g = acc[ai][bj][m][0] * (1.f / W8_SCALE), up = acc[ai][bj][m][1] * (1.f / W8_SCALE); f32x4 h;
#pragma unroll
                    for (int j = 0; j < 4; ++j) h[j] = g[j] * fast_sigmoid(g[j]) * up[j] * w;
                    __hip_atomic_store((unsigned*)(rowp + bj * 64), pk4_fp8(h[0], h[1], h[2], h[3]), __ATOMIC_RELAXED, __HIP_MEMORY_SCOPE_AGENT); } } }
    }
};
struct EpiMoe2 {
    bf16_t* ffo;
    __device__ __forceinline__ void operator()(const f32x4 (&acc)[2][2][4][2], const Unit& u, int wr, int wc, int fr, int fq) const {
        const int r0 = wr * 64 + fr, col0 = u.pn * BM + wc * 32 + 8 * fq;
#pragma unroll
        for (int ai = 0; ai < 2; ++ai)
#pragma unroll
            for (int m = 0; m < 4; ++m) { const int r = r0 + ai * HALF + m * 16; if (r < u.rows) { bf16_t* rowp = ffo + (size_t)(u.pm * BM + r) * DM + col0;
#pragma unroll
                for (int bj = 0; bj < 2; ++bj) { const f32x4 v0 = acc[ai][bj][m][0] * (1.f / (W8_SCALE * HID8_SCALE)), v1 = acc[ai][bj][m][1] * (1.f / (W8_SCALE * HID8_SCALE));
                    u32x4 w; w.x = cvt_pk_bf16(v0[0], v0[1]); w.y = cvt_pk_bf16(v0[2], v0[3]); w.z = cvt_pk_bf16(v1[0], v1[1]); w.w = cvt_pk_bf16(v1[2], v1[3]);
                    *(u32x4*)(rowp + bj * HALF) = w; } } }
    }
};
}
#define XB_TMO      128
#define XB_XCNT(j)  (256  + 64 * (j))
#define XB_XSUB(j)  (1280 + 64 * (j))
#define XB_XGEN(j)  (2304 + 64 * (j))
#define XB_TOP      3328
#define XB_TOPGEN   3392
#define XCD_BAR_WORDS 3456
#define XB_SPIN_CAP (1u << 18)
__device__ __forceinline__ unsigned xb_ld(unsigned* p)              { return __hip_atomic_load(p, __ATOMIC_RELAXED, __HIP_MEMORY_SCOPE_AGENT); }
__device__ __forceinline__ unsigned xb_add(unsigned* p, unsigned v) { return __hip_atomic_fetch_add(p, v, __ATOMIC_RELAXED, __HIP_MEMORY_SCOPE_AGENT); }
__device__ __forceinline__ unsigned xb_xcc_id() { return (unsigned)__builtin_amdgcn_s_getreg((3 << 11) | 20) & 0xFu; }
#define XB_SPIN(cond, bar) do { unsigned _sp = 0; while (cond) { __builtin_amdgcn_s_sleep(1); \
    if ((++_sp & 255u) == 0u) { if (xb_ld(&(bar)[XB_TMO])) break; if (_sp > XB_SPIN_CAP) { atomicAdd(&(bar)[XB_TMO], 1u); break; } } } } while (0)
struct XcdBarrier { unsigned* bar; unsigned x; volatile LAS unsigned* st; };
__device__ __forceinline__ XcdBarrier xcd_barrier_post(unsigned* bar, volatile LAS unsigned* st) {
    XcdBarrier b; b.bar = bar; b.x = xb_xcc_id(); b.st = st;
    if (threadIdx.x == 0) (void)xb_add(&bar[XB_XCNT(b.x)], 1u);
    return b;
}
__device__ __forceinline__ void xcd_barrier_complete(unsigned* bar, unsigned x, unsigned& nloc, unsigned& nx) {
    const unsigned G = gridDim.x * gridDim.y * gridDim.z;
    unsigned sum, cnt, mine, sp = 0u;
    for (;;) {
        sum = 0u; cnt = 0u; mine = 0u;
#pragma unroll
        for (unsigned j = 0; j < 16; ++j) { const unsigned c = xb_ld(&bar[XB_XCNT(j)]); sum += c; cnt += (c > 0u) ? 1u : 0u; mine = (j == x) ? c : mine; }
        if (sum == G) break;
        __builtin_amdgcn_s_sleep(1);
        if ((++sp & 255u) == 0u) { if (xb_ld(&bar[XB_TMO])) break; if (sp > XB_SPIN_CAP) { atomicAdd(&bar[XB_TMO], 1u); break; } }
    }
    nloc = mine > 0u ? mine : 1u; nx = cnt > 0u ? cnt : 1u;
}
__device__ __forceinline__ void xcd_barrier(const XcdBarrier& b) {
    asm volatile("s_waitcnt vmcnt(0)" ::: "memory");
    __syncthreads();
    if (threadIdx.x == 0) {
        unsigned* bar = b.bar;
        __builtin_amdgcn_s_waitcnt(0);
        unsigned nloc = b.st[0], nx = b.st[1];
        if (nloc == 0u) { xcd_barrier_complete(bar, b.x, nloc, nx); b.st[0] = nloc; b.st[1] = nx; }
        const unsigned old = xb_add(&bar[XB_XSUB(b.x)], 1u);
        const unsigned gen = old / nloc;
        if (old + 1u == (gen + 1u) * nloc) {
            __builtin_amdgcn_fence(__ATOMIC_RELEASE, "agent");
            asm volatile("s_waitcnt vmcnt(0)" ::: "memory");
            const unsigned og = xb_add(&bar[XB_TOP], 1u);
            const unsigned tg = og / nx;
            if (og + 1u == (tg + 1u) * nx) xb_add(&bar[XB_TOPGEN], 1u);
            else XB_SPIN(xb_ld(&bar[XB_TOPGEN]) == tg, bar);
            __builtin_amdgcn_fence(__ATOMIC_ACQUIRE, "agent");
            xb_add(&bar[XB_XGEN(b.x)], 1u);
            asm volatile("s_waitcnt vmcnt(0)" ::: "memory");
        } else {
            XB_SPIN(xb_ld(&bar[XB_XGEN(b.x)]) == gen, bar);
            __builtin_amdgcn_fence(__ATOMIC_ACQUIRE, "agent");
            asm volatile("s_waitcnt vmcnt(0)" ::: "memory");
        }
    }
    __syncthreads();
}

constexpr int NWAVES = 8;
struct Frame {
    LAS unsigned char* lds; volatile LAS unsigned* MISC; gu32* ctl;
    int tid, lane, wave, G, bx;
    unsigned char* ws;
    float* out;
};
#define INP(i) ((const float*)(const GAS float*)(((const float* const*)__builtin_amdgcn_kernarg_segment_ptr())[i]))
#define KWS() ((unsigned char*)(GAS unsigned char*)(((unsigned char* const*)__builtin_amdgcn_kernarg_segment_ptr())[20]))
__device__ __forceinline__ float wave_sum(float v) {
#pragma unroll
    for (int o = 1; o < 64; o <<= 1) v += __shfl_xor(v, o);
    return v;
}

__device__ __forceinline__ void p0_transpose_item(const float* colp, size_t pitch, bf16_t* WT, int K, int n0, int k0, LAS float* scr, int lane) {
    float tv[32];
#pragma unroll
    for (int i = 0; i < 32; ++i) { const int kk = 2 * i + (lane >> 5); tv[i] = colp[(size_t)(k0 + kk) * pitch]; }
#pragma unroll
    for (int i = 0; i < 32; ++i) { const int kk = 2 * i + (lane >> 5); scr[kk * 33 + (lane & 31)] = tv[i]; }
    LDS_WAIT(); asm volatile("" ::: "memory");
    const int c = lane & 7;
#pragma unroll
    for (int j = 0; j < 4; ++j) { const int n = (lane >> 3) + 8 * j; const LAS float* s = scr + (8 * c) * 33 + n;
        u32x4 o; o.x = pk2(s[0 * 33], s[1 * 33]); o.y = pk2(s[2 * 33], s[3 * 33]); o.z = pk2(s[4 * 33], s[5 * 33]); o.w = pk2(s[6 * 33], s[7 * 33]);
        *(GAS u32x4*)(WT + (size_t)(n0 + n) * K + k0 + 8 * c) = o; }
    LDS_WAIT(); asm volatile("" ::: "memory");
}
__device__ __forceinline__ void p0_transpose_item8(const float* colp, size_t pitch, unsigned char* WT8, int K, int n0, int k0, float scale, LAS float* scr, int lane) {
    float tv[32];
#pragma unroll
    for (int i = 0; i < 32; ++i) { const int kk = 2 * i + (lane >> 5); tv[i] = colp[(size_t)(k0 + kk) * pitch]; }
#pragma unroll
    for (int i = 0; i < 32; ++i) { const int kk = 2 * i + (lane >> 5); scr[kk * 33 + (lane & 31)] = tv[i] * scale; }
    LDS_WAIT(); asm volatile("" ::: "memory");
    const int c = lane & 7;
#pragma unroll
    for (int j = 0; j < 4; ++j) { const int n = (lane >> 3) + 8 * j; const LAS float* s = scr + (8 * c) * 33 + n;
        u32x2 o; o.x = pk4_fp8(s[0 * 33], s[1 * 33], s[2 * 33], s[3 * 33]); o.y = pk4_fp8(s[4 * 33], s[5 * 33], s[6 * 33], s[7 * 33]);
        *(GAS u32x2*)(WT8 + (size_t)(n0 + n) * K + k0 + 8 * c) = o; }
    LDS_WAIT(); asm volatile("" ::: "memory");
}
__device__ __forceinline__ int win_srccol(int n) {
    if (n < C_RQ) return n;
    if (n < C_RV) { const int hh = (n - C_RQ) >> 7, p = (n - C_RQ) & 127; return 3080 + hh * 128 + 4 * (p >> 3) + (p & 3) + 64 * ((p >> 2) & 1); }
    return n + 8;
}
constexpr int IT_WINB = 16 * 4 * N_BF16_TILES, IT_WIN8 = 16 * 4 * N_FP8_TILES, IT_WIN = IT_WINB + IT_WIN8;
constexpr int IT_BF = 8 * 32, IT_BR = 16 * 32, IT_OUT = 16 * 32, IT_GU = 32 * 16 * 16, IT_D = 32 * 4 * 32, IT_LAYER = IT_WIN + IT_BF + IT_BR + IT_OUT + IT_GU + IT_D;
__device__ __forceinline__ void cv_item(const float* colp, size_t pitch, unsigned char* dst, int K, int n0, int k0, bool f8, int lane) {
    const int nq = lane & 15, rg = lane >> 4;
    f32x4 v[32];
    const float* cp = colp + (size_t)(k0 + 32 * rg) * pitch;
#pragma unroll
    for (int i = 0; i < 32; ++i) v[i] = *(const f32x4*)(cp + (size_t)i * pitch);
    if (f8) { unsigned char* dp = dst + (size_t)(n0 + 4 * nq) * K + k0 + 32 * rg;
#pragma unroll
        for (int t = 0; t < 4; ++t) { u32x4 o0, o1;
#define CV_P4(i_) pk4_fp8(v[i_][t] * W8_SCALE, v[(i_) + 1][t] * W8_SCALE, v[(i_) + 2][t] * W8_SCALE, v[(i_) + 3][t] * W8_SCALE)
            o0.x = CV_P4(0); o0.y = CV_P4(4); o0.z = CV_P4(8); o0.w = CV_P4(12); o1.x = CV_P4(16); o1.y = CV_P4(20); o1.z = CV_P4(24); o1.w = CV_P4(28);
#undef CV_P4
            *(u32x4*)(dp + (size_t)t * K) = o0; *(u32x4*)(dp + (size_t)t * K + 16) = o1; } }
    else { unsigned char* dp = dst + 2 * ((size_t)(n0 + 4 * nq) * K + k0 + 32 * rg);
#pragma unroll
        for (int t = 0; t < 4; ++t)
#pragma unroll
            for (int m = 0; m < 4; ++m) { u32x4 o; o.x = pk2(v[8 * m][t], v[8 * m + 1][t]); o.y = pk2(v[8 * m + 2][t], v[8 * m + 3][t]); o.z = pk2(v[8 * m + 4][t], v[8 * m + 5][t]); o.w = pk2(v[8 * m + 6][t], v[8 * m + 7][t]);
                *(u32x4*)(dp + (size_t)t * 2 * K + 16 * m) = o; } }
}
__device__ __forceinline__ void cv_one(int l, int it, unsigned char* ws, int lane) {
    unsigned char* wl = ws + WS_W; const int n4 = 4 * (lane & 15);
    const float* src; int pitch, K, n0, k0; unsigned char* dst; bool f8;
    int r = it;
    if (r < IT_WINB) { const int kb = r / (4 * N_BF16_TILES), sb = r % (4 * N_BF16_TILES), nb = tile_of_bf16(sb >> 2) * 4 + (sb & 3);
        src = INP(3) + (size_t)l * DM * W_IN_COLS + win_srccol(64 * nb + n4); pitch = W_IN_COLS; K = 2048; k0 = 128 * kb; dst = wl + WL_WIN; n0 = 64 * sb; f8 = false; }
    else if ((r -= IT_WINB) < IT_WIN8) { const int kb = r / (4 * N_FP8_TILES), sb = r % (4 * N_FP8_TILES), nb = tile_of_fp8(sb >> 2) * 4 + (sb & 3);
        src = INP(3) + (size_t)l * DM * W_IN_COLS + win_srccol(64 * nb + n4); pitch = W_IN_COLS; K = 2048; k0 = 128 * kb; dst = wl + WL_WIN8; n0 = 64 * sb; f8 = true; }
    else if ((r -= IT_WIN8) < IT_BF) { const int kb = r / 32, nb = r % 32; src = INP(5) + (size_t)l * 1024 * DM + 64 * nb + n4; pitch = DM; dst = wl + WL_WBF; K = 1024; n0 = 64 * nb; k0 = 128 * kb; f8 = true; }
    else if ((r -= IT_BF) < IT_BR) { const int kb = r / 32, nb = r % 32; src = INP(6) + (size_t)l * 2048 * DM + 64 * nb + n4; pitch = DM; dst = wl + WL_WBR; K = 2048; n0 = 64 * nb; k0 = 128 * kb; f8 = false; }
    else if ((r -= IT_BR) < IT_OUT) { const int kb = r / 32, nb = r % 32; src = INP(7) + (size_t)l * 2048 * DM + 64 * nb + n4; pitch = DM; dst = wl + WL_WOUT; K = 2048; n0 = 64 * nb; k0 = 128 * kb; f8 = false; }
    else if ((r -= IT_OUT) < IT_GU) { const int e = r / 256, q = r % 256, kb = q / 16, nb = q % 16; const int row = 64 * nb + n4, col = 4 * (row >> 3);
        src = (((row >> 2) & 1) ? INP(15) : INP(14)) + (size_t)(l * NEXP + e) * DM * DEXP + col; pitch = DEXP; dst = wl + WL_WGU + (size_t)e * 1024 * 2048; K = 2048; n0 = 64 * nb; k0 = 128 * kb; f8 = true; }
    else { r -= IT_GU; const int e = r / 128, q = r % 128, kb = q / 32, nb = q % 32;
        src = INP(16) + (size_t)(l * NEXP + e) * DEXP * DM + 64 * nb + n4; pitch = DM; dst = wl + WL_WD + (size_t)e * 2048 * 512; K = 512; n0 = 64 * nb; k0 = 128 * kb; f8 = true; }
    cv_item(src, (size_t)pitch, dst, K, n0, k0, f8, lane);
}
constexpr int IT_REST = IT_LAYER - IT_WIN;
__device__ __forceinline__ void p0_weights_win(Frame& F) {
    const int gw = F.bx * NWAVES + F.wave, NGW = F.G * NWAVES;
    for (int it = gw; it < IT_WIN; it += NGW) cv_one(0, it, F.ws, F.lane);
}
__device__ __forceinline__ void p0_tables(Frame& F) {
    const int gw = F.bx * NWAVES + F.wave, NGW = F.G * NWAVES, lane = F.lane;
    { float* cosT = (float*)(F.ws + WS_ROPE); float* sinT = cosT + SEQ * 64;
      for (int i = (F.bx * NWAVES + F.wave) * 64 + lane; i < SEQ * 64; i += NGW * 64) { const int pos = i >> 6, j = i & 63;
          double pw = 1.0; for (int t = 0; t < j; ++t) pw *= 0.8659643233600653;
          const float inv = (float)pw; const double ang = (double)((float)pos * inv);
          const double qd = __builtin_rint(ang * 0.6366197723675814); const double r = ang - qd * 1.5707963267948966, r2 = r * r; const int qi = (int)qd & 3;
          const double sr = r * (1.0 + r2 * (-1.0 / 6 + r2 * (1.0 / 120 + r2 * (-1.0 / 5040 + r2 * (1.0 / 362880 + r2 * (-1.0 / 39916800))))));
          const double cr = 1.0 + r2 * (-0.5 + r2 * (1.0 / 24 + r2 * (-1.0 / 720 + r2 * (1.0 / 40320 + r2 * (-1.0 / 3628800 + r2 * (1.0 / 479001600))))));
          const double sv = (qi == 0) ? sr : (qi == 1) ? cr : (qi == 2) ? -sr : -cr, cv = (qi == 0) ? cr : (qi == 1) ? -sr : (qi == 2) ? -cr : sr;
          cosT[i] = (float)cv; sinT[i] = (float)sv; } }
    for (int job = F.wave * F.G + F.bx; job < 2 * 16 + 2 * 48; job += NGW) {
        int t, c; if (job < 32) { t = job >> 4; c = job & 15; } else { t = 2 + (job - 32) / 48; c = (job - 32) % 48; }
        const int l = t & 1; const float *g, *b; const float* W = nullptr; size_t pitch = 0;
        if (t < 2) { g = l ? INP(17) : INP(1); b = l ? INP(18) : INP(2); if (c < 8) { W = INP(3) + (size_t)l * DM * W_IN_COLS + 3072 + c; pitch = W_IN_COLS; } }
        else { g = INP(8) + l * DM; b = INP(9) + l * DM; if (c < 4) { W = INP(10) + (size_t)l * DM * 4 + c; pitch = 4; } else if (c < 36) { W = INP(12) + (size_t)l * DM * 32 + (c - 4); pitch = 32; } }
        bf16_t* hi = (bf16_t*)(F.ws + WS_SKW + (t < 2 ? (size_t)t * SKW_FGT_BYTES : 2 * SKW_FGT_BYTES + (size_t)(t - 2) * SKW_RTR_BYTES)); const int ncol = t < 2 ? 16 : 48; bf16_t* lo = hi + ncol * 2048;
        float s1 = 0.f, s2 = 0.f;
        for (int kk = 0; kk < DM; kk += 64 * 8) {
            float wv[8], gv[8], bv[8];
#pragma unroll
            for (int u = 0; u < 8; ++u) { const int k = kk + 64 * u + lane; wv[u] = W ? W[(size_t)k * pitch] : 0.f; gv[u] = g[k]; bv[u] = b[k]; }
#pragma unroll
            for (int u = 0; u < 8; ++u) { const int k = kk + 64 * u + lane; const float w = wv[u]; const float gw_ = gv[u] * w; const unsigned h16 = f2bf(gw_); const float hf_ = __builtin_bit_cast(float, h16 << 16); const unsigned l16 = f2bf(gw_ - hf_);
                hi[c * 2048 + k] = (bf16_t)h16; lo[c * 2048 + k] = (bf16_t)l16; s1 += hf_ + __builtin_bit_cast(float, l16 << 16); s2 += bv[u] * w; } }
        s1 = wave_sum(s1); s2 = wave_sum(s2);
        if (lane == 0) { float* S = (float*)(F.ws + WS_SKS + (size_t)t * 512); S[c] = s1; S[64 + c] = s2; }
    }
}
struct LnArgs {
    const float* zin;
    const bf16_t* zb;
    float* hf; bf16_t* hb;
    unsigned char* h8;
    const float* g; const float* b;
    const bf16_t* whi; const bf16_t* wlo; const float* S12;
    const bf16_t* ffo; const int* route;
    const bf16_t* mix;
    const LAS int* tab;
    const float* bfor; float* logf;
    const float* brg; const float* bre; int* route_out; int* list; float* wlist; unsigned* cnt;
};
template <int MODE, int NCG, bool PROJ>
__device__ __forceinline__ void ln_pass(Frame& F, const LnArgs& a) {
    const int lane = F.lane, w = F.wave, r = lane & 15, q = lane >> 4, tid = F.tid;
    LAS float* red = (LAS float*)(F.lds + LNS_OFF);
    LAS float* part = (LAS float*)(F.lds + LNS_OFF + 1024);
    LAS float* lg = (LAS float*)(F.lds + LNS_OFF + 1024 + 24576);
    LAS unsigned char* stash = F.lds + w * 16384;
#define LN_ISSUE(g_) do { const int row_ = (g_) * 16 + r; const int kb_ = 256 * w + 8 * q; \
        if (MODE == 2) { const int4 rt = *(const int4*)(a.route + row_ * 4); \
            const size_t sa = (size_t)(a.tab[32 + rt.x] + rt.y), sb = (size_t)(a.tab[32 + rt.z] + rt.w); \
            const bf16_t* pa = a.ffo + sa * DM + kb_; const bf16_t* pb = a.ffo + sb * DM + kb_; \
            _Pragma("unroll") for (int s = 0; s < 8; ++s) { __builtin_amdgcn_global_load_lds((const unsigned*)(pa + 32 * s), (LAS unsigned*)(stash + (2 * s) * 1024), 16, 0, 0); \
                __builtin_amdgcn_global_load_lds((const unsigned*)(pb + 32 * s), (LAS unsigned*)(stash + (2 * s + 1) * 1024), 16, 0, 0); } } \
        else if (MODE == 1) { const bf16_t* zp_ = a.zb + (size_t)row_ * DM + kb_; \
            _Pragma("unroll") for (int s = 0; s < 8; ++s) __builtin_amdgcn_global_load_lds((const unsigned*)(zp_ + 32 * s), (LAS unsigned*)(stash + s * 1024), 16, 0, 0); } \
        else { const float* zp_ = a.zin + (size_t)row_ * DM + kb_; \
            _Pragma("unroll") for (int s = 0; s < 8; ++s) { __builtin_amdgcn_global_load_lds((const unsigned*)(zp_ + 32 * s), (LAS unsigned*)(stash + (2 * s) * 1024), 16, 0, 0); \
                __builtin_amdgcn_global_load_lds((const unsigned*)(zp_ + 32 * s + 4), (LAS unsigned*)(stash + (2 * s + 1) * 1024), 16, 0, 0); } } } while (0)
    const int kb = 256 * w + 8 * q;
    unsigned gq[8][2][4];
#define LN_GLOAD() do { _Pragma("unroll") for (int s = 0; s < 8; ++s) _Pragma("unroll") for (int hh = 0; hh < 2; ++hh) { \
            const f32x4 gv = *(const f32x4*)(a.g + kb + 32 * s + 4 * hh), bv = *(const f32x4*)(a.b + kb + 32 * s + 4 * hh); \
            gq[s][hh][0] = __builtin_bit_cast(unsigned, __builtin_amdgcn_cvt_pkrtz(gv[0] - 1.f, gv[1] - 1.f)); gq[s][hh][1] = __builtin_bit_cast(unsigned, __builtin_amdgcn_cvt_pkrtz(gv[2] - 1.f, gv[3] - 1.f)); \
            gq[s][hh][2] = __builtin_bit_cast(unsigned, __builtin_amdgcn_cvt_pkrtz(bv[0], bv[1])); gq[s][hh][3] = __builtin_bit_cast(unsigned, __builtin_amdgcn_cvt_pkrtz(bv[2], bv[3])); } } while (0)
    constexpr bool GRES = (MODE != 1);
    if (GRES) LN_GLOAD();
    typedef _Float16 h16x2 __attribute__((ext_vector_type(2)));
#define LN_UNPK(dst, s_, hh_, i_) do { unsigned u0_ = gq[s_][hh_][i_], u1_ = gq[s_][hh_][(i_) + 1]; asm volatile("" : "+v"(u0_), "+v"(u1_)); const h16x2 h0_ = __builtin_bit_cast(h16x2, u0_), h1_ = __builtin_bit_cast(h16x2, u1_); \
        dst = (f32x4){(float)h0_[0], (float)h0_[1], (float)h1_[0], (float)h1_[1]}; } while (0)
    LAS float* tb = (LAS float*)(F.lds + LNS_OFF + 1024 + 24576 + 3072);
    LAS int* rrec = (LAS int*)(F.lds + LNS_OFF + 1024 + 24576 + 3072 + 256);
    LAS int* lcnt = rrec + 64 * 8;
    if (MODE == 1 && tid < 64) lcnt[tid] = 0;
    int nrec = 0;
    float s1a = 0.f, s2a = 0.f, s1b = 0.f, s2b = 0.f;
    if (PROJ) {
        if (MODE != 1) { if (tid < 8) tb[tid] = a.bfor[tid]; } else { if (tid < 4) tb[16 + tid] = a.brg[tid]; if (tid >= 32 && tid < 64) tb[tid] = a.bre[tid - 32]; }
        if (tid < 16 * 16 * NCG) { const int cc = tid % (16 * NCG); s1a = a.S12[cc]; s2a = a.S12[64 + cc]; }
        if (tid + NWAVES * 64 < 16 * 16 * NCG) { const int cc = (tid + NWAVES * 64) % (16 * NCG); s1b = a.S12[cc]; s2b = a.S12[64 + cc]; }
    }
    asm volatile("s_waitcnt vmcnt(0)" ::: "memory");
    if (F.bx < NTOK / 16) LN_ISSUE(F.bx);
    for (int gi = F.bx; gi < NTOK / 16; gi += F.G) {
        const int row = gi * 16 + r;
        f32x4 z[8][2];
        if (MODE == 2) {
            f32x4 rh[8][2];
            { const float* zp_ = a.zin + (size_t)row * DM + kb;
#pragma unroll
              for (int s = 0; s < 8; ++s) { rh[s][0] = *(const f32x4*)(zp_ + 32 * s); rh[s][1] = *(const f32x4*)(zp_ + 32 * s + 4); } }
            asm volatile("s_waitcnt vmcnt(0)" ::: "memory");
#pragma unroll
            for (int s = 0; s < 8; ++s) { const u32x4 ua = *(const LAS u32x4*)(stash + (2 * s) * 1024 + lane * 16), ub = *(const LAS u32x4*)(stash + (2 * s + 1) * 1024 + lane * 16);
                z[s][0] = rh[s][0] * ALPHA + ((f32x4){bflo(ua.x), bfhi(ua.x), bflo(ua.y), bfhi(ua.y)} + (f32x4){bflo(ub.x), bfhi(ub.x), bflo(ub.y), bfhi(ub.y)});
                z[s][1] = rh[s][1] * ALPHA + ((f32x4){bflo(ua.z), bfhi(ua.z), bflo(ua.w), bfhi(ua.w)} + (f32x4){bflo(ub.z), bfhi(ub.z), bflo(ub.w), bfhi(ub.w)}); }
        } else if (MODE == 1) {
            u32x4 rm[8];
            { const bf16_t* mp_ = a.mix + (size_t)row * DM + kb;
#pragma unroll
              for (int s = 0; s < 8; ++s) rm[s] = *(const u32x4*)(mp_ + 32 * s); }
            asm volatile("s_waitcnt vmcnt(0)" ::: "memory");
#pragma unroll
            for (int s = 0; s < 8; ++s) { const u32x4 um = rm[s]; const u32x4 uh = *(const LAS u32x4*)(stash + s * 1024 + lane * 16);
                z[s][0] = (f32x4){bflo(uh.x), bfhi(uh.x), bflo(uh.y), bfhi(uh.y)} * ALPHA + (f32x4){bflo(um.x), bfhi(um.x), bflo(um.y), bfhi(um.y)};
                z[s][1] = (f32x4){bflo(uh.z), bfhi(uh.z), bflo(uh.w), bfhi(uh.w)} * ALPHA + (f32x4){bflo(um.z), bfhi(um.z), bflo(um.w), bfhi(um.w)}; }
        } else {
            asm volatile("s_waitcnt vmcnt(0)" ::: "memory");
#pragma unroll
            for (int s = 0; s < 8; ++s) { z[s][0] = *(const LAS f32x4*)(stash + (2 * s) * 1024 + lane * 16); z[s][1] = *(const LAS f32x4*)(stash + (2 * s + 1) * 1024 + lane * 16); }
        }
        LDS_WAIT();
        float sm = 0.f, sq = 0.f;
#pragma unroll
        for (int s = 0; s < 8; ++s)
#pragma unroll
            for (int hh = 0; hh < 2; ++hh)
#pragma unroll
                for (int j = 0; j < 4; ++j) { const float v = z[s][hh][j]; sm += v; sq += v * v; }
        sm += __shfl_xor(sm, 16); sm += __shfl_xor(sm, 32); sq += __shfl_xor(sq, 16); sq += __shfl_xor(sq, 32);
        if (q == 0) { red[(w * 16 + r) * 2] = sm; red[(w * 16 + r) * 2 + 1] = sq; }
        if (PROJ) {
            f32x4 acc[NCG];
#pragma unroll
            for (int cg = 0; cg < NCG; ++cg) acc[cg] = (f32x4){0.f, 0.f, 0.f, 0.f};
            constexpr int WD = (MODE == 1) ? 8 : 6;
            bf16x8 bh[WD], bl[WD];
            unsigned wof[NCG];
#pragma unroll
            for (int cg = 0; cg < NCG; ++cg) { wof[cg] = (unsigned)((16 * cg + r) * DM + kb) * 2u; asm volatile("" : "+v"(wof[cg])); }
            constexpr int NVALID = (MODE == 1) ? 36 : 8;
#define LN_WLOAD(i_, bf_) do { const int cg_ = (i_) % NCG, s_ = (i_) / NCG; if (16 * cg_ + r < NVALID) { bh[bf_] = *(const bf16x8*)((const char*)a.whi + wof[cg_] + 64 * s_); bl[bf_] = *(const bf16x8*)((const char*)a.wlo + wof[cg_] + 64 * s_); } \
                else { bh[bf_] = (bf16x8){0, 0, 0, 0, 0, 0, 0, 0}; bl[bf_] = (bf16x8){0, 0, 0, 0, 0, 0, 0, 0}; } } while (0)
#pragma unroll
            for (int i = 0; i < WD - 1; ++i) LN_WLOAD(i, i % WD);
#pragma unroll
            for (int i = 0; i < 8 * NCG; ++i) { const int cg = i % NCG, s = i / NCG;
                asm volatile("" ::: "memory");
                if (i + WD - 1 < 8 * NCG) LN_WLOAD(i + WD - 1, (i + WD - 1) % WD);
                asm volatile("" ::: "memory");
                u32x4 hi, lo;
                { const f32x4 v0 = z[s][0], v1 = z[s][1];
                  hi.x = cvt_pk_bf16(v0[0], v0[1]); hi.y = cvt_pk_bf16(v0[2], v0[3]); hi.z = cvt_pk_bf16(v1[0], v1[1]); hi.w = cvt_pk_bf16(v1[2], v1[3]);
                  lo.x = cvt_pk_bf16(v0[0] - bflo(hi.x), v0[1] - bfhi(hi.x)); lo.y = cvt_pk_bf16(v0[2] - bflo(hi.y), v0[3] - bfhi(hi.y));
                  lo.z = cvt_pk_bf16(v1[0] - bflo(hi.z), v1[1] - bfhi(hi.z)); lo.w = cvt_pk_bf16(v1[2] - bflo(hi.w), v1[3] - bfhi(hi.w)); }
                const bf16x8 ahi = __builtin_bit_cast(bf16x8, hi), alo = __builtin_bit_cast(bf16x8, lo);
                const bf16x8 wh = bh[i % WD], wl_ = bl[i % WD];
                acc[cg] = __builtin_amdgcn_mfma_f32_16x16x32_bf16(ahi, wh, acc[cg], 0, 0, 0);
                acc[cg] = __builtin_amdgcn_mfma_f32_16x16x32_bf16(alo, wh, acc[cg], 0, 0, 0);
                acc[cg] = __builtin_amdgcn_mfma_f32_16x16x32_bf16(ahi, wl_, acc[cg], 0, 0, 0);
            }
#undef LN_WLOAD
#pragma unroll
            for (int cg = 0; cg < NCG; ++cg)
#pragma unroll
                for (int j = 0; j < 4; ++j) part[(w * 16 + 4 * q + j) * 48 + 16 * cg + r] = acc[cg][j];
        }
        asm volatile("" ::: "memory");
        if (!GRES) { LN_GLOAD(); asm volatile("" ::: "memory"); }
        if (gi + F.G < NTOK / 16) LN_ISSUE(gi + F.G);
        asm volatile("" ::: "memory");
        LDS_WAIT(); __syncthreads();
        float mean, rstd;
        { float ts = 0.f, tq = 0.f;
#pragma unroll
          for (int ww = 0; ww < 8; ++ww) { ts += red[(ww * 16 + r) * 2]; tq += red[(ww * 16 + r) * 2 + 1]; }
          mean = ts * (1.0f / DM); const float var = tq * (1.0f / DM) - mean * mean; rstd = 1.0f / sqrtf(fmaxf(var, 0.f) + LN_EPS); }
        { float* op = a.hf + (size_t)row * DM + kb; bf16_t* ob = a.hb ? a.hb + (size_t)row * DM + kb : nullptr;
#pragma unroll
          for (int s = 0; s < 8; ++s) {
              f32x4 dg0, dg1, bb0, bb1; LN_UNPK(dg0, s, 0, 0); LN_UNPK(dg1, s, 1, 0); LN_UNPK(bb0, s, 0, 2); LN_UNPK(bb1, s, 1, 2);
              const f32x4 n0 = (z[s][0] - mean) * rstd, n1 = (z[s][1] - mean) * rstd; const f32x4 y0 = n0 + n0 * dg0 + bb0, y1 = n1 + n1 * dg1 + bb1;
              if (a.hf) { *(f32x4*)(op + 32 * s) = y0; *(f32x4*)(op + 32 * s + 4) = y1; }
              if (ob) { u32x4 o; o.x = cvt_pk_bf16(y0[0], y0[1]); o.y = cvt_pk_bf16(y0[2], y0[3]); o.z = cvt_pk_bf16(y1[0], y1[1]); o.w = cvt_pk_bf16(y1[2], y1[3]); *(u32x4*)(ob + 32 * s) = o; }
              if (a.h8) { u32x2 o8; o8.x = pk4_fp8(y0[0], y0[1], y0[2], y0[3]); o8.y = pk4_fp8(y1[0], y1[1], y1[2], y1[3]); *(u32x2*)(a.h8 + (size_t)row * DM + kb + 32 * s) = o8; } } }
        if (PROJ) {
#define LN_LOGIT(t_, s1_, s2_) do { const int t = (t_); if (t < 16 * 16 * NCG) { const int rr = t / (16 * NCG), cc = t % (16 * NCG); float ts = 0.f, tq = 0.f, ps = 0.f; \
                _Pragma("unroll") for (int ww = 0; ww < 8; ++ww) { ts += red[(ww * 16 + rr) * 2]; tq += red[(ww * 16 + rr) * 2 + 1]; ps += part[(ww * 16 + rr) * 48 + cc]; } \
                const float mr = ts * (1.0f / DM), vr = tq * (1.0f / DM) - mr * mr, rs = 1.0f / sqrtf(fmaxf(vr, 0.f) + LN_EPS); \
                lg[rr * 48 + cc] = rs * (ps - mr * (s1_)) + (s2_); } } while (0)
            LN_LOGIT(tid, s1a, s2a); if (16 * 16 * NCG > NWAVES * 64) LN_LOGIT(tid + NWAVES * 64, s1b, s2b);
#undef LN_LOGIT
            LDS_WAIT(); __syncthreads();
            if (tid < 16) {
                const int tok = gi * 16 + tid; const LAS float* L = lg + tid * 48;
                if (MODE != 1) {
                    const int bb = tok / SEQ, ss = tok % SEQ;
#pragma unroll
                    for (int hh = 0; hh < 8; ++hh) { const float xv = L[hh] + tb[hh]; const float lsg = fminf(xv, 0.f) - log1pf(expf(-fabsf(xv))); a.logf[((size_t)bb * 8 + hh) * SEQ + ss] = lsg; }
                } else {
                    float gl[4]; float gmax = -3.0e38f; int gi_ = 0;
#pragma unroll
                    for (int j = 0; j < 4; ++j) { gl[j] = L[j] + tb[16 + j]; if (gl[j] > gmax) { gmax = gl[j]; gi_ = j; } }
                    float den = 0.f;
#pragma unroll
                    for (int j = 0; j < 4; ++j) den += expf(gl[j] - gmax);
                    const float grp_w = 1.0f / den;
                    float e1 = -3.0e38f, e2 = -3.0e38f; int i1 = 0, i2 = 0;
#pragma unroll
                    for (int j = 0; j < 8; ++j) { const float v = L[4 + 8 * gi_ + j] + tb[32 + 8 * gi_ + j];
                        if (v > e1) { e2 = e1; i2 = i1; e1 = v; i1 = j; } else if (v > e2) { e2 = v; i2 = j; } }
                    const float t2 = expf(e2 - e1), w1 = grp_w / (1.0f + t2), w2 = grp_w * t2 / (1.0f + t2);
                    const int x1 = 8 * gi_ + i1, x2 = 8 * gi_ + i2;
                    const int r1 = __hip_atomic_fetch_add(lcnt + x1, 1, __ATOMIC_RELAXED, __HIP_MEMORY_SCOPE_WORKGROUP), r2 = __hip_atomic_fetch_add(lcnt + x2, 1, __ATOMIC_RELAXED, __HIP_MEMORY_SCOPE_WORKGROUP);
                    LAS int* rc = rrec + (nrec + tid) * 8; rc[0] = tok; rc[1] = x1; rc[2] = r1; rc[3] = __float_as_int(w1); rc[4] = x2; rc[5] = r2; rc[6] = __float_as_int(w2);
                }
            }
        }
        __syncthreads();
        if (MODE == 1) {
            nrec += 16;
            if (nrec == 64 || gi + F.G >= NTOK / 16) {
                const int tf = opaque_tid();
                if (tf < 32) { const int cn = lcnt[tf]; lcnt[32 + tf] = cn ? (int)__hip_atomic_fetch_add(a.cnt + 64 * tf, (unsigned)cn, RLX_AGENT) : 0; lcnt[tf] = 0; }
                LDS_WAIT(); __syncthreads();
                if (tf < nrec) { const LAS int* rc = rrec + tf * 8; const int tok = rc[0], x1 = rc[1], x2 = rc[4]; const int p1 = lcnt[32 + x1] + rc[2], p2 = lcnt[32 + x2] + rc[5];
                    a.list[x1 * 16384 + p1] = tok; a.wlist[x1 * 16384 + p1] = __int_as_float(rc[3]); a.list[x2 * 16384 + p2] = tok; a.wlist[x2 * 16384 + p2] = __int_as_float(rc[6]);
                    *(int4*)(a.route_out + tok * 4) = make_int4(x1, p1, x2, p2); }
                nrec = 0;
                LDS_WAIT(); __syncthreads();
            }
        }
    }
#undef LN_ISSUE
#undef LN_UNPK
#undef LN_GLOAD
}
namespace fox {
constexpr int D = 128, NW = 8, QBLK = 32, KVBLK = 64, QB = NW * QBLK;
constexpr int SHM_V = KVBLK * D * 2, SHM_K = KVBLK * D * 2;
constexpr int OFF_WS = 2 * SHM_V + 2 * SHM_K, OFF_BIAS = OFF_WS + NW * 64 * 4, LDS_BYTES = OFF_BIAS + SEQ * 4;
constexpr float THR = 8.f, LN2 = 0.6931471805599453f;
#define KSWZ(row, colB) ((row) * 256 + ((colB) ^ (((row) & 7) << 4)))
__device__ __forceinline__ int v_st(int k, int c) { const int kk = (k & ~0xC) | ((k & 4) << 1) | ((k & 8) >> 1); return ((kk >> 3) * 4 + (c >> 5)) * 512 + ((kk & 7) * 32 + (c & 31)) * 2; }
__device__ __forceinline__ int v_rd_base(int lane) { return ((lane & 3) << 3) | (((lane >> 2) & 3) << 6) | (((lane >> 4) & 1) << 5) | (((lane >> 5) & 1) << 8); }
constexpr int v_rd_off(int d0, int ks, int half) { return d0 * 512 + ks * 4096 + half * 2048; }
__device__ __forceinline__ int crow(int r, int hi) { return (r & 3) + 8 * (r >> 2) + 4 * hi; }
__device__ __forceinline__ void mask_tile(f32x16& p0, f32x16& p1, int dq) {
    const float NEG = -__builtin_inff();
#pragma unroll
    for (int r = 0; r < 16; ++r) { const int c = (r & 3) + 8 * (r >> 2); if (dq - c < 0) p0[r] = NEG; if (dq - c - 32 < 0) p1[r] = NEG; }
}
__device__ __forceinline__ void partialSM(f32x16& p0, f32x16& p1, float& m_reg, float& mn, float& alpha) {
    float pmax = p0[0];
#pragma unroll
    for (int r = 1; r < 16; ++r) pmax = fmaxf(pmax, p0[r]);
#pragma unroll
    for (int r = 0; r < 16; ++r) pmax = fmaxf(pmax, p1[r]);
    { auto rr = __builtin_amdgcn_permlane32_swap(__float_as_uint(pmax), __float_as_uint(pmax), false, false); pmax = fmaxf(__uint_as_float(rr[0]), __uint_as_float(rr[1])); }
    if (__builtin_expect(__all((pmax - m_reg) * LN2 <= THR), 1)) { mn = m_reg; alpha = 1.f; }
    else { mn = fmaxf(m_reg, pmax); alpha = __builtin_amdgcn_exp2f(m_reg - mn); m_reg = mn; }
#pragma unroll
    for (int r = 0; r < 16; ++r) p0[r] = p0[r] - mn;
#pragma unroll
    for (int r = 0; r < 16; ++r) p1[r] = p1[r] - mn;
#pragma unroll
    for (int r = 0; r < 16; ++r) p0[r] = __builtin_amdgcn_exp2f(p0[r]);
}
__device__ __forceinline__ void finishSM(f32x16& p0, f32x16& p1, float alpha, float& l_reg, bf16x8& pa0, bf16x8& pa1, bf16x8& pa2, bf16x8& pa3) {
#pragma unroll
    for (int r = 0; r < 16; ++r) p1[r] = __builtin_amdgcn_exp2f(p1[r]);
    float ps = 0;
#pragma unroll
    for (int r = 0; r < 16; ++r) ps += p0[r];
#pragma unroll
    for (int r = 0; r < 16; ++r) ps += p1[r];
    { auto rr = __builtin_amdgcn_permlane32_swap(__float_as_uint(ps), __float_as_uint(ps), false, false); ps = __uint_as_float(rr[0]) + __uint_as_float(rr[1]); }
    l_reg = l_reg * alpha + ps;
#define PK4(P, B_, OUT) do { unsigned a0 = cvt_pk_bf16(P[B_+0], P[B_+1]), a1 = cvt_pk_bf16(P[B_+2], P[B_+3]);                          \
        unsigned b0 = cvt_pk_bf16(P[B_+4], P[B_+5]), b1 = cvt_pk_bf16(P[B_+6], P[B_+7]);                                             \
        auto r0 = __builtin_amdgcn_permlane32_swap(a0, b0, false, false); auto r1 = __builtin_amdgcn_permlane32_swap(a1, b1, false, false); \
        u32x4 w = {r0[0], r1[0], r0[1], r1[1]}; OUT = __builtin_bit_cast(bf16x8, w); } while (0)
    PK4(p0, 0, pa0); PK4(p0, 8, pa1); PK4(p1, 0, pa2); PK4(p1, 8, pa3);
#undef PK4
}
template <int KB>
__device__ __forceinline__ void qkt(f32x16& p0, f32x16& p1, const LAS char* K_lds, int r32, int hi, const bf16x8* qr, const LAS float* bl) {
#pragma unroll
    for (int g = 0; g < 4; ++g) { const f32x4 b0 = *(const LAS f32x4*)(bl + 8 * g), b1 = *(const LAS f32x4*)(bl + 32 + 8 * g);
        p0[4 * g] = b0[0]; p0[4 * g + 1] = b0[1]; p0[4 * g + 2] = b0[2]; p0[4 * g + 3] = b0[3]; p1[4 * g] = b1[0]; p1[4 * g + 1] = b1[1]; p1[4 * g + 2] = b1[2]; p1[4 * g + 3] = b1[3]; }
    const LAS char* kb[4];
#pragma unroll
    for (int dd = 0; dd < 4; ++dd) kb[dd] = K_lds + KB * SHM_K + KSWZ(r32, (dd * 16 + hi * 8) * 2);
#pragma unroll
    for (int d0 = 0; d0 < 8; ++d0) { const LAS char* a = kb[d0 & 3] + (d0 >> 2) * 128;
        bf16x8 b0 = *(const LAS bf16x8*)(a);
        bf16x8 b1 = *(const LAS bf16x8*)(a + 32 * 256);
        p0 = __builtin_amdgcn_mfma_f32_32x32x16_bf16(b0, qr[d0], p0, 0, 0, 0);
        p1 = __builtin_amdgcn_mfma_f32_32x32x16_bf16(b1, qr[d0], p1, 0, 0, 0); }
}
template <int VB>
__device__ __forceinline__ void pv_tile(f32x16* o, int vb0, bf16x8 pa0, bf16x8 pa1, bf16x8 pa2, bf16x8 pa3) {
#define TRRD(dst, off) asm volatile("ds_read_b64_tr_b16 %0, %1 offset:%2" : "=&v"(dst) : "v"(vb0), "i"(off) : "memory")
#define PV_D0(d0) do { s16x4 l0, l1, l2, l3, h0, h1, h2, h3; constexpr int b_ = VB * SHM_V + v_rd_off(d0, 0, 0); \
        TRRD(l0, b_); TRRD(h0, b_ + 2048); TRRD(l1, b_ + 4096); TRRD(h1, b_ + 6144); TRRD(l2, b_ + 8192); TRRD(h2, b_ + 10240); TRRD(l3, b_ + 12288); TRRD(h3, b_ + 14336); \
        asm volatile("s_waitcnt lgkmcnt(0)" ::: "memory"); SBAR();   \
        o[d0] = __builtin_amdgcn_mfma_f32_32x32x16_bf16(pa0, (bf16x8){l0[0], l0[1], l0[2], l0[3], h0[0], h0[1], h0[2], h0[3]}, o[d0], 0, 0, 0);   \
        o[d0] = __builtin_amdgcn_mfma_f32_32x32x16_bf16(pa1, (bf16x8){l1[0], l1[1], l1[2], l1[3], h1[0], h1[1], h1[2], h1[3]}, o[d0], 0, 0, 0);   \
        o[d0] = __builtin_amdgcn_mfma_f32_32x32x16_bf16(pa2, (bf16x8){l2[0], l2[1], l2[2], l2[3], h2[0], h2[1], h2[2], h2[3]}, o[d0], 0, 0, 0);   \
        o[d0] = __builtin_amdgcn_mfma_f32_32x32x16_bf16(pa3, (bf16x8){l3[0], l3[1], l3[2], l3[3], h3[0], h3[1], h3[2], h3[3]}, o[d0], 0, 0, 0); } while (0)
    PV_D0(0); PV_D0(1); PV_D0(2); PV_D0(3);
#undef PV_D0
#undef TRRD
}
struct BlockRef { const bf16_t* Q; const bf16_t* K; const bf16_t* V; bf16_t* O; int P0; };
struct Seam { bf16x8 qr[8]; bf16x8 st_v0, st_v1, st_k0, st_k1; };
#define VMW() asm volatile("s_waitcnt vmcnt(0)" ::: "memory")
#define VMWN(n) asm volatile("s_waitcnt vmcnt(%0)" :: "i"(n) : "memory")
#define SLOAD_H(Kp, Vp, k0) do { const char* vb_ = (const char*)(Vp) + (size_t)(k0) * (ld * 2); const char* kb_ = (const char*)(Kp) + (size_t)(k0) * (ld * 2); \
        S.st_v0 = *(const bf16x8*)(vb_ + soff); S.st_v1 = *(const bf16x8*)(vb_ + 32 * ld * 2 + soff); S.st_k0 = *(const bf16x8*)(kb_ + soff); S.st_k1 = *(const bf16x8*)(kb_ + 32 * ld * 2 + soff); } while (0)
#define SWRITE_HK(bf) do { *(LAS bf16x8*)(K_lds + (bf) * SHM_K + kws) = S.st_k0; *(LAS bf16x8*)(K_lds + (bf) * SHM_K + kws + 32 * 256) = S.st_k1; } while (0)
#define SWRITE_HV(bf) do { *(LAS bf16x8*)(V_lds + (bf) * SHM_V + vst0) = S.st_v0; *(LAS bf16x8*)(V_lds + (bf) * SHM_V + vst1) = S.st_v1; } while (0)
#define SWRITE_H(bf) do { SWRITE_HV(bf); SWRITE_HK(bf); } while (0)
template <int ld> __device__ __forceinline__ void prime(const BlockRef& cur, LAS char* lds, Seam& S) {
    const int tid = opaque_tid(), wid = __builtin_amdgcn_readfirstlane(tid >> 6), lane = tid & 63, r32 = lane & 31, hi = lane >> 5;
    const int sr = tid >> 4, sc = (tid & 15) * 8, kws = KSWZ(sr, sc * 2); LAS char* K_lds = lds + 2 * SHM_V;
    const unsigned soff = (unsigned)(sr * ld + sc) * 2u, qoff = (unsigned)((wid * QBLK + r32) * ld + hi * 8) * 2u;
#pragma unroll
    for (int d0 = 0; d0 < 8; ++d0) S.qr[d0] = *(const bf16x8*)((const char*)cur.Q + qoff + d0 * 32);
    SLOAD_H(cur.K, cur.V, 0); VMW(); SWRITE_HK(0);
    __syncthreads();
}
template <int ld, int ldo> __device__ __forceinline__ void block(const BlockRef& cur, const BlockRef& nxt, LAS char* lds, Seam& S) {
    const int tid = opaque_tid(), wid = __builtin_amdgcn_readfirstlane(tid >> 6), lane = tid & 63, r32 = lane & 31, hi = lane >> 5;
    const int NT = (cur.P0 + QB - 1) / KVBLK + 1;
    const int qlo = cur.P0 + wid * QBLK, qm = qlo + r32 - 4 * hi;
    LAS char* V_lds = lds; LAS char* K_lds = lds + 2 * SHM_V;
    LAS float* ws = (LAS float*)(lds + OFF_WS) + wid * 64; LAS float* li_l = ws; LAS float* al_l = ws + 32;
    const LAS float* bias = (const LAS float*)(lds + OFF_BIAS) + 4 * hi;
    float m_reg = -1e30f, l_reg = 0; f32x16 o[4] = {};
    const int sr = tid >> 4, sc = (tid & 15) * 8, vst0 = v_st(sr, sc), vst1 = v_st(32 + sr, sc), kws = KSWZ(sr, sc * 2);
    const unsigned soff = (unsigned)(sr * ld + sc) * 2u;
    const int vb0 = (int)(uintptr_t)V_lds + v_rd_base(lane);
    const bf16_t* Kh = cur.K; const bf16_t* Vh = cur.V;
#define RESC(a) do { if (__any((a) < 1.f)) { if (hi == 0) al_l[r32] = (a); asm volatile("s_waitcnt lgkmcnt(0)" ::: "memory");              \
                     for (int d_ = 0; d_ < 4; ++d_) for (int r = 0; r < 16; ++r) o[d_][r] *= al_l[crow(r, hi)]; } } while (0)
#define KBASE(t) ((t) * KVBLK)
#define MASKT(P0_, P1_, t) do { const int kb_ = KBASE(t); if (kb_ + KVBLK - 1 > qlo) mask_tile(P0_, P1_, qm - kb_); } while (0)
    constexpr int NQL = 8;
#define SEAM_K0() do { VMWN(NQL); SWRITE_HK(0); SBAR(); } while (0)
    f32x16 pA0, pA1, pB0, pB1; float mnA, mnB, alA, alB; bf16x8 pa0, pa1, pa2, pa3;
    SWRITE_HV(0); SBAR();
    if (NT > 1) { SLOAD_H(Kh, Vh, KBASE(1)); }
    SBAR(); qkt<0>(pA0, pA1, K_lds, r32, hi, S.qr, bias + KBASE(0));
    MASKT(pA0, pA1, 0); partialSM(pA0, pA1, m_reg, mnA, alA);
    if (NT > 1) { VMW(); SWRITE_H(1); }
    __syncthreads();
#define HALF_STEP(PX0, PX1, mnX, alX, PY0, PY1, alY, t, KB, VB, SB) do {                                                      \
        SBAR(); qkt<KB>(PX0, PX1, K_lds, r32, hi, S.qr, bias + KBASE(t));                                             \
        finishSM(PY0, PY1, alY, l_reg, pa0, pa1, pa2, pa3); SBAR();                                                           \
        if ((t) + 1 < NT) { SLOAD_H(Kh, Vh, KBASE((t) + 1)); SBAR(); }                                               \
        pv_tile<VB>(o, vb0, pa0, pa1, pa2, pa3); MASKT(PX0, PX1, (t)); partialSM(PX0, PX1, m_reg, mnX, alX);                                        \
        __syncthreads();                                                                                                      \
        if ((t) + 1 < NT) { VMW(); SWRITE_H(SB); }                                                                          \
        RESC(alX); __syncthreads(); } while (0)
    for (int t = 1; t + 1 < NT; t += 2) {
        HALF_STEP(pB0, pB1, mnB, alB, pA0, pA1, alA, t, 1, 0, 0);
        HALF_STEP(pA0, pA1, mnA, alA, pB0, pB1, alB, t + 1, 0, 1, 1);
    }
    const bool even = (NT & 1) == 0;
    if (even) { SBAR(); qkt<1>(pB0, pB1, K_lds, r32, hi, S.qr, bias + KBASE(NT - 1)); SBAR(); }
    int tid2 = tid; asm volatile("" : "+v"(tid2));
    const int r32b = tid2 & 31, hib = (tid2 >> 5) & 1;
    SBAR();
    finishSM(pA0, pA1, alA, l_reg, pa0, pa1, pa2, pa3); SBAR();
    pv_tile<0>(o, vb0, pa0, pa1, pa2, pa3);
    if (even) { MASKT(pB0, pB1, NT - 1); partialSM(pB0, pB1, m_reg, mnB, alB); __syncthreads(); RESC(alB);
        finishSM(pB0, pB1, alB, l_reg, pa0, pa1, pa2, pa3); SBAR(); pv_tile<1>(o, vb0, pa0, pa1, pa2, pa3); }
    SBAR();
    if (hi == 0) li_l[r32] = l_reg; asm volatile("s_waitcnt lgkmcnt(0)" ::: "memory");
    float rli[16];
#pragma unroll
    for (int r = 0; r < 16; ++r) rli[r] = __builtin_amdgcn_rcpf(li_l[crow(r, hi)]);
    char* Ow = (char*)cur.O + (size_t)(wid * QBLK) * ldo; const unsigned ooff = (unsigned)(4 * hib * ldo + r32b);
#pragma unroll
    for (int r = 0; r < 16; ++r) { const int orow0 = (r & 3) + 8 * (r >> 2);
#pragma unroll
        for (int d0 = 0; d0 < 4; ++d0) { const float v = o[d0][r] * rli[r] * Y8_SCALE; const float vn = __shfl_xor(v, 1);
            const unsigned pk = (unsigned)__builtin_amdgcn_cvt_pk_fp8_f32(v, vn, 0, false) & 0xffffu; const unsigned pn = (unsigned)__shfl_xor((int)pk, 2);
            if ((r32b & 3) == 0) *(unsigned*)(Ow + (size_t)(orow0 * ldo + d0 * 32) + ooff) = pk | (pn << 16); } }
    __syncthreads();
#undef RESC
#undef KBASE
#undef MASKT
#undef SEAM_K0
#undef HALF_STEP
}
#undef ROW
#undef VMW
#undef VMWN
#undef SLOAD_H
#undef SWRITE_HK
#undef SWRITE_HV
#undef SWRITE_H
#undef KSWZ
}
namespace ret {
constexpr int QS = 288, VS = 544, SS = 144;
constexpr int OFF_Q = 0, OFF_K = 64 * QS, OFF_V = 2 * 64 * QS, OFF_S = OFF_V + 64 * VS, OFF_QD = OFF_S + 64 * SS, OFF_RP = OFF_QD + 256, LDS_BYTES = OFF_RP + 8 * 64 * 4;
#define TRRD(dst, base, off) asm volatile("ds_read_b64_tr_b16 %0, %1 offset:%2" : "=&v"(dst) : "v"(base), "i"(off) : "memory")
__device__ __forceinline__ bf16x8 cat8(s16x4 a, s16x4 b) { return (bf16x8){a[0], a[1], a[2], a[3], b[0], b[1], b[2], b[3]}; }
__device__ __forceinline__ u32x4 scale8(u32x4 v, float s) {
    u32x4 o; o.x = cvt_pk_bf16(bflo(v.x) * s, bfhi(v.x) * s); o.y = cvt_pk_bf16(bflo(v.y) * s, bfhi(v.y) * s); o.z = cvt_pk_bf16(bflo(v.z) * s, bfhi(v.z) * s); o.w = cvt_pk_bf16(bflo(v.w) * s, bfhi(v.w) * s); return o;
}
__device__ __forceinline__ void item(const bf16_t* proj, bf16_t* yret, int b, int h, int seg, const float* Lbh, gu32* fbh, LAS unsigned char* lds) {
    const int tid = opaque_tid(), w = __builtin_amdgcn_readfirstlane(tid >> 6), lane = tid & 63, c = lane & 15, q = lane >> 4, qq = c >> 2, p = c & 3;
    const float gam = 1.0f - __builtin_amdgcn_exp2f(-5.0f - (float)h);
    const float lg = log2f(gam);
    const float cd = __builtin_amdgcn_exp2f(lg * 64.0f);
    const int srow = tid >> 3, sseg = tid & 7;
    const float kd = __builtin_amdgcn_exp2f(lg * (float)(63 - srow));
    if (tid < 64) ((LAS float*)(lds + OFF_QD))[tid] = __builtin_amdgcn_exp2f(lg * (float)(tid + 1));
    const size_t tok0 = (size_t)b * SEQ;
    const size_t hrow = (size_t)(b * 8 + h) * SEQ + srow;
    const bf16_t* gq = proj + PJ_RQ + hrow * 128 + 16 * sseg;
    const bf16_t* gk = proj + PJ_RK + hrow * 128 + 16 * sseg;
    const bf16_t* gv = proj + PJ_RV + hrow * 256 + 32 * sseg;
    LAS unsigned char* wq = lds + OFF_Q + srow * QS + sseg * 32; LAS unsigned char* wk = lds + OFF_K + srow * QS + sseg * 32; LAS unsigned char* wv = lds + OFF_V + srow * VS + sseg * 64;
    u32x4 pq0, pq1, pk0, pk1, pv0, pv1, pv2, pv3;
#define RET_LOAD(ch) do { const size_t o_ = (size_t)(ch) * 64 * 128, ov_ = (size_t)(ch) * 64 * 256; pq0 = *(const u32x4*)(gq + o_); pq1 = *(const u32x4*)(gq + o_ + 8); pk0 = *(const u32x4*)(gk + o_); pk1 = *(const u32x4*)(gk + o_ + 8); \
        pv0 = *(const u32x4*)(gv + ov_); pv1 = *(const u32x4*)(gv + ov_ + 8); pv2 = *(const u32x4*)(gv + ov_ + 16); pv3 = *(const u32x4*)(gv + ov_ + 24); } while (0)
#define RET_WRITE() do { *(LAS u32x4*)(wq) = pq0; *(LAS u32x4*)(wq + 16) = pq1; *(LAS u32x4*)(wk) = scale8(pk0, kd); *(LAS u32x4*)(wk + 16) = scale8(pk1, kd); \
        *(LAS u32x4*)(wv) = pv0; *(LAS u32x4*)(wv + 16) = pv1; *(LAS u32x4*)(wv + 32) = pv2; *(LAS u32x4*)(wv + 48) = pv3; } while (0)
    f32x4 st[8][2];
#pragma unroll
    for (int dt = 0; dt < 8; ++dt) { st[dt][0] = (f32x4){0.f, 0.f, 0.f, 0.f}; st[dt][1] = (f32x4){0.f, 0.f, 0.f, 0.f}; }
    const int c0 = seg * RCPS;
    RET_LOAD(c0);
    if (seg > 0) {
        if (tid == 0) { for (int i = 0; i < seg; ++i) { unsigned sp = 0; while (__hip_atomic_load(fbh + i * 16, RLX_AGENT) == 0u && ++sp < (1u << 22)) __builtin_amdgcn_s_sleep(2); } }
        __builtin_amdgcn_fence(__ATOMIC_ACQUIRE, "agent"); asm volatile("s_waitcnt vmcnt(0)" ::: "memory");
        __syncthreads();
        for (int i = 0; i < seg; ++i) { const float wgt = __builtin_amdgcn_exp2f(lg * (float)(64 * RCPS * (seg - 1 - i))); const float* Lp = Lbh + (size_t)i * 32768 + (size_t)(w * 16) * 256 + lane * 4;
#pragma unroll
            for (int dt = 0; dt < 8; ++dt)
#pragma unroll
                for (int ct = 0; ct < 2; ++ct) st[dt][ct] = st[dt][ct] + *(const f32x4*)(Lp + (dt * 2 + ct) * 256) * wgt; }
    }
    RET_WRITE();
    LDS_WAIT(); __syncthreads();
    const int mt = w & 3, nt0 = 2 * (w >> 2);
    const unsigned vbase = (unsigned)(uintptr_t)(lds + OFF_V) + (unsigned)((4 * q + qq) * VS + (32 * w + 4 * p) * 2);
    const unsigned kbase = (unsigned)(uintptr_t)(lds + OFF_K) + (unsigned)((4 * q + qq) * QS + (4 * p) * 2);
    const LAS unsigned char* qperm = lds + OFF_Q + c * QS + (4 * q) * 2;
    const LAS unsigned char* sperm = lds + OFF_S + c * SS + (4 * q) * 2;
    const LAS float* qd = (const LAS float*)(lds + OFF_QD); LAS float* rp = (LAS float*)(lds + OFF_RP);
    for (int ch = c0; ch < c0 + RCPS; ++ch) {
        if (ch + 1 < c0 + RCPS) RET_LOAD(ch + 1);
        {
            f32x4 s0 = (f32x4){0.f, 0.f, 0.f, 0.f}, s1 = (f32x4){0.f, 0.f, 0.f, 0.f};
#pragma unroll
            for (int ks = 0; ks < 4; ++ks) { const bf16x8 ak = *(const LAS bf16x8*)(lds + OFF_K + (16 * mt + c) * QS + (32 * ks + 8 * q) * 2);
                const bf16x8 b0 = *(const LAS bf16x8*)(lds + OFF_Q + (16 * nt0 + c) * QS + (32 * ks + 8 * q) * 2), b1 = *(const LAS bf16x8*)(lds + OFF_Q + (16 * nt0 + 16 + c) * QS + (32 * ks + 8 * q) * 2);
                s0 = __builtin_amdgcn_mfma_f32_16x16x32_bf16(ak, b0, s0, 0, 0, 0); s1 = __builtin_amdgcn_mfma_f32_16x16x32_bf16(ak, b1, s1, 0, 0, 0); }
#pragma unroll
            for (int t = 0; t < 2; ++t) { const int n = 16 * (nt0 + t) + c; f32x4 sv = t ? s1 : s0;
#pragma unroll
                for (int j = 0; j < 4; ++j) { const int m = 16 * mt + 4 * q + j; const int d = n > m ? n - m : m - n; sv[j] *= __builtin_amdgcn_exp2f(lg * (float)(d + m - 63)); }
                u32x2 o; o.x = cvt_pk_bf16(sv[0], sv[1]); o.y = cvt_pk_bf16(sv[2], sv[3]); *(LAS u32x2*)(lds + OFF_S + n * SS + (16 * mt + 4 * q) * 2) = o; }
        }
        LDS_WAIT(); __syncthreads();
        f32x4 acc[2][4];
#pragma unroll
        for (int ct = 0; ct < 2; ++ct)
#pragma unroll
            for (int nt = 0; nt < 4; ++nt) acc[ct][nt] = (f32x4){0.f, 0.f, 0.f, 0.f};
#pragma unroll
        for (int ks = 0; ks < 4; ++ks) {
            bf16x8 as[2];
#pragma unroll
            for (int ct = 0; ct < 2; ++ct) { const f32x4 x0 = st[2 * ks][ct], x1 = st[2 * ks + 1][ct]; u32x4 u; u.x = cvt_pk_bf16(x0[0], x0[1]); u.y = cvt_pk_bf16(x0[2], x0[3]); u.z = cvt_pk_bf16(x1[0], x1[1]); u.w = cvt_pk_bf16(x1[2], x1[3]); as[ct] = __builtin_bit_cast(bf16x8, u); }
#pragma unroll
            for (int nt = 0; nt < 4; ++nt) { const u32x2 lo = *(const LAS u32x2*)(qperm + nt * 16 * QS + ks * 64), hi = *(const LAS u32x2*)(qperm + nt * 16 * QS + ks * 64 + 32);
                const u32x4 bu = {lo.x, lo.y, hi.x, hi.y}; const bf16x8 bq = __builtin_bit_cast(bf16x8, bu);
                acc[0][nt] = __builtin_amdgcn_mfma_f32_16x16x32_bf16(as[0], bq, acc[0][nt], 0, 0, 0); acc[1][nt] = __builtin_amdgcn_mfma_f32_16x16x32_bf16(as[1], bq, acc[1][nt], 0, 0, 0); }
        }
#pragma unroll
        for (int nt = 0; nt < 4; ++nt) { const float f = qd[16 * nt + c]; acc[0][nt] = acc[0][nt] * f; acc[1][nt] = acc[1][nt] * f; }
        bf16x8 vt[2][2];
        { s16x4 a0, a1, a2, a3, a4, a5, a6, a7;
          TRRD(a0, vbase, 0); TRRD(a1, vbase, 16 * VS); TRRD(a2, vbase, 32); TRRD(a3, vbase, 16 * VS + 32);
          TRRD(a4, vbase, 32 * VS); TRRD(a5, vbase, 48 * VS); TRRD(a6, vbase, 32 * VS + 32); TRRD(a7, vbase, 48 * VS + 32);
          asm volatile("s_waitcnt lgkmcnt(0)" ::: "memory"); SBAR();
          vt[0][0] = cat8(a0, a1); vt[0][1] = cat8(a2, a3); vt[1][0] = cat8(a4, a5); vt[1][1] = cat8(a6, a7); }
#pragma unroll
        for (int ks2 = 0; ks2 < 2; ++ks2)
#pragma unroll
            for (int nt = 0; nt < 4; ++nt) { const u32x2 lo = *(const LAS u32x2*)(sperm + nt * 16 * SS + ks2 * 64), hi = *(const LAS u32x2*)(sperm + nt * 16 * SS + ks2 * 64 + 32);
                const u32x4 bu = {lo.x, lo.y, hi.x, hi.y}; const bf16x8 bs = __builtin_bit_cast(bf16x8, bu);
                acc[0][nt] = __builtin_amdgcn_mfma_f32_16x16x32_bf16(vt[ks2][0], bs, acc[0][nt], 0, 0, 0); acc[1][nt] = __builtin_amdgcn_mfma_f32_16x16x32_bf16(vt[ks2][1], bs, acc[1][nt], 0, 0, 0); }
#pragma unroll
        for (int dt = 0; dt < 8; ++dt) { s16x4 k0, k1, k2, k3;
            TRRD(k0, kbase, dt * 32); TRRD(k1, kbase, 16 * QS + dt * 32); TRRD(k2, kbase, 32 * QS + dt * 32); TRRD(k3, kbase, 48 * QS + dt * 32);
            asm volatile("s_waitcnt lgkmcnt(0)" ::: "memory"); SBAR();
            const bf16x8 ka = cat8(k0, k1), kb = cat8(k2, k3);
#pragma unroll
            for (int ct = 0; ct < 2; ++ct) { f32x4 s = st[dt][ct] * cd; s = __builtin_amdgcn_mfma_f32_16x16x32_bf16(ka, vt[0][ct], s, 0, 0, 0); s = __builtin_amdgcn_mfma_f32_16x16x32_bf16(kb, vt[1][ct], s, 0, 0, 0); st[dt][ct] = s; } }
#pragma unroll
        for (int nt = 0; nt < 4; ++nt) { float ss = 0.f;
#pragma unroll
            for (int ct = 0; ct < 2; ++ct)
#pragma unroll
                for (int j = 0; j < 4; ++j) ss += acc[ct][nt][j] * acc[ct][nt][j];
            ss += __shfl_xor(ss, 16); ss += __shfl_xor(ss, 32);
            if (q == 0) rp[w * 64 + 16 * nt + c] = ss; }
        LDS_WAIT(); __syncthreads();
        const size_t trow = tok0 + (size_t)ch * 64;
#pragma unroll
        for (int nt = 0; nt < 4; ++nt) { float tot = 0.f;
#pragma unroll
            for (int ww = 0; ww < 8; ++ww) tot += rp[ww * 64 + 16 * nt + c];
            const float rstd = 1.0f / sqrtf(tot * (1.0f / 256.0f) + RMS_EPS); const size_t tk = trow + 16 * nt + c;
#pragma unroll
            for (int ct = 0; ct < 2; ++ct) { const int col = h * 256 + 32 * w + 16 * ct + 4 * q;
                const u32x2 g = *(const u32x2*)(proj + PJ_RG + tk * 2048 + col); const f32x4 a = acc[ct][nt] * rstd;
                u32x2 o; o.x = cvt_pk_bf16(a[0] * bflo(g.x), a[1] * bfhi(g.x)); o.y = cvt_pk_bf16(a[2] * bflo(g.y), a[3] * bfhi(g.y));
                *(u32x2*)(yret + tk * DM + col) = o; } }
        if (ch + 1 < c0 + RCPS) { RET_WRITE(); }
        LDS_WAIT(); __syncthreads();
    }
#undef RET_LOAD
#undef RET_WRITE
}

__device__ __forceinline__ void pass1(const bf16_t* proj, float* Lout, gu32* flag, int b, int h, int seg, LAS unsigned char* lds) {
    const int tid = opaque_tid(), w = __builtin_amdgcn_readfirstlane(tid >> 6), lane = tid & 63, c = lane & 15, q = lane >> 4, qq = c >> 2, p = c & 3;
    const float gam = 1.0f - __builtin_amdgcn_exp2f(-5.0f - (float)h);
    const float lg = log2f(gam);
    const float cd = __builtin_amdgcn_exp2f(lg * 64.0f);
    const int srow = tid >> 3, sseg = tid & 7;
    const float kd = __builtin_amdgcn_exp2f(lg * (float)(63 - srow));
    const size_t hrow = (size_t)(b * 8 + h) * SEQ + srow;
    const bf16_t* gk = proj + PJ_RK + hrow * 128 + 16 * sseg;
    const bf16_t* gv = proj + PJ_RV + hrow * 256 + 32 * sseg;
    LAS unsigned char* wk = lds + OFF_K + srow * QS + sseg * 32; LAS unsigned char* wv = lds + OFF_V + srow * VS + sseg * 64;
    u32x4 pk0, pk1, pv0, pv1, pv2, pv3;
#define P1_LOAD(ch) do { const size_t o_ = (size_t)(ch) * 64 * 128, ov_ = (size_t)(ch) * 64 * 256; pk0 = *(const u32x4*)(gk + o_); pk1 = *(const u32x4*)(gk + o_ + 8); \
        pv0 = *(const u32x4*)(gv + ov_); pv1 = *(const u32x4*)(gv + ov_ + 8); pv2 = *(const u32x4*)(gv + ov_ + 16); pv3 = *(const u32x4*)(gv + ov_ + 24); } while (0)
#define P1_WRITE() do { *(LAS u32x4*)(wk) = scale8(pk0, kd); *(LAS u32x4*)(wk + 16) = scale8(pk1, kd); \
        *(LAS u32x4*)(wv) = pv0; *(LAS u32x4*)(wv + 16) = pv1; *(LAS u32x4*)(wv + 32) = pv2; *(LAS u32x4*)(wv + 48) = pv3; } while (0)
    f32x4 st[8][2];
#pragma unroll
    for (int dt = 0; dt < 8; ++dt) { st[dt][0] = (f32x4){0.f, 0.f, 0.f, 0.f}; st[dt][1] = (f32x4){0.f, 0.f, 0.f, 0.f}; }
    const int c0 = seg * RCPS;
    P1_LOAD(c0); P1_WRITE();
    LDS_WAIT(); __syncthreads();
    const unsigned vbase = (unsigned)(uintptr_t)(lds + OFF_V) + (unsigned)((4 * q + qq) * VS + (32 * w + 4 * p) * 2);
    const unsigned kbase = (unsigned)(uintptr_t)(lds + OFF_K) + (unsigned)((4 * q + qq) * QS + (4 * p) * 2);
    for (int ch = c0; ch < c0 + RCPS; ++ch) {
        if (ch + 1 < c0 + RCPS) P1_LOAD(ch + 1);
        bf16x8 vt[2][2];
        { s16x4 a0, a1, a2, a3, a4, a5, a6, a7;
          TRRD(a0, vbase, 0); TRRD(a1, vbase, 16 * VS); TRRD(a2, vbase, 32); TRRD(a3, vbase, 16 * VS + 32);
          TRRD(a4, vbase, 32 * VS); TRRD(a5, vbase, 48 * VS); TRRD(a6, vbase, 32 * VS + 32); TRRD(a7, vbase, 48 * VS + 32);
          asm volatile("s_waitcnt lgkmcnt(0)" ::: "memory"); SBAR();
          vt[0][0] = cat8(a0, a1); vt[0][1] = cat8(a2, a3); vt[1][0] = cat8(a4, a5); vt[1][1] = cat8(a6, a7); }
#pragma unroll
        for (int dt = 0; dt < 8; ++dt) { s16x4 k0, k1, k2, k3;
            TRRD(k0, kbase, dt * 32); TRRD(k1, kbase, 16 * QS + dt * 32); TRRD(k2, kbase, 32 * QS + dt * 32); TRRD(k3, kbase, 48 * QS + dt * 32);
            asm volatile("s_waitcnt lgkmcnt(0)" ::: "memory"); SBAR();
            const bf16x8 ka = cat8(k0, k1), kb = cat8(k2, k3);
#pragma unroll
            for (int ct = 0; ct < 2; ++ct) { f32x4 s = st[dt][ct] * cd; s = __builtin_amdgcn_mfma_f32_16x16x32_bf16(ka, vt[0][ct], s, 0, 0, 0); s = __builtin_amdgcn_mfma_f32_16x16x32_bf16(kb, vt[1][ct], s, 0, 0, 0); st[dt][ct] = s; } }
        __syncthreads();
        if (ch + 1 < c0 + RCPS) { P1_WRITE(); }
        LDS_WAIT(); __syncthreads();
    }
    { unsigned long long* Lp = (unsigned long long*)(Lout + (size_t)(w * 16) * 256 + lane * 4);
#pragma unroll
      for (int dt = 0; dt < 8; ++dt)
#pragma unroll
          for (int ct = 0; ct < 2; ++ct) { const f32x4 v = st[dt][ct]; unsigned long long* d = Lp + (dt * 2 + ct) * 128;
              __hip_atomic_store(d, ((unsigned long long)__float_as_uint(v[1]) << 32) | __float_as_uint(v[0]), RLX_AGENT);
              __hip_atomic_store(d + 1, ((unsigned long long)__float_as_uint(v[3]) << 32) | __float_as_uint(v[2]), RLX_AGENT); } }
    asm volatile("s_waitcnt vmcnt(0)" ::: "memory");
    __syncthreads();
    if (tid == 0) __hip_atomic_store(flag, 1u, RLX_AGENT);
#undef P1_LOAD
#undef P1_WRITE
}
#undef TRRD
}
#ifndef STAMP_K
#define STAMP_K -1
#endif
#ifndef STAMP_OFF
#define STAMP_OFF 0
#endif
constexpr int N_PHASES = 2 + 8 * NLAYER;
struct Args { const float* in[19]; float* out; unsigned char* ws; int ph_lo, ph_hi; };

__device__ __forceinline__ void moe_tables(Frame& F, int l) {
    LAS int* tab = (LAS int*)(F.lds + MOE_OFF);
    __syncthreads();
    if (F.tid < 32) tab[F.tid] = (int)__hip_atomic_load(F.ctl + CW_CNT + l * 2048 + 64 * F.tid, RLX_AGENT);
    LDS_WAIT(); __syncthreads();
    if (F.tid == 0) { int sa = 0, ta = 0; for (int e = 0; e < 32; ++e) { const int t = (tab[e] + 255) >> 8; tab[32 + e] = sa; tab[64 + e] = ta; sa += t * 256; ta += t; } tab[96] = ta; }
    LDS_WAIT(); __syncthreads();
}

constexpr int MQ_P1 = 64 * (RSEG - 1), MQ_A7 = MQ_P1 + 64, MQ_R2 = MQ_A7 + 64 * RSEG, MQ_END = MQ_R2 + 64 * 7;
constexpr int CV_PER = 40;
constexpr int cv_total(int l) { return IT_REST + (l + 1 < NLAYER ? IT_WIN : 0); }
constexpr int cv_items(int l) { return (cv_total(l) + CV_PER - 1) / CV_PER; }
static_assert(256 + cv_items(0) <= MQ_END, "interleave pattern");
__device__ __forceinline__ void mixer_phase(int l) {
    const int NCV = cv_items(l);
    for (;;) {
        GAS unsigned char* wsg_ = (GAS unsigned char*)KWS(); asm volatile("" : "+s"(wsg_)); unsigned char* ws = (unsigned char*)wsg_;
        LAS unsigned char* ldsb = (LAS unsigned char*)0; volatile LAS unsigned* MISC = (volatile LAS unsigned*)(ldsb + MISC_OFF);
        const int tid = opaque_tid(), lane = tid & 63, wave = __builtin_amdgcn_readfirstlane(tid >> 6);
        __syncthreads();
        if (tid == 0) MISC[16] = __hip_atomic_fetch_add((gu32*)(ws + WS_CTL) + CW_QUEUE + 64 * l, 1u, RLX_AGENT);
        LDS_WAIT(); __syncthreads();
        int it = __builtin_amdgcn_readfirstlane((int)MISC[16]);
        if (it >= 256 && it < 256 + 2 * NCV) {
            if ((it - 256) & 1) { const int cvi = (it - 256) >> 1;
#pragma unroll 1
                for (int j = 0; j < CV_PER / NWAVES; ++j) { const int wi = cvi * CV_PER + j * NWAVES + wave;
                    if (wi < cv_total(l)) { const bool own = wi < IT_REST; cv_one(own ? l : l + 1, own ? IT_WIN + wi : wi - IT_REST, ws, lane); } }
                continue; }
            it = 256 + ((it - 256) >> 1); }
        else if (it >= 256 + 2 * NCV) it -= NCV;
        if (it >= MQ_P1 && it < MQ_A7 + 64) it = it < MQ_A7 ? it + 64 : it - 64;
        if (it >= MQ_END) { if (STAMP_K >= 0 && l == 0 && threadIdx.x == 0) atomicMin((unsigned long long*)(ws + WS_CTL + 65536) + 41, (unsigned long long)wall_clock64()); break; }
        const bf16_t* proj = (const bf16_t*)(ws + WS_PROJ);
        if (it < MQ_P1) { const int bh = it & 63, seg = it >> 6;
            ret::pass1(proj, (float*)(ws + WS_RLOC) + (size_t)(bh * RSEG + seg) * 32768, (gu32*)(ws + WS_CTL) + CW_RFLAG + ((l * 64 + bh) * RSEG + seg) * 16, bh >> 3, bh & 7, seg, ldsb); continue; }
        if (it >= MQ_A7 && it < MQ_R2) { const int j = it - MQ_A7, bh = j & 63, seg = j >> 6;
            ret::item(proj, (bf16_t*)(ws + WS_YR), bh >> 3, bh & 7, seg, (const float*)(ws + WS_RLOC) + (size_t)(bh * RSEG) * 32768, (gu32*)(ws + WS_CTL) + CW_RFLAG + ((l * 64 + bh) * RSEG) * 16, ldsb);
            if (STAMP_K >= 0 && l == 0 && threadIdx.x == 0) atomicMax((unsigned long long*)(ws + WS_CTL + 65536) + 40, (unsigned long long)wall_clock64());
            continue; }
        const int j = it < MQ_A7 ? it - MQ_P1 : 64 + (it - MQ_R2), x = 7 - (j >> 6), bh = j & 63, b = bh >> 3, h = bh & 7;
        { const int n = 256 * (x + 1); LAS float* bias = (LAS float*)(ldsb + fox::OFF_BIAS); LAS float* wt = (LAS float*)(ldsb + fox::OFF_WS);
          const float* logf = (const float*)(ws + WS_LOGF);
          f32x4 v = (f32x4){0.f, 0.f, 0.f, 0.f}; if (4 * tid < n) v = *(const f32x4*)(logf + (size_t)(b * 8 + h) * SEQ + 4 * tid);
          v[1] += v[0]; v[2] += v[1]; v[3] += v[2];
          float run = v[3];
#pragma unroll
          for (int o = 1; o < 64; o <<= 1) { const float t = __shfl_up(run, o); if (lane >= o) run += t; }
          if (lane == 63) wt[wave] = run;
          LDS_WAIT(); __syncthreads();
          float base = run - v[3];
          for (int ww = 0; ww < wave; ++ww) base += wt[ww];
          *(LAS f32x4*)(bias + 4 * tid) = (f32x4){-(v[0] + base) * LOG2E, -(v[1] + base) * LOG2E, -(v[2] + base) * LOG2E, -(v[3] + base) * LOG2E};
          LDS_WAIT(); __syncthreads(); }
        const size_t tok0 = (size_t)b * SEQ;
        fox::BlockRef cur;
        const size_t hrow0 = (size_t)(b * 8 + h) * SEQ;
        cur.Q = proj + PJ_FQ + (hrow0 + 256 * x) * 128; cur.K = proj + PJ_FK + hrow0 * 128; cur.V = proj + PJ_FV + hrow0 * 128;
        cur.O = (bf16_t*)(ws + WS_YF + (tok0 + 256 * x) * 1024 + h * 128); cur.P0 = 256 * x;
        fox::Seam S;
        fox::prime<128>(cur, (LAS char*)ldsb, S);
        fox::block<128, 1024>(cur, cur, (LAS char*)ldsb, S);
    }
}

__global__ void __launch_bounds__(NWAVES * 64, 2) hybrid_fwd(Args args) {
    extern __shared__ __attribute__((aligned(16))) unsigned char lds_raw[];
    { LAS unsigned char* l0 = (LAS unsigned char*)lds_raw;
      for (int u = threadIdx.x; u < (LDS_BYTES - LDSCTL_OFF) / 4; u += NWAVES * 64) ((LAS unsigned*)(l0 + LDSCTL_OFF))[u] = 0u;
      __syncthreads(); }
#if MK_N_LAUNCHES == 1
    { GAS unsigned char* wsg_ = (GAS unsigned char*)args.ws; asm volatile("" : "+s"(wsg_)); unsigned char* ws = (unsigned char*)wsg_; (void)xcd_barrier_post((unsigned*)((gu32*)(ws + WS_CTL) + CW_BAR), (volatile LAS unsigned*)((LAS unsigned char*)lds_raw + MISC_OFF) + 8); }
#define GRID_BAR() do { GAS unsigned char* wsg_ = (GAS unsigned char*)args.ws; asm volatile("" : "+s"(wsg_)); unsigned char* ws_ = (unsigned char*)wsg_; XcdBarrier bar_; bar_.bar = (unsigned*)((gu32*)(ws_ + WS_CTL) + CW_BAR); bar_.x = xb_xcc_id(); \
        bar_.st = (volatile LAS unsigned*)((LAS unsigned char*)lds_raw + MISC_OFF) + 8; xcd_barrier(bar_); } while (0)
#else
#define GRID_BAR() do {} while (0)
#endif
    const int lo = args.ph_lo, hi = args.ph_hi;
    if (STAMP_K >= 0 && blockIdx.x == 0 && threadIdx.x == 0) { GAS unsigned long long* st_ = (GAS unsigned long long*)((GAS unsigned char*)args.ws + WS_CTL + 65536); st_[0] = wall_clock64(); st_[41] = ~0ull; }
#define IN(k) (lo <= (k) && (k) < hi)
#define SEAM(k) do { if (IN(k) && IN((k) + 1)) GRID_BAR(); if (STAMP_K >= 0 && blockIdx.x == 0 && threadIdx.x == 0) { GAS unsigned long long* st_ = (GAS unsigned long long*)((GAS unsigned char*)args.ws + WS_CTL + 65536); st_[(k) + 1] = wall_clock64(); } } while (0)
#define SEAM_NOBAR(k) do { if (STAMP_K >= 0 && blockIdx.x == 0 && threadIdx.x == 0) { GAS unsigned long long* st_ = (GAS unsigned long long*)((GAS unsigned char*)args.ws + WS_CTL + 65536); st_[(k) + 1] = wall_clock64(); } } while (0)
#define PHASE_PTRS() GAS unsigned char* wsg_ = (GAS unsigned char*)args.ws; asm volatile("" : "+s"(wsg_)); unsigned char* ws = (unsigned char*)wsg_; Frame F; F.lds = (LAS unsigned char*)lds_raw; F.MISC = (volatile LAS unsigned*)(F.lds + MISC_OFF); \
    F.tid = opaque_tid(); F.lane = F.tid & 63; F.wave = __builtin_amdgcn_readfirstlane(F.tid >> 6); F.G = gridDim.x; F.bx = blockIdx.x; F.ws = ws; F.ctl = (gu32*)(ws + WS_CTL); F.out = (float*)(GAS float*)args.out; \
    float* hf = (float*)(ws + WS_HF); bf16_t* hb = (bf16_t*)(ws + WS_HB); bf16_t* proj = (bf16_t*)(ws + WS_PROJ); \
    bf16_t* yfox = (bf16_t*)(ws + WS_YF); bf16_t* yret = (bf16_t*)(ws + WS_YR); bf16_t* mg = (bf16_t*)(ws + WS_MG); \
    float* z1 = (float*)(ws + WS_Z1); bf16_t* hid = (bf16_t*)(ws + WS_HID); bf16_t* ffo = (bf16_t*)(ws + WS_FFO); \
    float* logf = (float*)(ws + WS_LOGF); int* route = (int*)(ws + WS_ROUTE); int* list = (int*)(ws + WS_LIST); float* wlist = (float*)(ws + WS_WLIST); \
    const float* cosT = (const float*)(ws + WS_ROPE); const float* sinT = cosT + SEQ * 64; \
    const LAS int* tab = (const LAS int*)(F.lds + MOE_OFF); unsigned char* wl = ws + WS_W; \
    (void)hf; (void)hb; (void)proj; (void)yfox; (void)yret; (void)mg; (void)z1; (void)hid; (void)ffo; (void)logf; (void)route; (void)list; (void)wlist; (void)cosT; (void)sinT; (void)tab; (void)wl
#ifndef PH_MASK
#define PH_MASK 0xFFFF
#endif
#define PHON(k) ((PH_MASK >> (k)) & 1)
#ifndef DUP_MASK
#define DUP_MASK 0
#endif
#define REPS(k) (((DUP_MASK >> (k)) & 1) ? 2 : 1)
    if (PHON(0) && IN(0)) { const int l = 0; PHASE_PTRS(); p0_weights_win(F); p0_tables(F); } SEAM(0);
    if (PHON(1) && IN(1)) { const int l = 0; PHASE_PTRS();
        LnArgs a{}; a.zin = INP(0); a.hf = nullptr; a.hb = hb; a.h8 = ws + WS_HB8; a.g = INP(1); a.b = INP(2);
        a.whi = (const bf16_t*)(ws + WS_SKW); a.wlo = a.whi + 16 * 2048; a.S12 = (const float*)(ws + WS_SKS); a.bfor = INP(4); a.logf = logf;
        for (int rep_ = 0; rep_ < REPS(1); ++rep_) ln_pass<0, 1, true>(F, a);
    } SEAM(1);
    if ((DUP_MASK >> 12) & 1) { for (int xb = 0; xb < 20; ++xb) GRID_BAR(); }

    { constexpr int l = 0;
        const int pb = 2 + 8 * l;
        if (PHON(2) && IN(pb + 0)) { PHASE_PTRS();
            gm::SchedDense S{(const char*)hb, (const char*)(wl + WL_WIN), 2048 * 2, 2048 * 2, 32, 64, N_BF16_TILES, F.G, F.bx, 1};
            gm::EpiProj E{proj, cosT, sinT, 1.f};
            for (int rep_ = 0; rep_ < REPS(2); ++rep_) gm::gemm_phase<true, 0>(F.lds, S, E);
            gm::SchedDense S8{(const char*)(ws + WS_HB8), (const char*)(wl + WL_WIN8), 2048, 2048, 16, 64, N_FP8_TILES, F.G, F.bx, 2};
            gm::EpiProj E8{proj, cosT, sinT, 1.f / W8_SCALE};
            for (int rep_ = 0; rep_ < REPS(2); ++rep_) gm::gemm_phase<true, 1>(F.lds, S8, E8);
        } SEAM(pb + 0);
        if (PHON(3) && IN(pb + 1)) { mixer_phase(l); } SEAM(pb + 1);
        if (PHON(4) && IN(pb + 2)) { PHASE_PTRS();
            gm::SchedMerge S{(const char*)yfox, (const char*)(wl + WL_WBF), (const char*)yret, (const char*)(wl + WL_WBR), 64, 8, F.G, F.bx};
            gm::EpiMerge E{proj, mg};
            for (int rep_ = 0; rep_ < REPS(4); ++rep_) gm::gemm_phase<true, 2>(F.lds, S, E);
        } SEAM(pb + 2);
        if (PHON(5) && IN(pb + 3)) { PHASE_PTRS();
            gm::SchedDense S{(const char*)mg, (const char*)(wl + WL_WOUT), 2048 * 2, 2048 * 2, 32, 64, 8, F.G, F.bx, 0};
            gm::EpiMix E{yret};
            for (int rep_ = 0; rep_ < REPS(5); ++rep_) gm::gemm_phase<true, 0>(F.lds, S, E);
        } SEAM(pb + 3);
        if (PHON(6) && IN(pb + 4)) { PHASE_PTRS();
            LnArgs a{}; a.zb = hb; a.mix = yret; a.hf = z1; a.hb = nullptr; a.h8 = ws + WS_MG; a.g = INP(8) + l * DM; a.b = INP(9) + l * DM;
            a.whi = (const bf16_t*)(ws + WS_SKW + 2 * SKW_FGT_BYTES + (size_t)l * SKW_RTR_BYTES); a.wlo = a.whi + 48 * 2048; a.S12 = (const float*)(ws + WS_SKS + (size_t)(2 + l) * 512);
            a.brg = INP(11) + l * 4; a.bre = INP(13) + l * 32; a.route_out = route; a.list = list; a.wlist = wlist; a.cnt = (unsigned*)(F.ctl + CW_CNT + l * 2048);
            ln_pass<1, 3, true>(F, a);
        } SEAM(pb + 4);
        if (PHON(7) && IN(pb + 5)) { PHASE_PTRS();
            moe_tables(F, l);
            gm::SchedMoe<true> S{tab, (const char*)(ws + WS_MG), (const char*)(wl + WL_WGU), list, 4, F.G, F.bx, nullptr};
            gm::EpiMoe1 E{(unsigned char*)hid, wlist, tab, F.ctl + CW_MFLAG + l * 160 * 16};
            for (int rep_ = 0; rep_ < REPS(7); ++rep_) gm::gemm_phase<true, 1>(F.lds, S, E);
        } SEAM_NOBAR(pb + 5);
        if (PHON(8) && IN(pb + 6)) { PHASE_PTRS();
            if (MK_N_LAUNCHES != 1) moe_tables(F, l);
            gm::SchedMoe<false> S{tab, (const char*)hid, (const char*)(wl + WL_WD), list, 8, F.G, F.bx, F.ctl + CW_MFLAG + l * 160 * 16};
            gm::EpiMoe2 E{ffo};
            for (int rep_ = 0; rep_ < REPS(8); ++rep_) gm::gemm_phase<true, 1>(F.lds, S, E);
        } SEAM(pb + 6);
        if (PHON(9) && IN(pb + 7)) { PHASE_PTRS();
            if (MK_N_LAUNCHES != 1) moe_tables(F, l);
            LnArgs a{}; a.zin = z1; a.ffo = ffo; a.route = route; a.tab = tab; a.g = INP(17) + l * DM; a.b = INP(18) + l * DM;
            if (l + 1 < NLAYER) { a.hf = nullptr; a.hb = hb; a.h8 = ws + WS_HB8; a.whi = (const bf16_t*)(ws + WS_SKW + (size_t)(l + 1) * SKW_FGT_BYTES); a.wlo = a.whi + 16 * 2048; a.S12 = (const float*)(ws + WS_SKS + (size_t)(l + 1) * 512);
                a.bfor = INP(4) + (l + 1) * 8; a.logf = logf; for (int rep_ = 0; rep_ < REPS(9); ++rep_) ln_pass<2, 1, true>(F, a); }
            else { a.hf = F.out; a.hb = nullptr; ln_pass<2, 1, false>(F, a); }
        } SEAM(pb + 7);
    }
    { constexpr int l = 1;
        const int pb = 2 + 8 * l;
        if (PHON(2) && IN(pb + 0)) { PHASE_PTRS();
            gm::SchedDense S{(const char*)hb, (const char*)(wl + WL_WIN), 2048 * 2, 2048 * 2, 32, 64, N_BF16_TILES, F.G, F.bx, 1};
            gm::EpiProj E{proj, cosT, sinT, 1.f};
            for (int rep_ = 0; rep_ < REPS(2); ++rep_) gm::gemm_phase<true, 0>(F.lds, S, E);
            gm::SchedDense S8{(const char*)(ws + WS_HB8), (const char*)(wl + WL_WIN8), 2048, 2048, 16, 64, N_FP8_TILES, F.G, F.bx, 2};
            gm::EpiProj E8{proj, cosT, sinT, 1.f / W8_SCALE};
            for (int rep_ = 0; rep_ < REPS(2); ++rep_) gm::gemm_phase<true, 1>(F.lds, S8, E8);
        } SEAM(pb + 0);
        if (PHON(3) && IN(pb + 1)) { mixer_phase(l); } SEAM(pb + 1);
        if (PHON(4) && IN(pb + 2)) { PHASE_PTRS();
            gm::SchedMerge S{(const char*)yfox, (const char*)(wl + WL_WBF), (const char*)yret, (const char*)(wl + WL_WBR), 64, 8, F.G, F.bx};
            gm::EpiMerge E{proj, mg};
            for (int rep_ = 0; rep_ < REPS(4); ++rep_) gm::gemm_phase<true, 2>(F.lds, S, E);
        } SEAM(pb + 2);
        if (PHON(5) && IN(pb + 3)) { PHASE_PTRS();
            gm::SchedDense S{(const char*)mg, (const char*)(wl + WL_WOUT), 2048 * 2, 2048 * 2, 32, 64, 8, F.G, F.bx, 0};
            gm::EpiMix E{yret};
            for (int rep_ = 0; rep_ < REPS(5); ++rep_) gm::gemm_phase<true, 0>(F.lds, S, E);
        } SEAM(pb + 3);
        if (PHON(6) && IN(pb + 4)) { PHASE_PTRS();
            LnArgs a{}; a.zb = hb; a.mix = yret; a.hf = z1; a.hb = nullptr; a.h8 = ws + WS_MG; a.g = INP(8) + l * DM; a.b = INP(9) + l * DM;
            a.whi = (const bf16_t*)(ws + WS_SKW + 2 * SKW_FGT_BYTES + (size_t)l * SKW_RTR_BYTES); a.wlo = a.whi + 48 * 2048; a.S12 = (const float*)(ws + WS_SKS + (size_t)(2 + l) * 512);
            a.brg = INP(11) + l * 4; a.bre = INP(13) + l * 32; a.route_out = route; a.list = list; a.wlist = wlist; a.cnt = (unsigned*)(F.ctl + CW_CNT + l * 2048);
            ln_pass<1, 3, true>(F, a);
        } SEAM(pb + 4);
        if (PHON(7) && IN(pb + 5)) { PHASE_PTRS();
            moe_tables(F, l);
            gm::SchedMoe<true> S{tab, (const char*)(ws + WS_MG), (const char*)(wl + WL_WGU), list, 4, F.G, F.bx, nullptr};
            gm::EpiMoe1 E{(unsigned char*)hid, wlist, tab, F.ctl + CW_MFLAG + l * 160 * 16};
            for (int rep_ = 0; rep_ < REPS(7); ++rep_) gm::gemm_phase<true, 1>(F.lds, S, E);
        } SEAM_NOBAR(pb + 5);
        if (PHON(8) && IN(pb + 6)) { PHASE_PTRS();
            if (MK_N_LAUNCHES != 1) moe_tables(F, l);
            gm::SchedMoe<false> S{tab, (const char*)hid, (const char*)(wl + WL_WD), list, 8, F.G, F.bx, F.ctl + CW_MFLAG + l * 160 * 16};
            gm::EpiMoe2 E{ffo};
            for (int rep_ = 0; rep_ < REPS(8); ++rep_) gm::gemm_phase<true, 1>(F.lds, S, E);
        } SEAM(pb + 6);
        if (PHON(9) && IN(pb + 7)) { PHASE_PTRS();
            if (MK_N_LAUNCHES != 1) moe_tables(F, l);
            LnArgs a{}; a.zin = z1; a.ffo = ffo; a.route = route; a.tab = tab; a.g = INP(17) + l * DM; a.b = INP(18) + l * DM;
            if (l + 1 < NLAYER) { a.hf = nullptr; a.hb = hb; a.h8 = ws + WS_HB8; a.whi = (const bf16_t*)(ws + WS_SKW + (size_t)(l + 1) * SKW_FGT_BYTES); a.wlo = a.whi + 16 * 2048; a.S12 = (const float*)(ws + WS_SKS + (size_t)(l + 1) * 512);
                a.bfor = INP(4) + (l + 1) * 8; a.logf = logf; for (int rep_ = 0; rep_ < REPS(9); ++rep_) ln_pass<2, 1, true>(F, a); }
            else { a.hf = F.out; a.hb = nullptr; ln_pass<2, 1, false>(F, a); }
        } SEAM(pb + 7);
    }
    if (STAMP_K >= 0) { __syncthreads(); if (blockIdx.x == 0 && threadIdx.x == 0) { asm volatile("s_waitcnt vmcnt(0)" ::: "memory"); GAS unsigned long long* st_ = (GAS unsigned long long*)((GAS unsigned char*)args.ws + WS_CTL + 65536);
        ((GAS float*)args.out)[0] += (float)((STAMP_K == 100 ? st_[40] - st_[3] : STAMP_K == 101 ? st_[41] - st_[3] : st_[STAMP_K + 1] - st_[STAMP_K])) * 0.01f * 0.01f; } }
#undef IN
#undef SEAM
#undef GRID_BAR
}

extern "C" void kernel_launch(void* const* d_in, const int* in_sizes, int n_in, void* d_out, int out_size, void* d_ws, size_t ws_size, hipStream_t stream) {
    static int grid = 0;
    if (grid == 0) {
        if (n_in != 19 || out_size != NTOK * DM || ws_size < WS_END) { fprintf(stderr, "kernel_launch: unexpected problem (n_in %d, out %d, ws %zu)\n", n_in, out_size, ws_size); grid = -1; }
        int dev = 0, cus = 0;
        if (grid == 0 && (hipGetDevice(&dev) != hipSuccess || hipDeviceGetAttribute(&cus, hipDeviceAttributeMultiprocessorCount, dev) != hipSuccess)) grid = -1;
        if (grid == 0 && hipFuncSetAttribute((const void*)hybrid_fwd, hipFuncAttributeMaxDynamicSharedMemorySize, LDS_BYTES) != hipSuccess) { fprintf(stderr, "kernel_launch: hipFuncSetAttribute failed\n"); grid = -1; }
        (void)hipGetLastError();
        if (grid == 0) grid = cus;
    }
    if (grid < 0) { (void)hipMemsetAsync(d_out, 0xFF, (size_t)out_size * 4, stream); return; }
    if (hipMemsetAsync((char*)d_ws + WS_CTL, 0, CTL_ZERO_BYTES, stream) != hipSuccess) return;
    Args a{};
    for (int i = 0; i < 19; ++i) a.in[i] = (const float*)d_in[i];
    a.out = (float*)d_out; a.ws = (unsigned char*)d_ws;
#if MK_N_LAUNCHES == 1
    a.ph_lo = 0; a.ph_hi = N_PHASES;
    hipLaunchKernelGGL(hybrid_fwd, dim3(grid), dim3(NWAVES * 64), LDS_BYTES, stream, a);
#else
    for (int ph = 0; ph < N_PHASES; ++ph) { a.ph_lo = ph; a.ph_hi = ph + 1; hipLaunchKernelGGL(hybrid_fwd, dim3(grid), dim3(NWAVES * 64), LDS_BYTES, stream, a); }
#endif
}
```

```cpp
#include <hip/hip_runtime.h>
#include <cstdio>
#include <cstdint>
#include <type_traits>

#ifndef MK_N_LAUNCHES
#define MK_N_LAUNCHES 1
#endif

#define LAS __attribute__((address_space(3)))
#define GAS __attribute__((address_space(1)))
typedef unsigned short bf16_t;
typedef short bf16x8 __attribute__((ext_vector_type(8)));
typedef short s16x4 __attribute__((ext_vector_type(4)));
typedef float f32x4 __attribute__((ext_vector_type(4)));
typedef float f32x2 __attribute__((ext_vector_type(2)));
typedef float f32x16 __attribute__((ext_vector_type(16)));
typedef unsigned u32x4 __attribute__((ext_vector_type(4)));
typedef unsigned u32x2 __attribute__((ext_vector_type(2)));
typedef GAS unsigned gu32;
#define RLX_AGENT __ATOMIC_RELAXED, __HIP_MEMORY_SCOPE_AGENT
#define LDS_WAIT() asm volatile("s_waitcnt lgkmcnt(0)" ::: "memory")
#define VM_WAIT() asm volatile("s_waitcnt vmcnt(0)" ::: "memory")
#define SBAR() __builtin_amdgcn_sched_barrier(0)

constexpr int NTOK = 16384, DM = 2048, SEQ = 2048, NBATCH = 8, NLAYER = 2;
constexpr int NPROJ = 13312;
constexpr int C_FQ = 0, C_FK = 1024, C_FV = 2048, C_RQ = 3072, C_RK = 4096, C_RV = 5120, C_RG = 7168, C_GF = 9216, C_GR = 11264;
constexpr int W_IN_COLS = 13320;
constexpr int NEXP = 32, DEXP = 512;
constexpr int HID_ROWS = 40960;
constexpr float ALPHA = 1.4142135623730951f;
constexpr float LN_EPS = 1e-5f, RMS_EPS = 1e-6f;
constexpr float LOG2E = 1.4426950408889634f;
constexpr float QSCALE = 0.08838834764831845f * LOG2E;
constexpr float KSCALE = 0.08838834764831845f;

constexpr size_t MiB = 1u << 20;
constexpr size_t WS_CTL = 0, CTL_ZERO_BYTES = 1 * MiB;
constexpr size_t WS_ROPE = 1 * MiB;
constexpr size_t WS_SKW = 2 * MiB;
constexpr size_t SKW_FGT_BYTES = 16 * 2048 * 2 * 2, SKW_RTR_BYTES = 48 * 2048 * 2 * 2;
constexpr size_t WS_SKS = 3 * MiB;
constexpr size_t WS_LOGF = 3 * MiB + 512 * 1024;
constexpr size_t WS_ROUTE = 4 * MiB;
constexpr size_t WS_LIST = 5 * MiB;
constexpr size_t WS_WLIST = 7 * MiB;
constexpr size_t WS_W = 16 * MiB;
constexpr size_t WL_WIN = 0, WL_WBF = 52 * MiB, WL_WBR = 56 * MiB, WL_WOUT = 64 * MiB, WL_WGU = 72 * MiB, WL_WD = 200 * MiB, WL_BYTES = 264 * MiB;
constexpr size_t WS_HF = 280 * MiB;
constexpr size_t WS_HB = 408 * MiB;
constexpr size_t WS_YF = 472 * MiB, WS_YR = 504 * MiB, WS_MG = 568 * MiB;
constexpr size_t WS_PROJ = 632 * MiB;
constexpr size_t WS_Z1 = WS_PROJ, WS_HID = WS_PROJ + 128 * MiB, WS_FFO = WS_PROJ + 168 * MiB;
constexpr size_t WS_END = 1048 * MiB;
static_assert(WS_FFO + (size_t)HID_ROWS * 2048 * 2 <= WS_END && WS_HID + (size_t)HID_ROWS * 512 * 2 <= WS_FFO, "overlay map");
constexpr int CW_TMO = 0;
constexpr int CW_BAR = 4096;
constexpr int CW_QUEUE = 8192;
constexpr int CW_MFLAG = 49152;
constexpr int CW_CNT = 9216;

constexpr int RING_BYTES = 131072;
constexpr int LDSCTL_OFF = RING_BYTES;
constexpr int MISC_OFF = LDSCTL_OFF;
constexpr int MOE_OFF = LDSCTL_OFF + 256;
constexpr int LNS_OFF = LDSCTL_OFF + 1024;
constexpr int LDS_BYTES = 163840;

__device__ __forceinline__ unsigned cvt_pk_bf16(float lo, float hi) { unsigned r; asm volatile("v_cvt_pk_bf16_f32 %0, %1, %2" : "=v"(r) : "v"(lo), "v"(hi)); return r; }
__device__ __forceinline__ unsigned f2bf(float f) { unsigned u = __builtin_bit_cast(unsigned, f); return (u + 0x7fffu + ((u >> 16) & 1u)) >> 16; }
__device__ __forceinline__ unsigned pk2(float lo, float hi) { return f2bf(lo) | (f2bf(hi) << 16); }
__device__ __forceinline__ float bf2f(unsigned short b) { return __builtin_bit_cast(float, ((unsigned)b) << 16); }
__device__ __forceinline__ float bflo(unsigned w) { return __builtin_bit_cast(float, w << 16); }
__device__ __forceinline__ float bfhi(unsigned w) { return __builtin_bit_cast(float, w & 0xffff0000u); }
__device__ __forceinline__ float fast_sigmoid(float x) { return __builtin_amdgcn_rcpf(1.0f + __builtin_amdgcn_exp2f(-x * LOG2E)); }
__device__ __forceinline__ int opaque_tid() { int t = threadIdx.x; asm volatile("" : "+v"(t)); return t; }
typedef int v4i_t __attribute__((ext_vector_type(4)));
typedef int v8i_t __attribute__((ext_vector_type(8)));
__device__ __forceinline__ unsigned pk4_fp8(float a, float b, float c_, float d) { int w = __builtin_amdgcn_cvt_pk_fp8_f32(a, b, 0, false); w = __builtin_amdgcn_cvt_pk_fp8_f32(c_, d, w, true); return (unsigned)w; }
constexpr float W8_SCALE = 32.f;
constexpr float HID8_SCALE = 64.f;
constexpr int N_BF16_TILES = 24, N_FP8_TILES = 28;
__host__ __device__ constexpr int tile_of_bf16(int i) { return 12 + i; }
__host__ __device__ constexpr int tile_of_fp8(int i) { return i < 12 ? i : 36 + (i - 12); }
__host__ __device__ constexpr int slot_of_tile(int t) { return t < 12 ? ~t : t < 36 ? t - 12 : ~(12 + (t - 36)); }
constexpr size_t WL_WIN8 = WL_WIN + (size_t)N_BF16_TILES * 256 * 2048 * 2;
constexpr size_t WS_HB8 = WS_MG;
constexpr size_t PJ_M = (size_t)1 << 20;
constexpr size_t PJ_FQ = 0, PJ_FK = 16 * PJ_M, PJ_FV = 32 * PJ_M, PJ_RQ = 48 * PJ_M, PJ_RK = 64 * PJ_M, PJ_RV = 80 * PJ_M, PJ_RG = 112 * PJ_M, PJ_GF = 144 * PJ_M, PJ_GR = 176 * PJ_M;
static_assert((PJ_GR + 32 * PJ_M) * 2 == (size_t)NTOK * NPROJ * 2, "proj region map");
constexpr int RSEG = 4, RCPS = (SEQ / 64) / RSEG;
constexpr size_t WS_RLOC = WS_MG;
constexpr int CW_RFLAG = 32768;
constexpr float Y8_SCALE = 16.f;
namespace gm {
constexpr int BM = 256, BK = 64, HALF = 128, HTB = HALF * BK * 2, STAGE_BYTES = 8 * HTB, NXCD = 8, WGM = 8;
__host__ __device__ __forceinline__ int lds_byte(int r, int c) { const int st = (r >> 4) * 2 + (c >> 5), rr = r & 15, cc = c & 31, ob = rr * 64 + cc * 2; return st * 1024 + (ob ^ (((ob >> 9) & 1) << 5)); }
__host__ __device__ __forceinline__ void stage_rc(int b, int& R, int& C) { const int st = b / 1024, sb = b % 1024, swz = sb ^ (((sb >> 9) & 1) << 5); R = (st >> 1) * 16 + swz / 64; C = (st & 1) * 32 + (swz % 64) / 2; }
__host__ __device__ __forceinline__ int perm32(int rho) { const int n = rho >> 4, i = rho & 15; return 8 * (i >> 2) + 4 * n + (i & 3); }

struct Unit {
    const char* A;
    const char* B;
    unsigned lda, ldb;
    int nt;
    int pm, pn;
    int kind;
    int e, rows;
    int keep;
    int f8;
};
__device__ __forceinline__ bool static_tile(int L, int nM, int nN, int& pm, int& pn) {
    const int nwg = nM * nN; if (L >= nwg) return false;
    int wgid = L; { const int q = nwg / NXCD, r = nwg % NXCD, xcd = wgid % NXCD, off = wgid / NXCD; wgid = (xcd < r ? xcd * (q + 1) : r * (q + 1) + (xcd - r) * q) + off; }
    const int nig = WGM * nN, gid = wgid / nig, fm = gid * WGM, gsz = (nM - fm) < WGM ? (nM - fm) : WGM;
    pm = fm + ((wgid % nig) % gsz); pn = (wgid % nig) / gsz; return true;
}

template <class E, class = void> struct has_publish : std::false_type {};
template <class E> struct has_publish<E, std::void_t<decltype(&E::publish)>> : std::true_type {};
template <bool PERM, int FP8, class Sched, class Epi>
__device__ __forceinline__ void gemm_phase(LAS unsigned char* lds, const Sched& S, const Epi& E) {
    const int tid = opaque_tid(), wid = __builtin_amdgcn_readfirstlane(tid >> 6), lane = tid & 63, wr = wid >> 2, wc = wid & 3, fr = lane & 15, fq = lane >> 4;
    int Rr[2], Cc[2], Rb[2];
#pragma unroll
    for (int i = 0; i < 2; ++i) { int R, C; stage_rc(tid * 16 + i * 8192, R, C); Rr[i] = R; Cc[i] = C; Rb[i] = PERM ? ((R & ~31) + perm32(R & 31)) : R; }
    const unsigned ldsw = (unsigned)wid * 1024u;
    const int aoff = lds_byte(wr * 64 + fr, fq * 8), boff = lds_byte(wc * 32 + fr, fq * 8);
#define PG8_SA(b, h) (((b) * 2 + (h)) * HTB)
#define PG8_SB(b, h) ((4 + (b) * 2 + (h)) * HTB)
#define PG8_STAGE(bufoff, gbase, voff) do { _Pragma("unroll") for (int _i = 0; _i < 2; ++_i) \
        __builtin_amdgcn_global_load_lds((const unsigned*)((const char*)(gbase) + (voff)[_i]), (LAS unsigned*)(lds + (bufoff) + ldsw + _i * 8192), 16, 0, 0); } while (0)
#define PG8_LD8(p_) __builtin_shufflevector(*(const LAS v4i_t*)(p_), *(const LAS v4i_t*)((p_) + 1024), 0, 1, 2, 3, 4, 5, 6, 7)
#define PG8_LDA(dst, b, h) do { _Pragma("unroll") for (int m = 0; m < 4; ++m) dst[m] = PG8_LD8(lds + PG8_SA(b, h) + aoff + m * 2048); } while (0)
#define PG8_LDB(dst, b, h) do { _Pragma("unroll") for (int n = 0; n < 2; ++n) dst[n] = PG8_LD8(lds + PG8_SB(b, h) + boff + n * 2048); } while (0)
#define PG8_LO(v_) __builtin_bit_cast(bf16x8, __builtin_shufflevector(v_, v_, 0, 1, 2, 3))
#define PG8_HI(v_) __builtin_bit_cast(bf16x8, __builtin_shufflevector(v_, v_, 4, 5, 6, 7))
#define PG8_MMA8(ai, bj, At, Bt) do { _Pragma("unroll") for (int m = 0; m < 4; ++m) _Pragma("unroll") for (int n = 0; n < 2; ++n) \
            acc[ai][bj][m][n] = __builtin_amdgcn_mfma_scale_f32_16x16x128_f8f6f4(Bt[n], At[m], acc[ai][bj][m][n], 0, 0, 0, 0x7f7f7f7f, 0, 0x7f7f7f7f); } while (0)
#define PG8_MMA16(ai, bj, At, Bt) do { _Pragma("unroll") for (int m = 0; m < 4; ++m) _Pragma("unroll") for (int n = 0; n < 2; ++n) { \
            acc[ai][bj][m][n] = __builtin_amdgcn_mfma_f32_16x16x32_bf16(PG8_LO(Bt[n]), PG8_LO(At[m]), acc[ai][bj][m][n], 0, 0, 0); \
            acc[ai][bj][m][n] = __builtin_amdgcn_mfma_f32_16x16x32_bf16(PG8_HI(Bt[n]), PG8_HI(At[m]), acc[ai][bj][m][n], 0, 0, 0); } } while (0)
#define PG8_MMAF8(ai, bj, At, Bt) do { __builtin_amdgcn_s_setprio(1); PG8_MMA8(ai, bj, At, Bt); __builtin_amdgcn_s_setprio(0); } while (0)
#define PG8_MMAF16(ai, bj, At, Bt) do { __builtin_amdgcn_s_setprio(1); PG8_MMA16(ai, bj, At, Bt); __builtin_amdgcn_s_setprio(0); } while (0)
#define PG8_WAIT_V(n) asm volatile("s_waitcnt vmcnt(" #n ")" ::: "memory")
#define PG8_WAIT_L(n) asm volatile("s_waitcnt lgkmcnt(" #n ")" ::: "memory")
#define PG8_BAR __builtin_amdgcn_s_barrier()
#define PG8_SCHED __builtin_amdgcn_sched_barrier(0)
#define PG8_OFFS(u, tk) do { _Pragma("unroll") for (int _i = 0; _i < 2; ++_i) { \
        vA0[_i] = (Sched::GATHER ? (unsigned)tk[_i] : (unsigned)Rr[_i]) * (u).lda + (unsigned)Cc[_i] * 2u; vA1[_i] = (Sched::GATHER ? (unsigned)tk[2 + _i] : (unsigned)(HALF + Rr[_i])) * (u).lda + (unsigned)Cc[_i] * 2u; \
        vB[_i] = (unsigned)Rb[_i] * (u).ldb + (unsigned)Cc[_i] * 2u; } } while (0)
#define PG8_TOKS(u, tk) do { if (Sched::GATHER) { tk[0] = S.tok(u, Rr[0]); tk[1] = S.tok(u, Rr[1]); tk[2] = S.tok(u, HALF + Rr[0]); tk[3] = S.tok(u, HALF + Rr[1]); } } while (0)
    Unit cur, nxt; int ui = 0;
    if (!S.next(0, cur)) return;
    f32x4 acc[2][2][4][2];
#pragma unroll
    for (int a = 0; a < 2; ++a)
#pragma unroll
        for (int b = 0; b < 2; ++b)
#pragma unroll
            for (int m = 0; m < 4; ++m)
#pragma unroll
                for (int n = 0; n < 2; ++n) acc[a][b][m][n] = (f32x4){0.f, 0.f, 0.f, 0.f};
    v8i_t At[4], B0[2], B1[2];
    unsigned vA0[2], vA1[2], vB[2];
    int tk[4] = {0, 0, 0, 0};
    PG8_TOKS(cur, tk); PG8_OFFS(cur, tk);
    const char* cA = cur.A; const char* cB = cur.B; size_t hB = (size_t)HALF * cur.ldb;
    const size_t kstep = (size_t)(BK * 2);
    PG8_STAGE(PG8_SB(0, 0), cB, vB); PG8_STAGE(PG8_SB(0, 1), cB + hB, vB); PG8_STAGE(PG8_SA(0, 0), cA, vA0); PG8_STAGE(PG8_SA(0, 1), cA, vA1);
    if (wr == 1) PG8_BAR;
    PG8_WAIT_V(2); PG8_BAR;
    PG8_STAGE(PG8_SB(1, 0), cB + kstep, vB); PG8_STAGE(PG8_SA(1, 0), cA + kstep, vA0); PG8_STAGE(PG8_SB(1, 1), cB + hB + kstep, vB);
    PG8_WAIT_V(6); PG8_BAR;
#define PG8_UNIT(MMX_) do { \
        bool has_next = false; \
        const char* nAp = cA; const char* nBp = cB; size_t nhB = hB; \
        int nt = cur.nt; asm volatile("" : "+s"(nt)); \
        for (int t = 0; t < nt; t += 2) { \
            const bool last = (t == nt - 2); \
            asm volatile("" : "+v"(vA0[0]), "+v"(vA0[1]), "+v"(vA1[0]), "+v"(vA1[1]), "+v"(vB[0]), "+v"(vB[1])); \
            if (last) { has_next = S.next(ui + 1, nxt); if (has_next) { nAp = nxt.A; nBp = nxt.B; nhB = (size_t)HALF * nxt.ldb; } } \
            const char* a1 = cA + (size_t)(t + 1) * kstep; \
            const char* a2 = last ? nAp : cA + (size_t)(t + 2) * kstep; const char* b2 = last ? nBp : cB + (size_t)(t + 2) * kstep; \
            const char* a3 = a2 + kstep; const char* b3 = b2 + kstep; \
            const size_t h2 = last ? nhB : hB; \
            PG8_LDB(B0, 0, 0); PG8_LDB(B1, 0, 1); PG8_SCHED; PG8_LDA(At, 0, 0); PG8_STAGE(PG8_SA(1, 1), a1, vA1); \
            if (last && has_next) { PG8_TOKS(nxt, tk); PG8_OFFS(nxt, tk); } \
            PG8_WAIT_V(8); PG8_WAIT_L(0); PG8_BAR; MMX_(0, 0, At, B0); MMX_(0, 1, At, B1); PG8_BAR; PG8_SCHED; \
            PG8_LDA(At, 0, 1); PG8_STAGE(PG8_SB(0, 0), b2, vB); PG8_STAGE(PG8_SB(0, 1), b2 + h2, vB); PG8_STAGE(PG8_SA(0, 0), a2, vA0); \
            PG8_WAIT_V(8); PG8_WAIT_L(0); PG8_BAR; MMX_(1, 0, At, B0); MMX_(1, 1, At, B1); PG8_BAR; PG8_SCHED; \
            PG8_LDB(B0, 1, 0); PG8_LDB(B1, 1, 1); PG8_SCHED; PG8_LDA(At, 1, 0); PG8_STAGE(PG8_SA(0, 1), a2, vA1); \
            PG8_WAIT_V(8); PG8_WAIT_L(0); PG8_BAR; MMX_(0, 0, At, B0); MMX_(0, 1, At, B1); PG8_BAR; PG8_SCHED; \
            PG8_LDA(At, 1, 1); PG8_STAGE(PG8_SB(1, 0), b3, vB); PG8_STAGE(PG8_SB(1, 1), b3 + h2, vB); PG8_STAGE(PG8_SA(1, 0), a3, vA0); \
            PG8_WAIT_V(8); PG8_WAIT_L(0); PG8_BAR; MMX_(1, 0, At, B0); MMX_(1, 1, At, B1); PG8_BAR; PG8_SCHED; \
        } \
        if (wr == 0) PG8_BAR; \
        { const int tz = opaque_tid() & 63; E(acc, cur, wr, wc, tz & 15, tz >> 4); } \
        if constexpr (has_publish<Epi>::value) E.publish(cur); \
        if (!has_next) { done = true; } else { \
        if (!cur.keep) { \
        _Pragma("unroll") \
            for (int a = 0; a < 2; ++a) \
        _Pragma("unroll") \
                for (int b = 0; b < 2; ++b) \
        _Pragma("unroll") \
                    for (int m = 0; m < 4; ++m) \
        _Pragma("unroll") \
                        for (int n = 0; n < 2; ++n) acc[a][b][m][n] = (f32x4){0.f, 0.f, 0.f, 0.f}; \
        } \
        cur = nxt; cA = nAp; cB = nBp; hB = nhB; ++ui; \
        if (wr == 1) PG8_BAR; } \
    } while (0)
    bool done = false;
    for (;;) {
        if constexpr (FP8 == 2) { PG8_UNIT(PG8_MMAF8); if (done) break; PG8_UNIT(PG8_MMAF16); if (done) break; }
        else if constexpr (FP8 == 1) { PG8_UNIT(PG8_MMAF8); if (done) break; }
        else { PG8_UNIT(PG8_MMAF16); if (done) break; }
    }
#undef PG8_UNIT
    PG8_WAIT_V(0);
    PG8_BAR;
#undef PG8_SA
#undef PG8_SB
#undef PG8_STAGE
#undef PG8_LDA
#undef PG8_LD8
#undef PG8_LO
#undef PG8_HI
#undef PG8_LDB
#undef PG8_MMAF8
#undef PG8_MMAF16
#undef PG8_MMA8
#undef PG8_MMA16
#undef PG8_WAIT_V
#undef PG8_WAIT_L
#undef PG8_BAR
#undef PG8_SCHED
#undef PG8_OFFS
#undef PG8_TOKS
}
}
namespace gm {
struct SchedDense {
    const char* A; const char* B; unsigned lda, ldb; int nt, nM, nN, G, c, pmap;
    __device__ __forceinline__ bool next(int i, Unit& u) const {
        int pm, pn; if (!static_tile(i * G + c, nM, nN, pm, pn)) return false;
        u.A = A + (size_t)pm * BM * lda; u.B = B + (size_t)pn * BM * ldb; u.lda = lda; u.ldb = ldb; u.nt = nt; u.pm = pm; u.pn = pmap == 0 ? pn : (pmap == 1 ? tile_of_bf16(pn) : tile_of_fp8(pn)); u.kind = 0; u.e = 0; u.rows = BM; u.keep = 0; u.f8 = 0; return true;
    }
    static constexpr bool GATHER = false;
    __device__ __forceinline__ int tok(const Unit&, int) const { return 0; }
};
struct SchedMerge {
    const char* Af; const char* Bf; const char* Ar; const char* Br; int nM, nN, G, c;
    __device__ __forceinline__ bool next(int i, Unit& u) const {
        int pm, pn; if (!static_tile((i >> 1) * G + c, nM, nN, pm, pn)) return false;
        if ((i & 1) == 0) { u.lda = 1024; u.ldb = 1024; u.A = Af + (size_t)pm * BM * u.lda; u.B = Bf + (size_t)pn * BM * u.ldb; u.nt = 8; u.kind = 0; u.keep = 1; u.f8 = 1; }
        else { u.lda = 2048 * 2; u.ldb = 2048 * 2; u.A = Ar + (size_t)pm * BM * u.lda; u.B = Br + (size_t)pn * BM * u.ldb; u.nt = 32; u.kind = 1; u.keep = 0; u.f8 = 0; }
        u.pm = pm; u.pn = pn; u.e = 0; u.rows = BM; return true;
    }
    static constexpr bool GATHER = false;
    __device__ __forceinline__ int tok(const Unit&, int) const { return 0; }
};
template <bool GATHER_> struct SchedMoe {
    static constexpr bool GATHER = GATHER_;
    const LAS int* tab;
    const char* A; const char* W;
    const int* list;
    int NCT, G, c;
    const gu32* flags;
    __device__ __forceinline__ bool next(int i, Unit& u) const {
        const int ntile = __builtin_amdgcn_readfirstlane(tab[96]); int L = i * G + c;
        if (!GATHER && flags) {
            const int nu1 = ntile * 4, n3 = nu1 - (nu1 / G) * G, P = 3;
            if (c < n3) L = P * (G - n3) + i * G + c; else L = i < P ? i * (G - n3) + (c - n3) : P * (G - n3) + (i - P) * G + c; }
        if (L >= ntile * NCT) return false;
        const int rt = L / NCT, ct = L % NCT; const int ln = opaque_tid() & 63;
        const int tbv = tab[64 + (ln & 31)];
        const int e = __builtin_amdgcn_readfirstlane(__popcll(__ballot(ln >= 1 && ln < 32 && tbv <= rt)));
        const int tl = rt - __builtin_amdgcn_readfirstlane(tab[64 + e]), rows = __builtin_amdgcn_readfirstlane(tab[e]) - tl * BM;
        u.e = e; u.rows = rows < BM ? rows : BM; u.pn = ct; u.kind = 0; u.keep = 0; u.f8 = 1;
        if (GATHER) { u.lda = 2048; u.ldb = 2048; u.nt = 16; u.A = A; u.B = W + ((size_t)e * 1024 + (size_t)ct * BM) * u.ldb; u.pm = tl; }
        else { u.lda = 512; u.ldb = 512; u.nt = 4; u.pm = __builtin_amdgcn_readfirstlane(tab[32 + e]) / BM + tl; u.A = A + (size_t)u.pm * BM * u.lda; u.B = W + ((size_t)e * 2048 + (size_t)ct * BM) * u.ldb;
            if (flags) { const gu32* fp = flags + rt * 16; int spins = 0;
                while (__hip_atomic_load(fp, __ATOMIC_RELAXED, __HIP_MEMORY_SCOPE_AGENT) < 32u && ++spins < (1 << 22)) __builtin_amdgcn_s_sleep(2);
                asm volatile("" ::: "memory"); } }
        return true;
    }
    __device__ __forceinline__ int tok(const Unit& u, int r) const { return (r < u.rows) ? list[u.e * 16384 + u.pm * BM + r] : 0; }
};

struct EpiProj {
    bf16_t* proj; const float* cosT; const float* sinT; float accs;
    __device__ __forceinline__ void operator()(const f32x4 (&acc)[2][2][4][2], const Unit& u, int wr, int wc, int fr, int fq) const {
        const int colt = u.pn * BM; const int row0 = u.pm * BM + wr * 64 + fr, col0 = colt + wc * 32 + 8 * fq;
        int kind; float sc = 1.f;
        if (colt < C_FK) { kind = 0; sc = QSCALE; } else if (colt < C_RQ) kind = 0; else if (colt < C_RV) { kind = 1; sc = (colt >= C_RK) ? KSCALE : 1.f; } else if (colt < C_RG) kind = 0; else if (colt < C_GF) kind = 2; else kind = 3;
        const int j0 = 16 * wc + 4 * fq;
#pragma unroll
        for (int ai = 0; ai < 2; ++ai)
#pragma unroll
            for (int m = 0; m < 4; ++m) { const int row = row0 + ai * HALF + m * 16; const int bb = row >> 11, ss = row & (SEQ - 1);
                size_t rb; int bjstep;
                if (colt < C_RV) { const int si = colt >> 10, h0 = (colt & 1023) >> 7; rb = (size_t)si * (16 * PJ_M) + ((size_t)(bb * 8 + h0) * SEQ + ss) * 128 + wc * 32 + 8 * fq; bjstep = SEQ * 128; }
                else if (colt < C_RG) { const int hh = (colt - C_RV) >> 8; rb = PJ_RV + ((size_t)(bb * 8 + hh) * SEQ + ss) * 256 + wc * 32 + 8 * fq; bjstep = 128; }
                else { const int si2 = (colt - C_RG) >> 11; rb = PJ_RG + (size_t)si2 * (32 * PJ_M) + (size_t)row * 2048 + ((colt - C_RG) & 2047) + wc * 32 + 8 * fq; bjstep = 128; }
                bf16_t* rowp = proj + rb;
                f32x4 cs = (f32x4){1.f, 1.f, 1.f, 1.f}, sn = (f32x4){0.f, 0.f, 0.f, 0.f};
                if (kind == 1) { const int pos = row & (SEQ - 1); cs = *(const f32x4*)(cosT + pos * 64 + j0); sn = *(const f32x4*)(sinT + pos * 64 + j0); }
#pragma unroll
                for (int bj = 0; bj < 2; ++bj) { f32x4 v0 = acc[ai][bj][m][0] * accs, v1 = acc[ai][bj][m][1] * accs;
                    if (kind == 1) { const f32x4 y1 = v0 * cs - v1 * sn, y2 = v0 * sn + v1 * cs; v0 = y1 * sc; v1 = y2 * sc; }
                    else if (kind == 2) {
#pragma unroll
                        for (int j = 0; j < 4; ++j) { v0[j] = v0[j] * fast_sigmoid(v0[j]); v1[j] = v1[j] * fast_sigmoid(v1[j]); } }
                    else if (kind == 3) {
#pragma unroll
                        for (int j = 0; j < 4; ++j) { v0[j] = fast_sigmoid(v0[j]); v1[j] = fast_sigmoid(v1[j]); } }
                    else { v0 = v0 * sc; v1 = v1 * sc; }
                    u32x4 w; w.x = cvt_pk_bf16(v0[0], v0[1]); w.y = cvt_pk_bf16(v0[2], v0[3]); w.z = cvt_pk_bf16(v1[0], v1[1]); w.w = cvt_pk_bf16(v1[2], v1[3]);
                    *(u32x4*)(rowp + bj * bjstep) = w; } }
    }
};
struct EpiMerge {
    const bf16_t* proj; bf16_t* mg;
    __device__ __forceinline__ void operator()(f32x4 (&acc)[2][2][4][2], const Unit& u, int wr, int wc, int fr, int fq) const {
        const int row0 = u.pm * BM + wr * 64 + fr, col0 = u.pn * BM + wc * 32 + 8 * fq;
#pragma unroll
        for (int ai = 0; ai < 2; ++ai)
#pragma unroll
            for (int m = 0; m < 4; ++m) { const int row = row0 + ai * HALF + m * 16; const bf16_t* pr = proj + (size_t)row * 2048 + col0;
#pragma unroll
                for (int bj = 0; bj < 2; ++bj) {
                    const u32x4 gr = *(const u32x4*)(pr + PJ_GR + bj * HALF);
                    f32x4 r0 = (f32x4){bflo(gr.x), bfhi(gr.x), bflo(gr.y), bfhi(gr.y)}, r1 = (f32x4){bflo(gr.z), bfhi(gr.z), bflo(gr.w), bfhi(gr.w)};
                    if (u.kind == 0) { const u32x4 gf = *(const u32x4*)(pr + PJ_GF + bj * HALF);
                        const f32x4 f0 = (f32x4){bflo(gf.x), bfhi(gf.x), bflo(gf.y), bfhi(gf.y)}, f1 = (f32x4){bflo(gf.z), bfhi(gf.z), bflo(gf.w), bfhi(gf.w)};
#pragma unroll
                        for (int j = 0; j < 4; ++j) { acc[ai][bj][m][0][j] *= f0[j] * __builtin_amdgcn_rcpf(r0[j]) * (1.f / (W8_SCALE * Y8_SCALE)); acc[ai][bj][m][1][j] *= f1[j] * __builtin_amdgcn_rcpf(r1[j]) * (1.f / (W8_SCALE * Y8_SCALE)); } }
                    else { const f32x4 v0 = acc[ai][bj][m][0] * r0, v1 = acc[ai][bj][m][1] * r1;
                        u32x4 w; w.x = cvt_pk_bf16(v0[0], v0[1]); w.y = cvt_pk_bf16(v0[2], v0[3]); w.z = cvt_pk_bf16(v1[0], v1[1]); w.w = cvt_pk_bf16(v1[2], v1[3]);
                        *(u32x4*)(mg + (size_t)row * DM + col0 + bj * HALF) = w; } } }
    }
};
struct EpiMix {
    bf16_t* mix;
    __device__ __forceinline__ void operator()(const f32x4 (&acc)[2][2][4][2], const Unit& u, int wr, int wc, int fr, int fq) const {
        const int row0 = u.pm * BM + wr * 64 + fr, col0 = u.pn * BM + wc * 32 + 8 * fq;
#pragma unroll
        for (int ai = 0; ai < 2; ++ai)
#pragma unroll
            for (int m = 0; m < 4; ++m) { bf16_t* rowp = mix + (size_t)(row0 + ai * HALF + m * 16) * DM + col0;
#pragma unroll
                for (int bj = 0; bj < 2; ++bj) { const f32x4 v0 = acc[ai][bj][m][0], v1 = acc[ai][bj][m][1];
                    u32x4 w; w.x = cvt_pk_bf16(v0[0], v0[1]); w.y = cvt_pk_bf16(v0[2], v0[3]); w.z = cvt_pk_bf16(v1[0], v1[1]); w.w = cvt_pk_bf16(v1[2], v1[3]);
                    *(u32x4*)(rowp + bj * HALF) = w; } }
    }
};
struct EpiMoe1 {
    unsigned char* hid; const float* wlist; const LAS int* tab;
    gu32* flags;
    __device__ __forceinline__ void publish(const Unit& u) const {
        asm volatile("s_waitcnt vmcnt(0)" ::: "memory");
        if ((opaque_tid() & 63) == 0) __hip_atomic_fetch_add(flags + (__builtin_amdgcn_readfirstlane(tab[64 + u.e]) + u.pm) * 16, 1u, __ATOMIC_RELAXED, __HIP_MEMORY_SCOPE_AGENT);
    }
    __device__ __forceinline__ void operator()(const f32x4 (&acc)[2][2][4][2], const Unit& u, int wr, int wc, int fr, int fq) const {
        const int r0 = wr * 64 + fr, hc0 = u.pn * 128 + wc * 16 + 4 * fq; const int slot0 = __builtin_amdgcn_readfirstlane(tab[32 + u.e]) + u.pm * BM;
#pragma unroll
        for (int ai = 0; ai < 2; ++ai)
#pragma unroll
            for (int m = 0; m < 4; ++m) { const int r = r0 + ai * HALF + m * 16; if (r < u.rows) {
                const float w = wlist[u.e * 16384 + u.pm * BM + r] * HID8_SCALE; unsigned char* rowp = hid + (size_t)(slot0 + r) * DEXP + hc0;
#pragma unroll
                for (int bj = 0; bj < 2; ++bj) { const f32x4 g = acc[ai][bj][m][0] * (1.f / W8_SCALE), up = acc[ai][bj][m][1] * (1.f / W8_SCALE); f32x4 h;
#pragma unroll
                    for (int j = 0; j < 4; ++j) h[j] = g[j] * fast_sigmoid(g[j]) * up[j] * w;
                    __hip_atomic_store((unsigned*)(rowp + bj * 64), pk4_fp8(h[0], h[1], h[2], h[3]), __ATOMIC_RELAXED, __HIP_MEMORY_SCOPE_AGENT); } } }
    }
};
struct EpiMoe2 {
    bf16_t* ffo;
    __device__ __forceinline__ void operator()(const f32x4 (&acc)[2][2][4][2], const Unit& u, int wr, int wc, int fr, int fq) const {
        const int r0 = wr * 64 + fr, col0 = u.pn * BM + wc * 32 + 8 * fq;
#pragma unroll
        for (int ai = 0; ai < 2; ++ai)
#pragma unroll
            for (int m = 0; m < 4; ++m) { const int r = r0 + ai * HALF + m * 16; if (r < u.rows) { bf16_t* rowp = ffo + (size_t)(u.pm * BM + r) * DM + col0;
#pragma unroll
                for (int bj = 0; bj < 2; ++bj) { const f32x4 v0 = acc[ai][bj][m][0] * (1.f / (W8_SCALE * HID8_SCALE)), v1 = acc[ai][bj][m][1] * (1.f / (W8_SCALE * HID8_SCALE));
                    u32x4 w; w.x = cvt_pk_bf16(v0[0], v0[1]); w.y = cvt_pk_bf16(v0[2], v0[3]); w.z = cvt_pk_bf16(v1[0], v1[1]); w.w = cvt_pk_bf16(v1[2], v1[3]);
                    *(u32x4*)(rowp + bj * HALF) = w; } } }
    }
};
}
#define XB_TMO      128
#define XB_XCNT(j)  (256  + 64 * (j))
#define XB_XSUB(j)  (1280 + 64 * (j))
#define XB_XGEN(j)  (2304 + 64 * (j))
#define XB_TOP      3328
#define XB_TOPGEN   3392
#define XCD_BAR_WORDS 3456
#define XB_SPIN_CAP (1u << 18)
__device__ __forceinline__ unsigned xb_ld(unsigned* p)              { return __hip_atomic_load(p, __ATOMIC_RELAXED, __HIP_MEMORY_SCOPE_AGENT); }
__device__ __forceinline__ unsigned xb_add(unsigned* p, unsigned v) { return __hip_atomic_fetch_add(p, v, __ATOMIC_RELAXED, __HIP_MEMORY_SCOPE_AGENT); }
__device__ __forceinline__ unsigned xb_xcc_id() { return (unsigned)__builtin_amdgcn_s_getreg((3 << 11) | 20) & 0xFu; }
#define XB_SPIN(cond, bar) do { unsigned _sp = 0; while (cond) { __builtin_amdgcn_s_sleep(1); \
    if ((++_sp & 255u) == 0u) { if (xb_ld(&(bar)[XB_TMO])) break; if (_sp > XB_SPIN_CAP) { atomicAdd(&(bar)[XB_TMO], 1u); break; } } } } while (0)
struct XcdBarrier { unsigned* bar; unsigned x; volatile LAS unsigned* st; };
__device__ __forceinline__ XcdBarrier xcd_barrier_post(unsigned* bar, volatile LAS unsigned* st) {
    XcdBarrier b; b.bar = bar; b.x = xb_xcc_id(); b.st = st;
    if (threadIdx.x == 0) (void)xb_add(&bar[XB_XCNT(b.x)], 1u);
    return b;
}
__device__ __forceinline__ void xcd_barrier_complete(unsigned* bar, unsigned x, unsigned& nloc, unsigned& nx) {
    const unsigned G = gridDim.x * gridDim.y * gridDim.z;
    unsigned sum, cnt, mine, sp = 0u;
    for (;;) {
        sum = 0u; cnt = 0u; mine = 0u;
#pragma unroll
        for (unsigned j = 0; j < 16; ++j) { const unsigned c = xb_ld(&bar[XB_XCNT(j)]); sum += c; cnt += (c > 0u) ? 1u : 0u; mine = (j == x) ? c : mine; }
        if (sum == G) break;
        __builtin_amdgcn_s_sleep(1);
        if ((++sp & 255u) == 0u) { if (xb_ld(&bar[XB_TMO])) break; if (sp > XB_SPIN_CAP) { atomicAdd(&bar[XB_TMO], 1u); break; } }
    }
    nloc = mine > 0u ? mine : 1u; nx = cnt > 0u ? cnt : 1u;
}
__device__ __forceinline__ void xcd_barrier(const XcdBarrier& b) {
    asm volatile("s_waitcnt vmcnt(0)" ::: "memory");
    __syncthreads();
    if (threadIdx.x == 0) {
        unsigned* bar = b.bar;
        __builtin_amdgcn_s_waitcnt(0);
        unsigned nloc = b.st[0], nx = b.st[1];
        if (nloc == 0u) { xcd_barrier_complete(bar, b.x, nloc, nx); b.st[0] = nloc; b.st[1] = nx; }
        const unsigned old = xb_add(&bar[XB_XSUB(b.x)], 1u);
        const unsigned gen = old / nloc;
        if (old + 1u == (gen + 1u) * nloc) {
            __builtin_amdgcn_fence(__ATOMIC_RELEASE, "agent");
            asm volatile("s_waitcnt vmcnt(0)" ::: "memory");
            const unsigned og = xb_add(&bar[XB_TOP], 1u);
            const unsigned tg = og / nx;
            if (og + 1u == (tg + 1u) * nx) xb_add(&bar[XB_TOPGEN], 1u);
            else XB_SPIN(xb_ld(&bar[XB_TOPGEN]) == tg, bar);
            __builtin_amdgcn_fence(__ATOMIC_ACQUIRE, "agent");
            xb_add(&bar[XB_XGEN(b.x)], 1u);
            asm volatile("s_waitcnt vmcnt(0)" ::: "memory");
        } else {
            XB_SPIN(xb_ld(&bar[XB_XGEN(b.x)]) == gen, bar);
            __builtin_amdgcn_fence(__ATOMIC_ACQUIRE, "agent");
            asm volatile("s_waitcnt vmcnt(0)" ::: "memory");
        }
    }
    __syncthreads();
}

constexpr int NWAVES = 8;
struct Frame {
    LAS unsigned char* lds; volatile LAS unsigned* MISC; gu32* ctl;
    int tid, lane, wave, G, bx;
    unsigned char* ws;
    float* out;
};
#define INP(i) ((const float*)(const GAS float*)(((const float* const*)__builtin_amdgcn_kernarg_segment_ptr())[i]))
#define KWS() ((unsigned char*)(GAS unsigned char*)(((unsigned char* const*)__builtin_amdgcn_kernarg_segment_ptr())[20]))
__device__ __forceinline__ float wave_sum(float v) {
#pragma unroll
    for (int o = 1; o < 64; o <<= 1) v += __shfl_xor(v, o);
    return v;
}

__device__ __forceinline__ void p0_transpose_item(const float* colp, size_t pitch, bf16_t* WT, int K, int n0, int k0, LAS float* scr, int lane) {
    float tv[32];
#pragma unroll
    for (int i = 0; i < 32; ++i) { const int kk = 2 * i + (lane >> 5); tv[i] = colp[(size_t)(k0 + kk) * pitch]; }
#pragma unroll
    for (int i = 0; i < 32; ++i) { const int kk = 2 * i + (lane >> 5); scr[kk * 33 + (lane & 31)] = tv[i]; }
    LDS_WAIT(); asm volatile("" ::: "memory");
    const int c = lane & 7;
#pragma unroll
    for (int j = 0; j < 4; ++j) { const int n = (lane >> 3) + 8 * j; const LAS float* s = scr + (8 * c) * 33 + n;
        u32x4 o; o.x = pk2(s[0 * 33], s[1 * 33]); o.y = pk2(s[2 * 33], s[3 * 33]); o.z = pk2(s[4 * 33], s[5 * 33]); o.w = pk2(s[6 * 33], s[7 * 33]);
        *(GAS u32x4*)(WT + (size_t)(n0 + n) * K + k0 + 8 * c) = o; }
    LDS_WAIT(); asm volatile("" ::: "memory");
}
__device__ __forceinline__ void p0_transpose_item8(const float* colp, size_t pitch, unsigned char* WT8, int K, int n0, int k0, float scale, LAS float* scr, int lane) {
    float tv[32];
#pragma unroll
    for (int i = 0; i < 32; ++i) { const int kk = 2 * i + (lane >> 5); tv[i] = colp[(size_t)(k0 + kk) * pitch]; }
#pragma unroll
    for (int i = 0; i < 32; ++i) { const int kk = 2 * i + (lane >> 5); scr[kk * 33 + (lane & 31)] = tv[i] * scale; }
    LDS_WAIT(); asm volatile("" ::: "memory");
    const int c = lane & 7;
#pragma unroll
    for (int j = 0; j < 4; ++j) { const int n = (lane >> 3) + 8 * j; const LAS float* s = scr + (8 * c) * 33 + n;
        u32x2 o; o.x = pk4_fp8(s[0 * 33], s[1 * 33], s[2 * 33], s[3 * 33]); o.y = pk4_fp8(s[4 * 33], s[5 * 33], s[6 * 33], s[7 * 33]);
        *(GAS u32x2*)(WT8 + (size_t)(n0 + n) * K + k0 + 8 * c) = o; }
    LDS_WAIT(); asm volatile("" ::: "memory");
}
__device__ __forceinline__ int win_srccol(int n) {
    if (n < C_RQ) return n;
    if (n < C_RV) { const int hh = (n - C_RQ) >> 7, p = (n - C_RQ) & 127; return 3080 + hh * 128 + 4 * (p >> 3) + (p & 3) + 64 * ((p >> 2) & 1); }
    return n + 8;
}
constexpr int IT_WINB = 16 * 4 * N_BF16_TILES, IT_WIN8 = 16 * 4 * N_FP8_TILES, IT_WIN = IT_WINB + IT_WIN8;
constexpr int IT_BF = 8 * 32, IT_BR = 16 * 32, IT_OUT = 16 * 32, IT_GU = 32 * 16 * 16, IT_D = 32 * 4 * 32, IT_LAYER = IT_WIN + IT_BF + IT_BR + IT_OUT + IT_GU + IT_D;
__device__ __forceinline__ void cv_item(const float* colp, size_t pitch, unsigned char* dst, int K, int n0, int k0, bool f8, int lane) {
    const int nq = lane & 15, rg = lane >> 4;
    f32x4 v[32];
    const float* cp = colp + (size_t)(k0 + 32 * rg) * pitch;
#pragma unroll
    for (int i = 0; i < 32; ++i) v[i] = *(const f32x4*)(cp + (size_t)i * pitch);
    if (f8) { unsigned char* dp = dst + (size_t)(n0 + 4 * nq) * K + k0 + 32 * rg;
#pragma unroll
        for (int t = 0; t < 4; ++t) { u32x4 o0, o1;
#define CV_P4(i_) pk4_fp8(v[i_][t] * W8_SCALE, v[(i_) + 1][t] * W8_SCALE, v[(i_) + 2][t] * W8_SCALE, v[(i_) + 3][t] * W8_SCALE)
            o0.x = CV_P4(0); o0.y = CV_P4(4); o0.z = CV_P4(8); o0.w = CV_P4(12); o1.x = CV_P4(16); o1.y = CV_P4(20); o1.z = CV_P4(24); o1.w = CV_P4(28);
#undef CV_P4
            *(u32x4*)(dp + (size_t)t * K) = o0; *(u32x4*)(dp + (size_t)t * K + 16) = o1; } }
    else { unsigned char* dp = dst + 2 * ((size_t)(n0 + 4 * nq) * K + k0 + 32 * rg);
#pragma unroll
        for (int t = 0; t < 4; ++t)
#pragma unroll
            for (int m = 0; m < 4; ++m) { u32x4 o; o.x = pk2(v[8 * m][t], v[8 * m + 1][t]); o.y = pk2(v[8 * m + 2][t], v[8 * m + 3][t]); o.z = pk2(v[8 * m + 4][t], v[8 * m + 5][t]); o.w = pk2(v[8 * m + 6][t], v[8 * m + 7][t]);
                *(u32x4*)(dp + (size_t)t * 2 * K + 16 * m) = o; } }
}
__device__ __forceinline__ void cv_one(int l, int it, unsigned char* ws, int lane) {
    unsigned char* wl = ws + WS_W; const int n4 = 4 * (lane & 15);
    const float* src; int pitch, K, n0, k0; unsigned char* dst; bool f8;
    int r = it;
    if (r < IT_WINB) { const int kb = r / (4 * N_BF16_TILES), sb = r % (4 * N_BF16_TILES), nb = tile_of_bf16(sb >> 2) * 4 + (sb & 3);
        src = INP(3) + (size_t)l * DM * W_IN_COLS + win_srccol(64 * nb + n4); pitch = W_IN_COLS; K = 2048; k0 = 128 * kb; dst = wl + WL_WIN; n0 = 64 * sb; f8 = false; }
    else if ((r -= IT_WINB) < IT_WIN8) { const int kb = r / (4 * N_FP8_TILES), sb = r % (4 * N_FP8_TILES), nb = tile_of_fp8(sb >> 2) * 4 + (sb & 3);
        src = INP(3) + (size_t)l * DM * W_IN_COLS + win_srccol(64 * nb + n4); pitch = W_IN_COLS; K = 2048; k0 = 128 * kb; dst = wl + WL_WIN8; n0 = 64 * sb; f8 = true; }
    else if ((r -= IT_WIN8) < IT_BF) { const int kb = r / 32, nb = r % 32; src = INP(5) + (size_t)l * 1024 * DM + 64 * nb + n4; pitch = DM; dst = wl + WL_WBF; K = 1024; n0 = 64 * nb; k0 = 128 * kb; f8 = true; }
    else if ((r -= IT_BF) < IT_BR) { const int kb = r / 32, nb = r % 32; src = INP(6) + (size_t)l * 2048 * DM + 64 * nb + n4; pitch = DM; dst = wl + WL_WBR; K = 2048; n0 = 64 * nb; k0 = 128 * kb; f8 = false; }
    else if ((r -= IT_BR) < IT_OUT) { const int kb = r / 32, nb = r % 32; src = INP(7) + (size_t)l * 2048 * DM + 64 * nb + n4; pitch = DM; dst = wl + WL_WOUT; K = 2048; n0 = 64 * nb; k0 = 128 * kb; f8 = false; }
    else if ((r -= IT_OUT) < IT_GU) { const int e = r / 256, q = r % 256, kb = q / 16, nb = q % 16; const int row = 64 * nb + n4, col = 4 * (row >> 3);
        src = (((row >> 2) & 1) ? INP(15) : INP(14)) + (size_t)(l * NEXP + e) * DM * DEXP + col; pitch = DEXP; dst = wl + WL_WGU + (size_t)e * 1024 * 2048; K = 2048; n0 = 64 * nb; k0 = 128 * kb; f8 = true; }
    else { r -= IT_GU; const int e = r / 128, q = r % 128, kb = q / 32, nb = q % 32;
        src = INP(16) + (size_t)(l * NEXP + e) * DEXP * DM + 64 * nb + n4; pitch = DM; dst = wl + WL_WD + (size_t)e * 2048 * 512; K = 512; n0 = 64 * nb; k0 = 128 * kb; f8 = true; }
    cv_item(src, (size_t)pitch, dst, K, n0, k0, f8, lane);
}
constexpr int IT_REST = IT_LAYER - IT_WIN;
__device__ __forceinline__ void p0_weights_win(Frame& F) {
    const int gw = F.bx * NWAVES + F.wave, NGW = F.G * NWAVES;
    for (int it = gw; it < IT_WIN; it += NGW) cv_one(0, it, F.ws, F.lane);
}
__device__ __forceinline__ void p0_tables(Frame& F) {
    const int gw = F.bx * NWAVES + F.wave, NGW = F.G * NWAVES, lane = F.lane;
    { float* cosT = (float*)(F.ws + WS_ROPE); float* sinT = cosT + SEQ * 64;
      for (int i = (F.bx * NWAVES + F.wave) * 64 + lane; i < SEQ * 64; i += NGW * 64) { const int pos = i >> 6, j = i & 63;
          double pw = 1.0; for (int t = 0; t < j; ++t) pw *= 0.8659643233600653;
          const float inv = (float)pw; const double ang = (double)((float)pos * inv);
          const double qd = __builtin_rint(ang * 0.6366197723675814); const double r = ang - qd * 1.5707963267948966, r2 = r * r; const int qi = (int)qd & 3;
          const double sr = r * (1.0 + r2 * (-1.0 / 6 + r2 * (1.0 / 120 + r2 * (-1.0 / 5040 + r2 * (1.0 / 362880 + r2 * (-1.0 / 39916800))))));
          const double cr = 1.0 + r2 * (-0.5 + r2 * (1.0 / 24 + r2 * (-1.0 / 720 + r2 * (1.0 / 40320 + r2 * (-1.0 / 3628800 + r2 * (1.0 / 479001600))))));
          const double sv = (qi == 0) ? sr : (qi == 1) ? cr : (qi == 2) ? -sr : -cr, cv = (qi == 0) ? cr : (qi == 1) ? -sr : (qi == 2) ? -cr : sr;
          cosT[i] = (float)cv; sinT[i] = (float)sv; } }
    for (int job = F.wave * F.G + F.bx; job < 2 * 16 + 2 * 48; job += NGW) {
        int t, c; if (job < 32) { t = job >> 4; c = job & 15; } else { t = 2 + (job - 32) / 48; c = (job - 32) % 48; }
        const int l = t & 1; const float *g, *b; const float* W = nullptr; size_t pitch = 0;
        if (t < 2) { g = l ? INP(17) : INP(1); b = l ? INP(18) : INP(2); if (c < 8) { W = INP(3) + (size_t)l * DM * W_IN_COLS + 3072 + c; pitch = W_IN_COLS; } }
        else { g = INP(8) + l * DM; b = INP(9) + l * DM; if (c < 4) { W = INP(10) + (size_t)l * DM * 4 + c; pitch = 4; } else if (c < 36) { W = INP(12) + (size_t)l * DM * 32 + (c - 4); pitch = 32; } }
        bf16_t* hi = (bf16_t*)(F.ws + WS_SKW + (t < 2 ? (size_t)t * SKW_FGT_BYTES : 2 * SKW_FGT_BYTES + (size_t)(t - 2) * SKW_RTR_BYTES)); const int ncol = t < 2 ? 16 : 48; bf16_t* lo = hi + ncol * 2048;
        float s1 = 0.f, s2 = 0.f;
        for (int kk = 0; kk < DM; kk += 64 * 8) {
            float wv[8], gv[8], bv[8];
#pragma unroll
            for (int u = 0; u < 8; ++u) { const int k = kk + 64 * u + lane; wv[u] = W ? W[(size_t)k * pitch] : 0.f; gv[u] = g[k]; bv[u] = b[k]; }
#pragma unroll
            for (int u = 0; u < 8; ++u) { const int k = kk + 64 * u + lane; const float w = wv[u]; const float gw_ = gv[u] * w; const unsigned h16 = f2bf(gw_); const float hf_ = __builtin_bit_cast(float, h16 << 16); const unsigned l16 = f2bf(gw_ - hf_);
                hi[c * 2048 + k] = (bf16_t)h16; lo[c * 2048 + k] = (bf16_t)l16; s1 += hf_ + __builtin_bit_cast(float, l16 << 16); s2 += bv[u] * w; } }
        s1 = wave_sum(s1); s2 = wave_sum(s2);
        if (lane == 0) { float* S = (float*)(F.ws + WS_SKS + (size_t)t * 512); S[c] = s1; S[64 + c] = s2; }
    }
}
struct LnArgs {
    const float* zin;
    const bf16_t* zb;
    float* hf; bf16_t* hb;
    unsigned char* h8;
    const float* g; const float* b;
    const bf16_t* whi; const bf16_t* wlo; const float* S12;
    const bf16_t* ffo; const int* route;
    const bf16_t* mix;
    const LAS int* tab;
    const float* bfor; float* logf;
    const float* brg; const float* bre; int* route_out; int* list; float* wlist; unsigned* cnt;
};
template <int MODE, int NCG, bool PROJ>
__device__ __forceinline__ void ln_pass(Frame& F, const LnArgs& a) {
    const int lane = F.lane, w = F.wave, r = lane & 15, q = lane >> 4, tid = F.tid;
    LAS float* red = (LAS float*)(F.lds + LNS_OFF);
    LAS float* part = (LAS float*)(F.lds + LNS_OFF + 1024);
    LAS float* lg = (LAS float*)(F.lds + LNS_OFF + 1024 + 24576);
    LAS unsigned char* stash = F.lds + w * 16384;
#define LN_ISSUE(g_) do { const int row_ = (g_) * 16 + r; const int kb_ = 256 * w + 8 * q; \
        if (MODE == 2) { const int4 rt = *(const int4*)(a.route + row_ * 4); \
            const size_t sa = (size_t)(a.tab[32 + rt.x] + rt.y), sb = (size_t)(a.tab[32 + rt.z] + rt.w); \
            const bf16_t* pa = a.ffo + sa * DM + kb_; const bf16_t* pb = a.ffo + sb * DM + kb_; \
            _Pragma("unroll") for (int s = 0; s < 8; ++s) { __builtin_amdgcn_global_load_lds((const unsigned*)(pa + 32 * s), (LAS unsigned*)(stash + (2 * s) * 1024), 16, 0, 0); \
                __builtin_amdgcn_global_load_lds((const unsigned*)(pb + 32 * s), (LAS unsigned*)(stash + (2 * s + 1) * 1024), 16, 0, 0); } } \
        else if (MODE == 1) { const bf16_t* zp_ = a.zb + (size_t)row_ * DM + kb_; \
            _Pragma("unroll") for (int s = 0; s < 8; ++s) __builtin_amdgcn_global_load_lds((const unsigned*)(zp_ + 32 * s), (LAS unsigned*)(stash + s * 1024), 16, 0, 0); } \
        else { const float* zp_ = a.zin + (size_t)row_ * DM + kb_; \
            _Pragma("unroll") for (int s = 0; s < 8; ++s) { __builtin_amdgcn_global_load_lds((const unsigned*)(zp_ + 32 * s), (LAS unsigned*)(stash + (2 * s) * 1024), 16, 0, 0); \
                __builtin_amdgcn_global_load_lds((const unsigned*)(zp_ + 32 * s + 4), (LAS unsigned*)(stash + (2 * s + 1) * 1024), 16, 0, 0); } } } while (0)
    const int kb = 256 * w + 8 * q;
    unsigned gq[8][2][4];
#define LN_GLOAD() do { _Pragma("unroll") for (int s = 0; s < 8; ++s) _Pragma("unroll") for (int hh = 0; hh < 2; ++hh) { \
            const f32x4 gv = *(const f32x4*)(a.g + kb + 32 * s + 4 * hh), bv = *(const f32x4*)(a.b + kb + 32 * s + 4 * hh); \
            gq[s][hh][0] = __builtin_bit_cast(unsigned, __builtin_amdgcn_cvt_pkrtz(gv[0] - 1.f, gv[1] - 1.f)); gq[s][hh][1] = __builtin_bit_cast(unsigned, __builtin_amdgcn_cvt_pkrtz(gv[2] - 1.f, gv[3] - 1.f)); \
            gq[s][hh][2] = __builtin_bit_cast(unsigned, __builtin_amdgcn_cvt_pkrtz(bv[0], bv[1])); gq[s][hh][3] = __builtin_bit_cast(unsigned, __builtin_amdgcn_cvt_pkrtz(bv[2], bv[3])); } } while (0)
    constexpr bool GRES = (MODE != 1);
    if (GRES) LN_GLOAD();
    else {
        LN_GLOAD();
        if (r == 0) {
#pragma unroll
            for (int s = 0; s < 8; ++s)
#pragma unroll
                for (int hh = 0; hh < 2; ++hh) { u32x4 t_; t_.x = gq[s][hh][0]; t_.y = gq[s][hh][1]; t_.z = gq[s][hh][2]; t_.w = gq[s][hh][3]; *(LAS u32x4*)(stash + 8192 + ((q * 8 + s) * 2 + hh) * 16) = t_; } }
        LDS_WAIT();
    }
    typedef _Float16 h16x2 __attribute__((ext_vector_type(2)));
#define LN_UNPK(dst, s_, hh_, i_) do { unsigned u0_ = gq[s_][hh_][i_], u1_ = gq[s_][hh_][(i_) + 1]; asm volatile("" : "+v"(u0_), "+v"(u1_)); const h16x2 h0_ = __builtin_bit_cast(h16x2, u0_), h1_ = __builtin_bit_cast(h16x2, u1_); \
        dst = (f32x4){(float)h0_[0], (float)h0_[1], (float)h1_[0], (float)h1_[1]}; } while (0)
    LAS float* tb = (LAS float*)(F.lds + LNS_OFF + 1024 + 24576 + 3072);
    LAS int* rrec = (LAS int*)(F.lds + LNS_OFF + 1024 + 24576 + 3072 + 256);
    LAS int* lcnt = rrec + 64 * 8;
    if (MODE == 1 && tid < 64) lcnt[tid] = 0;
    int nrec = 0;
    float s1a = 0.f, s2a = 0.f, s1b = 0.f, s2b = 0.f;
    if (PROJ) {
        if (MODE != 1) { if (tid < 8) tb[tid] = a.bfor[tid]; } else { if (tid < 4) tb[16 + tid] = a.brg[tid]; if (tid >= 32 && tid < 64) tb[tid] = a.bre[tid - 32]; }
        if (tid < 16 * 16 * NCG) { const int cc = tid % (16 * NCG); s1a = a.S12[cc]; s2a = a.S12[64 + cc]; }
        if (tid + NWAVES * 64 < 16 * 16 * NCG) { const int cc = (tid + NWAVES * 64) % (16 * NCG); s1b = a.S12[cc]; s2b = a.S12[64 + cc]; }
    }
    asm volatile("s_waitcnt vmcnt(0)" ::: "memory");
    if (F.bx < NTOK / 16) LN_ISSUE(F.bx);
    for (int gi = F.bx; gi < NTOK / 16; gi += F.G) {
        const int row = gi * 16 + r;
        f32x4 z[8][2];
        if (MODE == 2) {
            f32x4 rh[8][2];
            { const float* zp_ = a.zin + (size_t)row * DM + kb;
#pragma unroll
              for (int s = 0; s < 8; ++s) { rh[s][0] = *(const f32x4*)(zp_ + 32 * s); rh[s][1] = *(const f32x4*)(zp_ + 32 * s + 4); } }
            asm volatile("s_waitcnt vmcnt(0)" ::: "memory");
#pragma unroll
            for (int s = 0; s < 8; ++s) { const u32x4 ua = *(const LAS u32x4*)(stash + (2 * s) * 1024 + lane * 16), ub = *(const LAS u32x4*)(stash + (2 * s + 1) * 1024 + lane * 16);
                z[s][0] = rh[s][0] * ALPHA + ((f32x4){bflo(ua.x), bfhi(ua.x), bflo(ua.y), bfhi(ua.y)} + (f32x4){bflo(ub.x), bfhi(ub.x), bflo(ub.y), bfhi(ub.y)});
                z[s][1] = rh[s][1] * ALPHA + ((f32x4){bflo(ua.z), bfhi(ua.z), bflo(ua.w), bfhi(ua.w)} + (f32x4){bflo(ub.z), bfhi(ub.z), bflo(ub.w), bfhi(ub.w)}); }
        } else if (MODE == 1) {
            u32x4 rm[8];
            { const bf16_t* mp_ = a.mix + (size_t)row * DM + kb;
#pragma unroll
              for (int s = 0; s < 8; ++s) rm[s] = *(const u32x4*)(mp_ + 32 * s); }
            asm volatile("s_waitcnt vmcnt(0)" ::: "memory");
#pragma unroll
            for (int s = 0; s < 8; ++s) { const u32x4 um = rm[s]; const u32x4 uh = *(const LAS u32x4*)(stash + s * 1024 + lane * 16);
                z[s][0] = (f32x4){bflo(uh.x), bfhi(uh.x), bflo(uh.y), bfhi(uh.y)} * ALPHA + (f32x4){bflo(um.x), bfhi(um.x), bflo(um.y), bfhi(um.y)};
                z[s][1] = (f32x4){bflo(uh.z), bfhi(uh.z), bflo(uh.w), bfhi(uh.w)} * ALPHA + (f32x4){bflo(um.z), bfhi(um.z), bflo(um.w), bfhi(um.w)}; }
        } else {
            asm volatile("s_waitcnt vmcnt(0)" ::: "memory");
#pragma unroll
            for (int s = 0; s < 8; ++s) { z[s][0] = *(const LAS f32x4*)(stash + (2 * s) * 1024 + lane * 16); z[s][1] = *(const LAS f32x4*)(stash + (2 * s + 1) * 1024 + lane * 16); }
        }
        LDS_WAIT();
        float sm = 0.f, sq = 0.f;
#pragma unroll
        for (int s = 0; s < 8; ++s)
#pragma unroll
            for (int hh = 0; hh < 2; ++hh)
#pragma unroll
                for (int j = 0; j < 4; ++j) { const float v = z[s][hh][j]; sm += v; sq += v * v; }
        sm += __shfl_xor(sm, 16); sm += __shfl_xor(sm, 32); sq += __shfl_xor(sq, 16); sq += __shfl_xor(sq, 32);
        if (q == 0) { red[(w * 16 + r) * 2] = sm; red[(w * 16 + r) * 2 + 1] = sq; }
        if (PROJ) {
            f32x4 acc[NCG];
#pragma unroll
            for (int cg = 0; cg < NCG; ++cg) acc[cg] = (f32x4){0.f, 0.f, 0.f, 0.f};
            constexpr int WD = (MODE == 1) ? 8 : 6;
            bf16x8 bh[WD], bl[WD];
            unsigned wof[NCG];
#pragma unroll
            for (int cg = 0; cg < NCG; ++cg) { wof[cg] = (unsigned)((16 * cg + r) * DM + kb) * 2u; asm volatile("" : "+v"(wof[cg])); }
            constexpr int NVALID = (MODE == 1) ? 36 : 8;
#define LN_WLOAD(i_, bf_) do { const int cg_ = (i_) % NCG, s_ = (i_) / NCG; if (16 * cg_ + r < NVALID) { bh[bf_] = *(const bf16x8*)((const char*)a.whi + wof[cg_] + 64 * s_); bl[bf_] = *(const bf16x8*)((const char*)a.wlo + wof[cg_] + 64 * s_); } \
                else { bh[bf_] = (bf16x8){0, 0, 0, 0, 0, 0, 0, 0}; bl[bf_] = (bf16x8){0, 0, 0, 0, 0, 0, 0, 0}; } } while (0)
#pragma unroll
            for (int i = 0; i < WD - 1; ++i) LN_WLOAD(i, i % WD);
#pragma unroll
            for (int i = 0; i < 8 * NCG; ++i) { const int cg = i % NCG, s = i / NCG;
                asm volatile("" ::: "memory");
                if (i + WD - 1 < 8 * NCG) LN_WLOAD(i + WD - 1, (i + WD - 1) % WD);
                asm volatile("" ::: "memory");
                u32x4 hi, lo;
                { const f32x4 v0 = z[s][0], v1 = z[s][1];
                  hi.x = cvt_pk_bf16(v0[0], v0[1]); hi.y = cvt_pk_bf16(v0[2], v0[3]); hi.z = cvt_pk_bf16(v1[0], v1[1]); hi.w = cvt_pk_bf16(v1[2], v1[3]);
                  lo.x = cvt_pk_bf16(v0[0] - bflo(hi.x), v0[1] - bfhi(hi.x)); lo.y = cvt_pk_bf16(v0[2] - bflo(hi.y), v0[3] - bfhi(hi.y));
                  lo.z = cvt_pk_bf16(v1[0] - bflo(hi.z), v1[1] - bfhi(hi.z)); lo.w = cvt_pk_bf16(v1[2] - bflo(hi.w), v1[3] - bfhi(hi.w)); }
                const bf16x8 ahi = __builtin_bit_cast(bf16x8, hi), alo = __builtin_bit_cast(bf16x8, lo);
                const bf16x8 wh = bh[i % WD], wl_ = bl[i % WD];
                acc[cg] = __builtin_amdgcn_mfma_f32_16x16x32_bf16(ahi, wh, acc[cg], 0, 0, 0);
                acc[cg] = __builtin_amdgcn_mfma_f32_16x16x32_bf16(alo, wh, acc[cg], 0, 0, 0);
                acc[cg] = __builtin_amdgcn_mfma_f32_16x16x32_bf16(ahi, wl_, acc[cg], 0, 0, 0);
            }
#undef LN_WLOAD
#pragma unroll
            for (int cg = 0; cg < NCG; ++cg)
#pragma unroll
                for (int j = 0; j < 4; ++j) part[(w * 16 + 4 * q + j) * 48 + 16 * cg + r] = acc[cg][j];
        }
        asm volatile("" ::: "memory");
        if (gi + F.G < NTOK / 16) LN_ISSUE(gi + F.G);
        asm volatile("" ::: "memory");
        LDS_WAIT(); __syncthreads();
        if (!GRES) {
#pragma unroll
            for (int s = 0; s < 8; ++s)
#pragma unroll
                for (int hh = 0; hh < 2; ++hh) { const u32x4 t_ = *(const LAS u32x4*)(stash + 8192 + ((q * 8 + s) * 2 + hh) * 16); gq[s][hh][0] = t_.x; gq[s][hh][1] = t_.y; gq[s][hh][2] = t_.z; gq[s][hh][3] = t_.w; } }
        float mean, rstd;
        { float ts = 0.f, tq = 0.f;
#pragma unroll
          for (int ww = 0; ww < 8; ++ww) { ts += red[(ww * 16 + r) * 2]; tq += red[(ww * 16 + r) * 2 + 1]; }
          mean = ts * (1.0f / DM); const float var = tq * (1.0f / DM) - mean * mean; rstd = 1.0f / sqrtf(fmaxf(var, 0.f) + LN_EPS); }
        { float* op = a.hf + (size_t)row * DM + kb; bf16_t* ob = a.hb ? a.hb + (size_t)row * DM + kb : nullptr;
#pragma unroll
          for (int s = 0; s < 8; ++s) {
              f32x4 dg0, dg1, bb0, bb1; LN_UNPK(dg0, s, 0, 0); LN_UNPK(dg1, s, 1, 0); LN_UNPK(bb0, s, 0, 2); LN_UNPK(bb1, s, 1, 2);
              const f32x4 n0 = (z[s][0] - mean) * rstd, n1 = (z[s][1] - mean) * rstd; const f32x4 y0 = n0 + n0 * dg0 + bb0, y1 = n1 + n1 * dg1 + bb1;
              if (a.hf) { *(f32x4*)(op + 32 * s) = y0; *(f32x4*)(op + 32 * s + 4) = y1; }
              if (ob) { u32x4 o; o.x = cvt_pk_bf16(y0[0], y0[1]); o.y = cvt_pk_bf16(y0[2], y0[3]); o.z = cvt_pk_bf16(y1[0], y1[1]); o.w = cvt_pk_bf16(y1[2], y1[3]); *(u32x4*)(ob + 32 * s) = o; }
              if (a.h8) { u32x2 o8; o8.x = pk4_fp8(y0[0], y0[1], y0[2], y0[3]); o8.y = pk4_fp8(y1[0], y1[1], y1[2], y1[3]); *(u32x2*)(a.h8 + (size_t)row * DM + kb + 32 * s) = o8; } } }
        if (PROJ) {
#define LN_LOGIT(t_, s1_, s2_) do { const int t = (t_); if (t < 16 * 16 * NCG) { const int rr = t / (16 * NCG), cc = t % (16 * NCG); float ts = 0.f, tq = 0.f, ps = 0.f; \
                _Pragma("unroll") for (int ww = 0; ww < 8; ++ww) { ts += red[(ww * 16 + rr) * 2]; tq += red[(ww * 16 + rr) * 2 + 1]; ps += part[(ww * 16 + rr) * 48 + cc]; } \
                const float mr = ts * (1.0f / DM), vr = tq * (1.0f / DM) - mr * mr, rs = 1.0f / sqrtf(fmaxf(vr, 0.f) + LN_EPS); \
                lg[rr * 48 + cc] = rs * (ps - mr * (s1_)) + (s2_); } } while (0)
            LN_LOGIT(tid, s1a, s2a); if (16 * 16 * NCG > NWAVES * 64) LN_LOGIT(tid + NWAVES * 64, s1b, s2b);
#undef LN_LOGIT
            LDS_WAIT(); __syncthreads();
            if (tid < 16) {
                const int tok = gi * 16 + tid; const LAS float* L = lg + tid * 48;
                if (MODE != 1) {
                    const int bb = tok / SEQ, ss = tok % SEQ;
#pragma unroll
                    for (int hh = 0; hh < 8; ++hh) { const float xv = L[hh] + tb[hh]; const float lsg = fminf(xv, 0.f) - log1pf(expf(-fabsf(xv))); a.logf[((size_t)bb * 8 + hh) * SEQ + ss] = lsg; }
                } else {
                    float gl[4]; float gmax = -3.0e38f; int gi_ = 0;
#pragma unroll
                    for (int j = 0; j < 4; ++j) { gl[j] = L[j] + tb[16 + j]; if (gl[j] > gmax) { gmax = gl[j]; gi_ = j; } }
                    float den = 0.f;
#pragma unroll
                    for (int j = 0; j < 4; ++j) den += expf(gl[j] - gmax);
                    const float grp_w = 1.0f / den;
                    float e1 = -3.0e38f, e2 = -3.0e38f; int i1 = 0, i2 = 0;
#pragma unroll
                    for (int j = 0; j < 8; ++j) { const float v = L[4 + 8 * gi_ + j] + tb[32 + 8 * gi_ + j];
                        if (v > e1) { e2 = e1; i2 = i1; e1 = v; i1 = j; } else if (v > e2) { e2 = v; i2 = j; } }
                    const float t2 = expf(e2 - e1), w1 = grp_w / (1.0f + t2), w2 = grp_w * t2 / (1.0f + t2);
                    const int x1 = 8 * gi_ + i1, x2 = 8 * gi_ + i2;
                    const int r1 = __hip_atomic_fetch_add(lcnt + x1, 1, __ATOMIC_RELAXED, __HIP_MEMORY_SCOPE_WORKGROUP), r2 = __hip_atomic_fetch_add(lcnt + x2, 1, __ATOMIC_RELAXED, __HIP_MEMORY_SCOPE_WORKGROUP);
                    LAS int* rc = rrec + (nrec + tid) * 8; rc[0] = tok; rc[1] = x1; rc[2] = r1; rc[3] = __float_as_int(w1); rc[4] = x2; rc[5] = r2; rc[6] = __float_as_int(w2);
                }
            }
        }
        __syncthreads();
        if (MODE == 1) {
            nrec += 16;
            if (nrec == 64 || gi + F.G >= NTOK / 16) {
                const int tf = opaque_tid();
                if (tf < 32) { const int cn = lcnt[tf]; lcnt[32 + tf] = cn ? (int)__hip_atomic_fetch_add(a.cnt + 64 * tf, (unsigned)cn, RLX_AGENT) : 0; lcnt[tf] = 0; }
                LDS_WAIT(); __syncthreads();
                if (tf < nrec) { const LAS int* rc = rrec + tf * 8; const int tok = rc[0], x1 = rc[1], x2 = rc[4]; const int p1 = lcnt[32 + x1] + rc[2], p2 = lcnt[32 + x2] + rc[5];
                    a.list[x1 * 16384 + p1] = tok; a.wlist[x1 * 16384 + p1] = __int_as_float(rc[3]); a.list[x2 * 16384 + p2] = tok; a.wlist[x2 * 16384 + p2] = __int_as_float(rc[6]);
                    *(int4*)(a.route_out + tok * 4) = make_int4(x1, p1, x2, p2); }
                nrec = 0;
                LDS_WAIT(); __syncthreads();
            }
        }
    }
#undef LN_ISSUE
#undef LN_UNPK
#undef LN_GLOAD
}
namespace fox {
constexpr int D = 128, NW = 8, QBLK = 32, KVBLK = 64, QB = NW * QBLK;
constexpr int SHM_V = KVBLK * D * 2, SHM_K = KVBLK * D * 2;
constexpr int OFF_WS = 2 * SHM_V + 2 * SHM_K, OFF_BIAS = OFF_WS + NW * 64 * 4, LDS_BYTES = OFF_BIAS + SEQ * 4;
constexpr float THR = 8.f, LN2 = 0.6931471805599453f;
#define KSWZ(row, colB) ((row) * 256 + ((colB) ^ (((row) & 7) << 4)))
__device__ __forceinline__ int v_st(int k, int c) { const int kk = (k & ~0xC) | ((k & 4) << 1) | ((k & 8) >> 1); return ((kk >> 3) * 4 + (c >> 5)) * 512 + ((kk & 7) * 32 + (c & 31)) * 2; }
__device__ __forceinline__ int v_rd_base(int lane) { return ((lane & 3) << 3) | (((lane >> 2) & 3) << 6) | (((lane >> 4) & 1) << 5) | (((lane >> 5) & 1) << 8); }
constexpr int v_rd_off(int d0, int ks, int half) { return d0 * 512 + ks * 4096 + half * 2048; }
__device__ __forceinline__ int crow(int r, int hi) { return (r & 3) + 8 * (r >> 2) + 4 * hi; }
__device__ __forceinline__ void mask_tile(f32x16& p0, f32x16& p1, int dq) {
    const float NEG = -__builtin_inff();
#pragma unroll
    for (int r = 0; r < 16; ++r) { const int c = (r & 3) + 8 * (r >> 2); if (dq - c < 0) p0[r] = NEG; if (dq - c - 32 < 0) p1[r] = NEG; }
}
__device__ __forceinline__ void partialSM(f32x16& p0, f32x16& p1, float& m_reg, float& mn, float& alpha) {
    float pmax = p0[0];
#pragma unroll
    for (int r = 1; r < 16; ++r) pmax = fmaxf(pmax, p0[r]);
#pragma unroll
    for (int r = 0; r < 16; ++r) pmax = fmaxf(pmax, p1[r]);
    { auto rr = __builtin_amdgcn_permlane32_swap(__float_as_uint(pmax), __float_as_uint(pmax), false, false); pmax = fmaxf(__uint_as_float(rr[0]), __uint_as_float(rr[1])); }
    if (__builtin_expect(__all((pmax - m_reg) * LN2 <= THR), 1)) { mn = m_reg; alpha = 1.f; }
    else { mn = fmaxf(m_reg, pmax); alpha = __builtin_amdgcn_exp2f(m_reg - mn); m_reg = mn; }
#pragma unroll
    for (int r = 0; r < 16; ++r) p0[r] = p0[r] - mn;
#pragma unroll
    for (int r = 0; r < 16; ++r) p1[r] = p1[r] - mn;
#pragma unroll
    for (int r = 0; r < 16; ++r) p0[r] = __builtin_amdgcn_exp2f(p0[r]);
}
__device__ __forceinline__ void finishSM(f32x16& p0, f32x16& p1, float alpha, float& l_reg, bf16x8& pa0, bf16x8& pa1, bf16x8& pa2, bf16x8& pa3) {
#pragma unroll
    for (int r = 0; r < 16; ++r) p1[r] = __builtin_amdgcn_exp2f(p1[r]);
    float ps = 0;
#pragma unroll
    for (int r = 0; r < 16; ++r) ps += p0[r];
#pragma unroll
    for (int r = 0; r < 16; ++r) ps += p1[r];
    { auto rr = __builtin_amdgcn_permlane32_swap(__float_as_uint(ps), __float_as_uint(ps), false, false); ps = __uint_as_float(rr[0]) + __uint_as_float(rr[1]); }
    l_reg = l_reg * alpha + ps;
#define PK4(P, B_, OUT) do { unsigned a0 = cvt_pk_bf16(P[B_+0], P[B_+1]), a1 = cvt_pk_bf16(P[B_+2], P[B_+3]);                          \
        unsigned b0 = cvt_pk_bf16(P[B_+4], P[B_+5]), b1 = cvt_pk_bf16(P[B_+6], P[B_+7]);                                             \
        auto r0 = __builtin_amdgcn_permlane32_swap(a0, b0, false, false); auto r1 = __builtin_amdgcn_permlane32_swap(a1, b1, false, false); \
        u32x4 w = {r0[0], r1[0], r0[1], r1[1]}; OUT = __builtin_bit_cast(bf16x8, w); } while (0)
    PK4(p0, 0, pa0); PK4(p0, 8, pa1); PK4(p1, 0, pa2); PK4(p1, 8, pa3);
#undef PK4
}
template <int KB>
__device__ __forceinline__ void qkt(f32x16& p0, f32x16& p1, const LAS char* K_lds, int r32, int hi, const bf16x8* qr, const LAS float* bl) {
#pragma unroll
    for (int g = 0; g < 4; ++g) { const f32x4 b0 = *(const LAS f32x4*)(bl + 8 * g), b1 = *(const LAS f32x4*)(bl + 32 + 8 * g);
        p0[4 * g] = b0[0]; p0[4 * g + 1] = b0[1]; p0[4 * g + 2] = b0[2]; p0[4 * g + 3] = b0[3]; p1[4 * g] = b1[0]; p1[4 * g + 1] = b1[1]; p1[4 * g + 2] = b1[2]; p1[4 * g + 3] = b1[3]; }
    const LAS char* kb[4];
#pragma unroll
    for (int dd = 0; dd < 4; ++dd) kb[dd] = K_lds + KB * SHM_K + KSWZ(r32, (dd * 16 + hi * 8) * 2);
#pragma unroll
    for (int d0 = 0; d0 < 8; ++d0) { const LAS char* a = kb[d0 & 3] + (d0 >> 2) * 128;
        bf16x8 b0 = *(const LAS bf16x8*)(a);
        bf16x8 b1 = *(const LAS bf16x8*)(a + 32 * 256);
        p0 = __builtin_amdgcn_mfma_f32_32x32x16_bf16(b0, qr[d0], p0, 0, 0, 0);
        p1 = __builtin_amdgcn_mfma_f32_32x32x16_bf16(b1, qr[d0], p1, 0, 0, 0); }
}
template <int VB>
__device__ __forceinline__ void pv_tile(f32x16* o, int vb0, bf16x8 pa0, bf16x8 pa1, bf16x8 pa2, bf16x8 pa3) {
#define TRRD(dst, off) asm volatile("ds_read_b64_tr_b16 %0, %1 offset:%2" : "=&v"(dst) : "v"(vb0), "i"(off) : "memory")
#define PV_D0(d0) do { s16x4 l0, l1, l2, l3, h0, h1, h2, h3; constexpr int b_ = VB * SHM_V + v_rd_off(d0, 0, 0); \
        TRRD(l0, b_); TRRD(h0, b_ + 2048); TRRD(l1, b_ + 4096); TRRD(h1, b_ + 6144); TRRD(l2, b_ + 8192); TRRD(h2, b_ + 10240); TRRD(l3, b_ + 12288); TRRD(h3, b_ + 14336); \
        asm volatile("s_waitcnt lgkmcnt(0)" ::: "memory"); SBAR();   \
        o[d0] = __builtin_amdgcn_mfma_f32_32x32x16_bf16(pa0, (bf16x8){l0[0], l0[1], l0[2], l0[3], h0[0], h0[1], h0[2], h0[3]}, o[d0], 0, 0, 0);   \
        o[d0] = __builtin_amdgcn_mfma_f32_32x32x16_bf16(pa1, (bf16x8){l1[0], l1[1], l1[2], l1[3], h1[0], h1[1], h1[2], h1[3]}, o[d0], 0, 0, 0);   \
        o[d0] = __builtin_amdgcn_mfma_f32_32x32x16_bf16(pa2, (bf16x8){l2[0], l2[1], l2[2], l2[3], h2[0], h2[1], h2[2], h2[3]}, o[d0], 0, 0, 0);   \
        o[d0] = __builtin_amdgcn_mfma_f32_32x32x16_bf16(pa3, (bf16x8){l3[0], l3[1], l3[2], l3[3], h3[0], h3[1], h3[2], h3[3]}, o[d0], 0, 0, 0); } while (0)
    PV_D0(0); PV_D0(1); PV_D0(2); PV_D0(3);
#undef PV_D0
#undef TRRD
}
struct BlockRef { const bf16_t* Q; const bf16_t* K; const bf16_t* V; bf16_t* O; int P0; };
struct Seam { bf16x8 qr[8]; bf16x8 st_v0, st_v1, st_k0, st_k1; };
#define VMW() asm volatile("s_waitcnt vmcnt(0)" ::: "memory")
#define VMWN(n) asm volatile("s_waitcnt vmcnt(%0)" :: "i"(n) : "memory")
#define SLOAD_H(Kp, Vp, k0) do { const char* vb_ = (const char*)(Vp) + (size_t)(k0) * (ld * 2); const char* kb_ = (const char*)(Kp) + (size_t)(k0) * (ld * 2); \
        S.st_v0 = *(const bf16x8*)(vb_ + soff); S.st_v1 = *(const bf16x8*)(vb_ + 32 * ld * 2 + soff); S.st_k0 = *(const bf16x8*)(kb_ + soff); S.st_k1 = *(const bf16x8*)(kb_ + 32 * ld * 2 + soff); } while (0)
#define SWRITE_HK(bf) do { *(LAS bf16x8*)(K_lds + (bf) * SHM_K + kws) = S.st_k0; *(LAS bf16x8*)(K_lds + (bf) * SHM_K + kws + 32 * 256) = S.st_k1; } while (0)
#define SWRITE_HV(bf) do { *(LAS bf16x8*)(V_lds + (bf) * SHM_V + vst0) = S.st_v0; *(LAS bf16x8*)(V_lds + (bf) * SHM_V + vst1) = S.st_v1; } while (0)
#define SWRITE_H(bf) do { SWRITE_HV(bf); SWRITE_HK(bf); } while (0)
template <int ld> __device__ __forceinline__ void prime(const BlockRef& cur, LAS char* lds, Seam& S) {
    const int tid = opaque_tid(), wid = __builtin_amdgcn_readfirstlane(tid >> 6), lane = tid & 63, r32 = lane & 31, hi = lane >> 5;
    const int sr = tid >> 4, sc = (tid & 15) * 8, kws = KSWZ(sr, sc * 2); LAS char* K_lds = lds + 2 * SHM_V;
    const unsigned soff = (unsigned)(sr * ld + sc) * 2u, qoff = (unsigned)((wid * QBLK + r32) * ld + hi * 8) * 2u;
#pragma unroll
    for (int d0 = 0; d0 < 8; ++d0) S.qr[d0] = *(const bf16x8*)((const char*)cur.Q + qoff + d0 * 32);
    SLOAD_H(cur.K, cur.V, 0); VMW(); SWRITE_HK(0);
    __syncthreads();
}
template <int ld, int ldo> __device__ __forceinline__ void block(const BlockRef& cur, const BlockRef& nxt, LAS char* lds, Seam& S) {
    const int tid = opaque_tid(), wid = __builtin_amdgcn_readfirstlane(tid >> 6), lane = tid & 63, r32 = lane & 31, hi = lane >> 5;
    const int NT = (cur.P0 + QB - 1) / KVBLK + 1;
    const int qlo = cur.P0 + wid * QBLK, qm = qlo + r32 - 4 * hi;
    LAS char* V_lds = lds; LAS char* K_lds = lds + 2 * SHM_V;
    LAS float* ws = (LAS float*)(lds + OFF_WS) + wid * 64; LAS float* li_l = ws; LAS float* al_l = ws + 32;
    const LAS float* bias = (const LAS float*)(lds + OFF_BIAS) + 4 * hi;
    float m_reg = -1e30f, l_reg = 0; f32x16 o[4] = {};
    const int sr = tid >> 4, sc = (tid & 15) * 8, vst0 = v_st(sr, sc), vst1 = v_st(32 + sr, sc), kws = KSWZ(sr, sc * 2);
    const unsigned soff = (unsigned)(sr * ld + sc) * 2u;
    const int vb0 = (int)(uintptr_t)V_lds + v_rd_base(lane);
    const bf16_t* Kh = cur.K; const bf16_t* Vh = cur.V;
#define RESC(a) do { if (__any((a) < 1.f)) { if (hi == 0) al_l[r32] = (a); asm volatile("s_waitcnt lgkmcnt(0)" ::: "memory");              \
                     for (int d_ = 0; d_ < 4; ++d_) for (int r = 0; r < 16; ++r) o[d_][r] *= al_l[crow(r, hi)]; } } while (0)
#define KBASE(t) ((t) * KVBLK)
#define MASKT(P0_, P1_, t) do { const int kb_ = KBASE(t); if (kb_ + KVBLK - 1 > qlo) mask_tile(P0_, P1_, qm - kb_); } while (0)
    constexpr int NQL = 8;
#define SEAM_K0() do { VMWN(NQL); SWRITE_HK(0); SBAR(); } while (0)
    f32x16 pA0, pA1, pB0, pB1; float mnA, mnB, alA, alB; bf16x8 pa0, pa1, pa2, pa3;
    SWRITE_HV(0); SBAR();
    if (NT > 1) { SLOAD_H(Kh, Vh, KBASE(1)); }
    SBAR(); qkt<0>(pA0, pA1, K_lds, r32, hi, S.qr, bias + KBASE(0));
    MASKT(pA0, pA1, 0); partialSM(pA0, pA1, m_reg, mnA, alA);
    if (NT > 1) { VMW(); SWRITE_H(1); }
    __syncthreads();
#define HALF_STEP(PX0, PX1, mnX, alX, PY0, PY1, alY, t, KB, VB, SB) do {                                                      \
        SBAR(); qkt<KB>(PX0, PX1, K_lds, r32, hi, S.qr, bias + KBASE(t));                                             \
        finishSM(PY0, PY1, alY, l_reg, pa0, pa1, pa2, pa3); SBAR();                                                           \
        if ((t) + 1 < NT) { SLOAD_H(Kh, Vh, KBASE((t) + 1)); SBAR(); }                                               \
        pv_tile<VB>(o, vb0, pa0, pa1, pa2, pa3); MASKT(PX0, PX1, (t)); partialSM(PX0, PX1, m_reg, mnX, alX);                                        \
        __syncthreads();                                                                                                      \
        if ((t) + 1 < NT) { VMW(); SWRITE_H(SB); }                                                                          \
        RESC(alX); __syncthreads(); } while (0)
    for (int t = 1; t + 1 < NT; t += 2) {
        HALF_STEP(pB0, pB1, mnB, alB, pA0, pA1, alA, t, 1, 0, 0);
        HALF_STEP(pA0, pA1, mnA, alA, pB0, pB1, alB, t + 1, 0, 1, 1);
    }
    const bool even = (NT & 1) == 0;
    if (even) { SBAR(); qkt<1>(pB0, pB1, K_lds, r32, hi, S.qr, bias + KBASE(NT - 1)); SBAR(); }
    int tid2 = tid; asm volatile("" : "+v"(tid2));
    const int r32b = tid2 & 31, hib = (tid2 >> 5) & 1;
    SBAR();
    finishSM(pA0, pA1, alA, l_reg, pa0, pa1, pa2, pa3); SBAR();
    pv_tile<0>(o, vb0, pa0, pa1, pa2, pa3);
    if (even) { MASKT(pB0, pB1, NT - 1); partialSM(pB0, pB1, m_reg, mnB, alB); __syncthreads(); RESC(alB);
        finishSM(pB0, pB1, alB, l_reg, pa0, pa1, pa2, pa3); SBAR(); pv_tile<1>(o, vb0, pa0, pa1, pa2, pa3); }
    SBAR();
    if (hi == 0) li_l[r32] = l_reg; asm volatile("s_waitcnt lgkmcnt(0)" ::: "memory");
    float rli[16];
#pragma unroll
    for (int r = 0; r < 16; ++r) rli[r] = __builtin_amdgcn_rcpf(li_l[crow(r, hi)]);
    char* Ow = (char*)cur.O + (size_t)(wid * QBLK) * ldo; const unsigned ooff = (unsigned)(4 * hib * ldo + r32b);
#pragma unroll
    for (int r = 0; r < 16; ++r) { const int orow0 = (r & 3) + 8 * (r >> 2);
#pragma unroll
        for (int d0 = 0; d0 < 4; ++d0) { const float v = o[d0][r] * rli[r] * Y8_SCALE; const float vn = __shfl_xor(v, 1);
            const unsigned pk = (unsigned)__builtin_amdgcn_cvt_pk_fp8_f32(v, vn, 0, false) & 0xffffu; const unsigned pn = (unsigned)__shfl_xor((int)pk, 2);
            if ((r32b & 3) == 0) *(unsigned*)(Ow + (size_t)(orow0 * ldo + d0 * 32) + ooff) = pk | (pn << 16); } }
    __syncthreads();
#undef RESC
#undef KBASE
#undef MASKT
#undef SEAM_K0
#undef HALF_STEP
}
#undef ROW
#undef VMW
#undef VMWN
#undef SLOAD_H
#undef SWRITE_HK
#undef SWRITE_HV
#undef SWRITE_H
#undef KSWZ
}
namespace ret {
constexpr int QS = 288, VS = 544, SS = 144;
constexpr int OFF_Q = 0, OFF_K = 64 * QS, OFF_V = 2 * 64 * QS, OFF_S = OFF_V + 64 * VS, OFF_QD = OFF_S + 64 * SS, OFF_RP = OFF_QD + 256, LDS_BYTES = OFF_RP + 8 * 64 * 4;
#define TRRD(dst, base, off) asm volatile("ds_read_b64_tr_b16 %0, %1 offset:%2" : "=&v"(dst) : "v"(base), "i"(off) : "memory")
__device__ __forceinline__ bf16x8 cat8(s16x4 a, s16x4 b) { return (bf16x8){a[0], a[1], a[2], a[3], b[0], b[1], b[2], b[3]}; }
__device__ __forceinline__ u32x4 scale8(u32x4 v, float s) {
    u32x4 o; o.x = cvt_pk_bf16(bflo(v.x) * s, bfhi(v.x) * s); o.y = cvt_pk_bf16(bflo(v.y) * s, bfhi(v.y) * s); o.z = cvt_pk_bf16(bflo(v.z) * s, bfhi(v.z) * s); o.w = cvt_pk_bf16(bflo(v.w) * s, bfhi(v.w) * s); return o;
}
__device__ __forceinline__ void item(const bf16_t* proj, bf16_t* yret, int b, int h, int seg, const float* Lbh, gu32* fbh, LAS unsigned char* lds) {
    const int tid = opaque_tid(), w = __builtin_amdgcn_readfirstlane(tid >> 6), lane = tid & 63, c = lane & 15, q = lane >> 4, qq = c >> 2, p = c & 3;
    const float gam = 1.0f - __builtin_amdgcn_exp2f(-5.0f - (float)h);
    const float lg = log2f(gam);
    const float cd = __builtin_amdgcn_exp2f(lg * 64.0f);
    const int srow = tid >> 3, sseg = tid & 7;
    const float kd = __builtin_amdgcn_exp2f(lg * (float)(63 - srow));
    if (tid < 64) ((LAS float*)(lds + OFF_QD))[tid] = __builtin_amdgcn_exp2f(lg * (float)(tid + 1));
    const size_t tok0 = (size_t)b * SEQ;
    const size_t hrow = (size_t)(b * 8 + h) * SEQ + srow;
    const bf16_t* gq = proj + PJ_RQ + hrow * 128 + 16 * sseg;
    const bf16_t* gk = proj + PJ_RK + hrow * 128 + 16 * sseg;
    const bf16_t* gv = proj + PJ_RV + hrow * 256 + 32 * sseg;
    LAS unsigned char* wq = lds + OFF_Q + srow * QS + sseg * 32; LAS unsigned char* wk = lds + OFF_K + srow * QS + sseg * 32; LAS unsigned char* wv = lds + OFF_V + srow * VS + sseg * 64;
    u32x4 pq0, pq1, pk0, pk1, pv0, pv1, pv2, pv3;
#define RET_LOAD(ch) do { const size_t o_ = (size_t)(ch) * 64 * 128, ov_ = (size_t)(ch) * 64 * 256; pq0 = *(const u32x4*)(gq + o_); pq1 = *(const u32x4*)(gq + o_ + 8); pk0 = *(const u32x4*)(gk + o_); pk1 = *(const u32x4*)(gk + o_ + 8); \
        pv0 = *(const u32x4*)(gv + ov_); pv1 = *(const u32x4*)(gv + ov_ + 8); pv2 = *(const u32x4*)(gv + ov_ + 16); pv3 = *(const u32x4*)(gv + ov_ + 24); } while (0)
#define RET_WRITE() do { *(LAS u32x4*)(wq) = pq0; *(LAS u32x4*)(wq + 16) = pq1; *(LAS u32x4*)(wk) = scale8(pk0, kd); *(LAS u32x4*)(wk + 16) = scale8(pk1, kd); \
        *(LAS u32x4*)(wv) = pv0; *(LAS u32x4*)(wv + 16) = pv1; *(LAS u32x4*)(wv + 32) = pv2; *(LAS u32x4*)(wv + 48) = pv3; } while (0)
    f32x4 st[8][2];
#pragma unroll
    for (int dt = 0; dt < 8; ++dt) { st[dt][0] = (f32x4){0.f, 0.f, 0.f, 0.f}; st[dt][1] = (f32x4){0.f, 0.f, 0.f, 0.f}; }
    const int c0 = seg * RCPS;
    RET_LOAD(c0);
    if (seg > 0) {
        if (tid == 0) { for (int i = 0; i < seg; ++i) { unsigned sp = 0; while (__hip_atomic_load(fbh + i * 16, RLX_AGENT) == 0u && ++sp < (1u << 22)) __builtin_amdgcn_s_sleep(2); } }
        __builtin_amdgcn_fence(__ATOMIC_ACQUIRE, "agent"); asm volatile("s_waitcnt vmcnt(0)" ::: "memory");
        __syncthreads();
        for (int i = 0; i < seg; ++i) { const float wgt = __builtin_amdgcn_exp2f(lg * (float)(64 * RCPS * (seg - 1 - i))); const float* Lp = Lbh + (size_t)i * 32768 + (size_t)(w * 16) * 256 + lane * 4;
#pragma unroll
            for (int dt = 0; dt < 8; ++dt)
#pragma unroll
                for (int ct = 0; ct < 2; ++ct) st[dt][ct] = st[dt][ct] + *(const f32x4*)(Lp + (dt * 2 + ct) * 256) * wgt; }
    }
    RET_WRITE();
    LDS_WAIT(); __syncthreads();
    const int mt = w & 3, nt0 = 2 * (w >> 2);
    const unsigned vbase = (unsigned)(uintptr_t)(lds + OFF_V) + (unsigned)((4 * q + qq) * VS + (32 * w + 4 * p) * 2);
    const unsigned kbase = (unsigned)(uintptr_t)(lds + OFF_K) + (unsigned)((4 * q + qq) * QS + (4 * p) * 2);
    const LAS unsigned char* qperm = lds + OFF_Q + c * QS + (4 * q) * 2;
    const LAS unsigned char* sperm = lds + OFF_S + c * SS + (4 * q) * 2;
    const LAS float* qd = (const LAS float*)(lds + OFF_QD); LAS float* rp = (LAS float*)(lds + OFF_RP);
    for (int ch = c0; ch < c0 + RCPS; ++ch) {
        if (ch + 1 < c0 + RCPS) RET_LOAD(ch + 1);
        {
            f32x4 s0 = (f32x4){0.f, 0.f, 0.f, 0.f}, s1 = (f32x4){0.f, 0.f, 0.f, 0.f};
#pragma unroll
            for (int ks = 0; ks < 4; ++ks) { const bf16x8 ak = *(const LAS bf16x8*)(lds + OFF_K + (16 * mt + c) * QS + (32 * ks + 8 * q) * 2);
                const bf16x8 b0 = *(const LAS bf16x8*)(lds + OFF_Q + (16 * nt0 + c) * QS + (32 * ks + 8 * q) * 2), b1 = *(const LAS bf16x8*)(lds + OFF_Q + (16 * nt0 + 16 + c) * QS + (32 * ks + 8 * q) * 2);
                s0 = __builtin_amdgcn_mfma_f32_16x16x32_bf16(ak, b0, s0, 0, 0, 0); s1 = __builtin_amdgcn_mfma_f32_16x16x32_bf16(ak, b1, s1, 0, 0, 0); }
#pragma unroll
            for (int t = 0; t < 2; ++t) { const int n = 16 * (nt0 + t) + c; f32x4 sv = t ? s1 : s0;
#pragma unroll
                for (int j = 0; j < 4; ++j) { const int m = 16 * mt + 4 * q + j; const int d = n > m ? n - m : m - n; sv[j] *= __builtin_amdgcn_exp2f(lg * (float)(d + m - 63)); }
                u32x2 o; o.x = cvt_pk_bf16(sv[0], sv[1]); o.y = cvt_pk_bf16(sv[2], sv[3]); *(LAS u32x2*)(lds + OFF_S + n * SS + (16 * mt + 4 * q) * 2) = o; }
        }
        LDS_WAIT(); __syncthreads();
        f32x4 acc[2][4];
#pragma unroll
        for (int ct = 0; ct < 2; ++ct)
#pragma unroll
            for (int nt = 0; nt < 4; ++nt) acc[ct][nt] = (f32x4){0.f, 0.f, 0.f, 0.f};
#pragma unroll
        for (int ks = 0; ks < 4; ++ks) {
            bf16x8 as[2];
#pragma unroll
            for (int ct = 0; ct < 2; ++ct) { const f32x4 x0 = st[2 * ks][ct], x1 = st[2 * ks + 1][ct]; u32x4 u; u.x = cvt_pk_bf16(x0[0], x0[1]); u.y = cvt_pk_bf16(x0[2], x0[3]); u.z = cvt_pk_bf16(x1[0], x1[1]); u.w = cvt_pk_bf16(x1[2], x1[3]); as[ct] = __builtin_bit_cast(bf16x8, u); }
#pragma unroll
            for (int nt = 0; nt < 4; ++nt) { const u32x2 lo = *(const LAS u32x2*)(qperm + nt * 16 * QS + ks * 64), hi = *(const LAS u32x2*)(qperm + nt * 16 * QS + ks * 64 + 32);
                const u32x4 bu = {lo.x, lo.y, hi.x, hi.y}; const bf16x8 bq = __builtin_bit_cast(bf16x8, bu);
                acc[0][nt] = __builtin_amdgcn_mfma_f32_16x16x32_bf16(as[0], bq, acc[0][nt], 0, 0, 0); acc[1][nt] = __builtin_amdgcn_mfma_f32_16x16x32_bf16(as[1], bq, acc[1][nt], 0, 0, 0); }
        }
#pragma unroll
        for (int nt = 0; nt < 4; ++nt) { const float f = qd[16 * nt + c]; acc[0][nt] = acc[0][nt] * f; acc[1][nt] = acc[1][nt] * f; }
        bf16x8 vt[2][2];
        { s16x4 a0, a1, a2, a3, a4, a5, a6, a7;
          TRRD(a0, vbase, 0); TRRD(a1, vbase, 16 * VS); TRRD(a2, vbase, 32); TRRD(a3, vbase, 16 * VS + 32);
          TRRD(a4, vbase, 32 * VS); TRRD(a5, vbase, 48 * VS); TRRD(a6, vbase, 32 * VS + 32); TRRD(a7, vbase, 48 * VS + 32);
          asm volatile("s_waitcnt lgkmcnt(0)" ::: "memory"); SBAR();
          vt[0][0] = cat8(a0, a1); vt[0][1] = cat8(a2, a3); vt[1][0] = cat8(a4, a5); vt[1][1] = cat8(a6, a7); }
#pragma unroll
        for (int ks2 = 0; ks2 < 2; ++ks2)
#pragma unroll
            for (int nt = 0; nt < 4; ++nt) { const u32x2 lo = *(const LAS u32x2*)(sperm + nt * 16 * SS + ks2 * 64), hi = *(const LAS u32x2*)(sperm + nt * 16 * SS + ks2 * 64 + 32);
                const u32x4 bu = {lo.x, lo.y, hi.x, hi.y}; const bf16x8 bs = __builtin_bit_cast(bf16x8, bu);
                acc[0][nt] = __builtin_amdgcn_mfma_f32_16x16x32_bf16(vt[ks2][0], bs, acc[0][nt], 0, 0, 0); acc[1][nt] = __builtin_amdgcn_mfma_f32_16x16x32_bf16(vt[ks2][1], bs, acc[1][nt], 0, 0, 0); }
#pragma unroll
        for (int dt = 0; dt < 8; ++dt) { s16x4 k0, k1, k2, k3;
            TRRD(k0, kbase, dt * 32); TRRD(k1, kbase, 16 * QS + dt * 32); TRRD(k2, kbase, 32 * QS + dt * 32); TRRD(k3, kbase, 48 * QS + dt * 32);
            asm volatile("s_waitcnt lgkmcnt(0)" ::: "memory"); SBAR();
            const bf16x8 ka = cat8(k0, k1), kb = cat8(k2, k3);
#pragma unroll
            for (int ct = 0; ct < 2; ++ct) { f32x4 s = st[dt][ct] * cd; s = __builtin_amdgcn_mfma_f32_16x16x32_bf16(ka, vt[0][ct], s, 0, 0, 0); s = __builtin_amdgcn_mfma_f32_16x16x32_bf16(kb, vt[1][ct], s, 0, 0, 0); st[dt][ct] = s; } }
#pragma unroll
        for (int nt = 0; nt < 4; ++nt) { float ss = 0.f;
#pragma unroll
            for (int ct = 0; ct < 2; ++ct)
#pragma unroll
                for (int j = 0; j < 4; ++j) ss += acc[ct][nt][j] * acc[ct][nt][j];
            ss += __shfl_xor(ss, 16); ss += __shfl_xor(ss, 32);
            if (q == 0) rp[w * 64 + 16 * nt + c] = ss; }
        LDS_WAIT(); __syncthreads();
        const size_t trow = tok0 + (size_t)ch * 64;
#pragma unroll
        for (int nt = 0; nt < 4; ++nt) { float tot = 0.f;
#pragma unroll
            for (int ww = 0; ww < 8; ++ww) tot += rp[ww * 64 + 16 * nt + c];
            const float rstd = 1.0f / sqrtf(tot * (1.0f / 256.0f) + RMS_EPS); const size_t tk = trow + 16 * nt + c;
#pragma unroll
            for (int ct = 0; ct < 2; ++ct) { const int col = h * 256 + 32 * w + 16 * ct + 4 * q;
                const u32x2 g = *(const u32x2*)(proj + PJ_RG + tk * 2048 + col); const f32x4 a = acc[ct][nt] * rstd;
                u32x2 o; o.x = cvt_pk_bf16(a[0] * bflo(g.x), a[1] * bfhi(g.x)); o.y = cvt_pk_bf16(a[2] * bflo(g.y), a[3] * bfhi(g.y));
                *(u32x2*)(yret + tk * DM + col) = o; } }
        if (ch + 1 < c0 + RCPS) { RET_WRITE(); }
        LDS_WAIT(); __syncthreads();
    }
#undef RET_LOAD
#undef RET_WRITE
}

__device__ __forceinline__ void pass1(const bf16_t* proj, float* Lout, gu32* flag, int b, int h, int seg, LAS unsigned char* lds) {
    const int tid = opaque_tid(), w = __builtin_amdgcn_readfirstlane(tid >> 6), lane = tid & 63, c = lane & 15, q = lane >> 4, qq = c >> 2, p = c & 3;
    const float gam = 1.0f - __builtin_amdgcn_exp2f(-5.0f - (float)h);
    const float lg = log2f(gam);
    const float cd = __builtin_amdgcn_exp2f(lg * 64.0f);
    const int srow = tid >> 3, sseg = tid & 7;
    const float kd = __builtin_amdgcn_exp2f(lg * (float)(63 - srow));
    const size_t hrow = (size_t)(b * 8 + h) * SEQ + srow;
    const bf16_t* gk = proj + PJ_RK + hrow * 128 + 16 * sseg;
    const bf16_t* gv = proj + PJ_RV + hrow * 256 + 32 * sseg;
    LAS unsigned char* wk = lds + OFF_K + srow * QS + sseg * 32; LAS unsigned char* wv = lds + OFF_V + srow * VS + sseg * 64;
    u32x4 pk0, pk1, pv0, pv1, pv2, pv3;
#define P1_LOAD(ch) do { const size_t o_ = (size_t)(ch) * 64 * 128, ov_ = (size_t)(ch) * 64 * 256; pk0 = *(const u32x4*)(gk + o_); pk1 = *(const u32x4*)(gk + o_ + 8); \
        pv0 = *(const u32x4*)(gv + ov_); pv1 = *(const u32x4*)(gv + ov_ + 8); pv2 = *(const u32x4*)(gv + ov_ + 16); pv3 = *(const u32x4*)(gv + ov_ + 24); } while (0)
#define P1_WRITE() do { *(LAS u32x4*)(wk) = scale8(pk0, kd); *(LAS u32x4*)(wk + 16) = scale8(pk1, kd); \
        *(LAS u32x4*)(wv) = pv0; *(LAS u32x4*)(wv + 16) = pv1; *(LAS u32x4*)(wv + 32) = pv2; *(LAS u32x4*)(wv + 48) = pv3; } while (0)
    f32x4 st[8][2];
#pragma unroll
    for (int dt = 0; dt < 8; ++dt) { st[dt][0] = (f32x4){0.f, 0.f, 0.f, 0.f}; st[dt][1] = (f32x4){0.f, 0.f, 0.f, 0.f}; }
    const int c0 = seg * RCPS;
    P1_LOAD(c0); P1_WRITE();
    LDS_WAIT(); __syncthreads();
    const unsigned vbase = (unsigned)(uintptr_t)(lds + OFF_V) + (unsigned)((4 * q + qq) * VS + (32 * w + 4 * p) * 2);
    const unsigned kbase = (unsigned)(uintptr_t)(lds + OFF_K) + (unsigned)((4 * q + qq) * QS + (4 * p) * 2);
    for (int ch = c0; ch < c0 + RCPS; ++ch) {
        if (ch + 1 < c0 + RCPS) P1_LOAD(ch + 1);
        bf16x8 vt[2][2];
        { s16x4 a0, a1, a2, a3, a4, a5, a6, a7;
          TRRD(a0, vbase, 0); TRRD(a1, vbase, 16 * VS); TRRD(a2, vbase, 32); TRRD(a3, vbase, 16 * VS + 32);
          TRRD(a4, vbase, 32 * VS); TRRD(a5, vbase, 48 * VS); TRRD(a6, vbase, 32 * VS + 32); TRRD(a7, vbase, 48 * VS + 32);
          asm volatile("s_waitcnt lgkmcnt(0)" ::: "memory"); SBAR();
          vt[0][0] = cat8(a0, a1); vt[0][1] = cat8(a2, a3); vt[1][0] = cat8(a4, a5); vt[1][1] = cat8(a6, a7); }
#pragma unroll
        for (int dt = 0; dt < 8; ++dt) { s16x4 k0, k1, k2, k3;
            TRRD(k0, kbase, dt * 32); TRRD(k1, kbase, 16 * QS + dt * 32); TRRD(k2, kbase, 32 * QS + dt * 32); TRRD(k3, kbase, 48 * QS + dt * 32);
            asm volatile("s_waitcnt lgkmcnt(0)" ::: "memory"); SBAR();
            const bf16x8 ka = cat8(k0, k1), kb = cat8(k2, k3);
#pragma unroll
            for (int ct = 0; ct < 2; ++ct) { f32x4 s = st[dt][ct] * cd; s = __builtin_amdgcn_mfma_f32_16x16x32_bf16(ka, vt[0][ct], s, 0, 0, 0); s = __builtin_amdgcn_mfma_f32_16x16x32_bf16(kb, vt[1][ct], s, 0, 0, 0); st[dt][ct] = s; } }
        __syncthreads();
        if (ch + 1 < c0 + RCPS) { P1_WRITE(); }
        LDS_WAIT(); __syncthreads();
    }
    { unsigned long long* Lp = (unsigned long long*)(Lout + (size_t)(w * 16) * 256 + lane * 4);
#pragma unroll
      for (int dt = 0; dt < 8; ++dt)
#pragma unroll
          for (int ct = 0; ct < 2; ++ct) { const f32x4 v = st[dt][ct]; unsigned long long* d = Lp + (dt * 2 + ct) * 128;
              __hip_atomic_store(d, ((unsigned long long)__float_as_uint(v[1]) << 32) | __float_as_uint(v[0]), RLX_AGENT);
              __hip_atomic_store(d + 1, ((unsigned long long)__float_as_uint(v[3]) << 32) | __float_as_uint(v[2]), RLX_AGENT); } }
    asm volatile("s_waitcnt vmcnt(0)" ::: "memory");
    __syncthreads();
    if (tid == 0) __hip_atomic_store(flag, 1u, RLX_AGENT);
#undef P1_LOAD
#undef P1_WRITE
}
#undef TRRD
}
#ifndef STAMP_K
#define STAMP_K -1
#endif
#ifndef STAMP_OFF
#define STAMP_OFF 0
#endif
constexpr int N_PHASES = 2 + 8 * NLAYER;
struct Args { const float* in[19]; float* out; unsigned char* ws; int ph_lo, ph_hi; };

__device__ __forceinline__ void moe_tables(Frame& F, int l) {
    LAS int* tab = (LAS int*)(F.lds + MOE_OFF);
    __syncthreads();
    if (F.tid < 32) tab[F.tid] = (int)__hip_atomic_load(F.ctl + CW_CNT + l * 2048 + 64 * F.tid, RLX_AGENT);
    LDS_WAIT(); __syncthreads();
    if (F.tid == 0) { int sa = 0, ta = 0; for (int e = 0; e < 32; ++e) { const int t = (tab[e] + 255) >> 8; tab[32 + e] = sa; tab[64 + e] = ta; sa += t * 256; ta += t; } tab[96] = ta; }
    LDS_WAIT(); __syncthreads();
}

constexpr int MQ_P1 = 64 * (RSEG - 1), MQ_A7 = MQ_P1 + 64, MQ_R2 = MQ_A7 + 64 * RSEG, MQ_END = MQ_R2 + 64 * 7;
constexpr int CV_PER = 40;
constexpr int cv_total(int l) { return IT_REST + (l + 1 < NLAYER ? IT_WIN : 0); }
constexpr int cv_items(int l) { return (cv_total(l) + CV_PER - 1) / CV_PER; }
static_assert(256 + cv_items(0) <= MQ_END, "interleave pattern");
__device__ __forceinline__ void mixer_phase(int l) {
    const int NCV = cv_items(l);
    for (;;) {
        GAS unsigned char* wsg_ = (GAS unsigned char*)KWS(); asm volatile("" : "+s"(wsg_)); unsigned char* ws = (unsigned char*)wsg_;
        LAS unsigned char* ldsb = (LAS unsigned char*)0; volatile LAS unsigned* MISC = (volatile LAS unsigned*)(ldsb + MISC_OFF);
        const int tid = opaque_tid(), lane = tid & 63, wave = __builtin_amdgcn_readfirstlane(tid >> 6);
        __syncthreads();
        if (tid == 0) MISC[16] = __hip_atomic_fetch_add((gu32*)(ws + WS_CTL) + CW_QUEUE + 64 * l, 1u, RLX_AGENT);
        LDS_WAIT(); __syncthreads();
        int it = __builtin_amdgcn_readfirstlane((int)MISC[16]);
        if (it >= 256 && it < 256 + 2 * NCV) {
            if ((it - 256) & 1) { const int cvi = (it - 256) >> 1;
#pragma unroll 1
                for (int j = 0; j < CV_PER / NWAVES; ++j) { const int wi = cvi * CV_PER + j * NWAVES + wave;
                    if (wi < cv_total(l)) { const bool own = wi < IT_REST; cv_one(own ? l : l + 1, own ? IT_WIN + wi : wi - IT_REST, ws, lane); } }
                continue; }
            it = 256 + ((it - 256) >> 1); }
        else if (it >= 256 + 2 * NCV) it -= NCV;
        if (it >= MQ_P1 && it < MQ_A7 + 64) it = it < MQ_A7 ? it + 64 : it - 64;
        if (it >= MQ_END) { if (STAMP_K >= 0 && l == 0 && threadIdx.x == 0) atomicMin((unsigned long long*)(ws + WS_CTL + 65536) + 41, (unsigned long long)wall_clock64()); break; }
        const bf16_t* proj = (const bf16_t*)(ws + WS_PROJ);
        if (it < MQ_P1) { const int bh = it & 63, seg = it >> 6;
            ret::pass1(proj, (float*)(ws + WS_RLOC) + (size_t)(bh * RSEG + seg) * 32768, (gu32*)(ws + WS_CTL) + CW_RFLAG + ((l * 64 + bh) * RSEG + seg) * 16, bh >> 3, bh & 7, seg, ldsb); continue; }
        if (it >= MQ_A7 && it < MQ_R2) { const int j = it - MQ_A7, bh = j & 63, seg = j >> 6;
            ret::item(proj, (bf16_t*)(ws + WS_YR), bh >> 3, bh & 7, seg, (const float*)(ws + WS_RLOC) + (size_t)(bh * RSEG) * 32768, (gu32*)(ws + WS_CTL) + CW_RFLAG + ((l * 64 + bh) * RSEG) * 16, ldsb);
            if (STAMP_K >= 0 && l == 0 && threadIdx.x == 0) atomicMax((unsigned long long*)(ws + WS_CTL + 65536) + 40, (unsigned long long)wall_clock64());
            continue; }
        const int j = it < MQ_A7 ? it - MQ_P1 : 64 + (it - MQ_R2), x = 7 - (j >> 6), bh = j & 63, b = bh >> 3, h = bh & 7;
        { const int n = 256 * (x + 1); LAS float* bias = (LAS float*)(ldsb + fox::OFF_BIAS); LAS float* wt = (LAS float*)(ldsb + fox::OFF_WS);
          const float* logf = (const float*)(ws + WS_LOGF);
          f32x4 v = (f32x4){0.f, 0.f, 0.f, 0.f}; if (4 * tid < n) v = *(const f32x4*)(logf + (size_t)(b * 8 + h) * SEQ + 4 * tid);
          v[1] += v[0]; v[2] += v[1]; v[3] += v[2];
          float run = v[3];
#pragma unroll
          for (int o = 1; o < 64; o <<= 1) { const float t = __shfl_up(run, o); if (lane >= o) run += t; }
          if (lane == 63) wt[wave] = run;
          LDS_WAIT(); __syncthreads();
          float base = run - v[3];
          for (int ww = 0; ww < wave; ++ww) base += wt[ww];
          *(LAS f32x4*)(bias + 4 * tid) = (f32x4){-(v[0] + base) * LOG2E, -(v[1] + base) * LOG2E, -(v[2] + base) * LOG2E, -(v[3] + base) * LOG2E};
          LDS_WAIT(); __syncthreads(); }
        const size_t tok0 = (size_t)b * SEQ;
        fox::BlockRef cur;
        const size_t hrow0 = (size_t)(b * 8 + h) * SEQ;
        cur.Q = proj + PJ_FQ + (hrow0 + 256 * x) * 128; cur.K = proj + PJ_FK + hrow0 * 128; cur.V = proj + PJ_FV + hrow0 * 128;
        cur.O = (bf16_t*)(ws + WS_YF + (tok0 + 256 * x) * 1024 + h * 128); cur.P0 = 256 * x;
        fox::Seam S;
        fox::prime<128>(cur, (LAS char*)ldsb, S);
        fox::block<128, 1024>(cur, cur, (LAS char*)ldsb, S);
    }
}

__global__ void __launch_bounds__(NWAVES * 64, 2) hybrid_fwd(Args args) {
    extern __shared__ __attribute__((aligned(16))) unsigned char lds_raw[];
    { LAS unsigned char* l0 = (LAS unsigned char*)lds_raw;
      for (int u = threadIdx.x; u < (LDS_BYTES - LDSCTL_OFF) / 4; u += NWAVES * 64) ((LAS unsigned*)(l0 + LDSCTL_OFF))[u] = 0u;
      __syncthreads(); }
#if MK_N_LAUNCHES == 1
    { GAS unsigned char* wsg_ = (GAS unsigned char*)args.ws; asm volatile("" : "+s"(wsg_)); unsigned char* ws = (unsigned char*)wsg_; (void)xcd_barrier_post((unsigned*)((gu32*)(ws + WS_CTL) + CW_BAR), (volatile LAS unsigned*)((LAS unsigned char*)lds_raw + MISC_OFF) + 8); }
#define GRID_BAR() do { GAS unsigned char* wsg_ = (GAS unsigned char*)args.ws; asm volatile("" : "+s"(wsg_)); unsigned char* ws_ = (unsigned char*)wsg_; XcdBarrier bar_; bar_.bar = (unsigned*)((gu32*)(ws_ + WS_CTL) + CW_BAR); bar_.x = xb_xcc_id(); \
        bar_.st = (volatile LAS unsigned*)((LAS unsigned char*)lds_raw + MISC_OFF) + 8; xcd_barrier(bar_); } while (0)
#else
#define GRID_BAR() do {} while (0)
#endif
    const int lo = args.ph_lo, hi = args.ph_hi;
    if (STAMP_K >= 0 && blockIdx.x == 0 && threadIdx.x == 0) { GAS unsigned long long* st_ = (GAS unsigned long long*)((GAS unsigned char*)args.ws + WS_CTL + 65536); st_[0] = wall_clock64(); st_[41] = ~0ull; }
#define IN(k) (lo <= (k) && (k) < hi)
#define SEAM(k) do { if (IN(k) && IN((k) + 1)) GRID_BAR(); if (STAMP_K >= 0 && blockIdx.x == 0 && threadIdx.x == 0) { GAS unsigned long long* st_ = (GAS unsigned long long*)((GAS unsigned char*)args.ws + WS_CTL + 65536); st_[(k) + 1] = wall_clock64(); } } while (0)
#define SEAM_NOBAR(k) do { if (STAMP_K >= 0 && blockIdx.x == 0 && threadIdx.x == 0) { GAS unsigned long long* st_ = (GAS unsigned long long*)((GAS unsigned char*)args.ws + WS_CTL + 65536); st_[(k) + 1] = wall_clock64(); } } while (0)
#define PHASE_PTRS() GAS unsigned char* wsg_ = (GAS unsigned char*)args.ws; asm volatile("" : "+s"(wsg_)); unsigned char* ws = (unsigned char*)wsg_; Frame F; F.lds = (LAS unsigned char*)lds_raw; F.MISC = (volatile LAS unsigned*)(F.lds + MISC_OFF); \
    F.tid = opaque_tid(); F.lane = F.tid & 63; F.wave = __builtin_amdgcn_readfirstlane(F.tid >> 6); F.G = gridDim.x; F.bx = blockIdx.x; F.ws = ws; F.ctl = (gu32*)(ws + WS_CTL); F.out = (float*)(GAS float*)args.out; \
    float* hf = (float*)(ws + WS_HF); bf16_t* hb = (bf16_t*)(ws + WS_HB); bf16_t* proj = (bf16_t*)(ws + WS_PROJ); \
    bf16_t* yfox = (bf16_t*)(ws + WS_YF); bf16_t* yret = (bf16_t*)(ws + WS_YR); bf16_t* mg = (bf16_t*)(ws + WS_MG); \
    float* z1 = (float*)(ws + WS_Z1); bf16_t* hid = (bf16_t*)(ws + WS_HID); bf16_t* ffo = (bf16_t*)(ws + WS_FFO); \
    float* logf = (float*)(ws + WS_LOGF); int* route = (int*)(ws + WS_ROUTE); int* list = (int*)(ws + WS_LIST); float* wlist = (float*)(ws + WS_WLIST); \
    const float* cosT = (const float*)(ws + WS_ROPE); const float* sinT = cosT + SEQ * 64; \
    const LAS int* tab = (const LAS int*)(F.lds + MOE_OFF); unsigned char* wl = ws + WS_W; \
    (void)hf; (void)hb; (void)proj; (void)yfox; (void)yret; (void)mg; (void)z1; (void)hid; (void)ffo; (void)logf; (void)route; (void)list; (void)wlist; (void)cosT; (void)sinT; (void)tab; (void)wl
#ifndef PH_MASK
#define PH_MASK 0xFFFF
#endif
#define PHON(k) ((PH_MASK >> (k)) & 1)
#ifndef DUP_MASK
#define DUP_MASK 0
#endif
#define REPS(k) (((DUP_MASK >> (k)) & 1) ? 2 : 1)
    if (PHON(0) && IN(0)) { const int l = 0; PHASE_PTRS(); p0_weights_win(F); p0_tables(F); } SEAM(0);
    if (PHON(1) && IN(1)) { const int l = 0; PHASE_PTRS();
        LnArgs a{}; a.zin = INP(0); a.hf = nullptr; a.hb = hb; a.h8 = ws + WS_HB8; a.g = INP(1); a.b = INP(2);
        a.whi = (const bf16_t*)(ws + WS_SKW); a.wlo = a.whi + 16 * 2048; a.S12 = (const float*)(ws + WS_SKS); a.bfor = INP(4); a.logf = logf;
        for (int rep_ = 0; rep_ < REPS(1); ++rep_) ln_pass<0, 1, true>(F, a);
    } SEAM(1);
    if ((DUP_MASK >> 12) & 1) { for (int xb = 0; xb < 20; ++xb) GRID_BAR(); }

    { constexpr int l = 0;
        const int pb = 2 + 8 * l;
        if (PHON(2) && IN(pb + 0)) { PHASE_PTRS();
            gm::SchedDense S{(const char*)hb, (const char*)(wl + WL_WIN), 2048 * 2, 2048 * 2, 32, 64, N_BF16_TILES, F.G, F.bx, 1};
            gm::EpiProj E{proj, cosT, sinT, 1.f};
            for (int rep_ = 0; rep_ < REPS(2); ++rep_) gm::gemm_phase<true, 0>(F.lds, S, E);
            gm::SchedDense S8{(const char*)(ws + WS_HB8), (const char*)(wl + WL_WIN8), 2048, 2048, 16, 64, N_FP8_TILES, F.G, F.bx, 2};
            gm::EpiProj E8{proj, cosT, sinT, 1.f / W8_SCALE};
            for (int rep_ = 0; rep_ < REPS(2); ++rep_) gm::gemm_phase<true, 1>(F.lds, S8, E8);
        } SEAM(pb + 0);
        if (PHON(3) && IN(pb + 1)) { mixer_phase(l); } SEAM(pb + 1);
        if (PHON(4) && IN(pb + 2)) { PHASE_PTRS();
            gm::SchedMerge S{(const char*)yfox, (const char*)(wl + WL_WBF), (const char*)yret, (const char*)(wl + WL_WBR), 64, 8, F.G, F.bx};
            gm::EpiMerge E{proj, mg};
            for (int rep_ = 0; rep_ < REPS(4); ++rep_) gm::gemm_phase<true, 2>(F.lds, S, E);
        } SEAM(pb + 2);
        if (PHON(5) && IN(pb + 3)) { PHASE_PTRS();
            gm::SchedDense S{(const char*)mg, (const char*)(wl + WL_WOUT), 2048 * 2, 2048 * 2, 32, 64, 8, F.G, F.bx, 0};
            gm::EpiMix E{yret};
            for (int rep_ = 0; rep_ < REPS(5); ++rep_) gm::gemm_phase<true, 0>(F.lds, S, E);
        } SEAM(pb + 3);
        if (PHON(6) && IN(pb + 4)) { PHASE_PTRS();
            LnArgs a{}; a.zb = hb; a.mix = yret; a.hf = z1; a.hb = nullptr; a.h8 = ws + WS_MG; a.g = INP(8) + l * DM; a.b = INP(9) + l * DM;
            a.whi = (const bf16_t*)(ws + WS_SKW + 2 * SKW_FGT_BYTES + (size_t)l * SKW_RTR_BYTES); a.wlo = a.whi + 48 * 2048; a.S12 = (const float*)(ws + WS_SKS + (size_t)(2 + l) * 512);
            a.brg = INP(11) + l * 4; a.bre = INP(13) + l * 32; a.route_out = route; a.list = list; a.wlist = wlist; a.cnt = (unsigned*)(F.ctl + CW_CNT + l * 2048);
            ln_pass<1, 3, true>(F, a);
        } SEAM(pb + 4);
        if (PHON(7) && IN(pb + 5)) { PHASE_PTRS();
            moe_tables(F, l);
            gm::SchedMoe<true> S{tab, (const char*)(ws + WS_MG), (const char*)(wl + WL_WGU), list, 4, F.G, F.bx, nullptr};
            gm::EpiMoe1 E{(unsigned char*)hid, wlist, tab, F.ctl + CW_MFLAG + l * 160 * 16};
            for (int rep_ = 0; rep_ < REPS(7); ++rep_) gm::gemm_phase<true, 1>(F.lds, S, E);
        } SEAM_NOBAR(pb + 5);
        if (PHON(8) && IN(pb + 6)) { PHASE_PTRS();
            if (MK_N_LAUNCHES != 1) moe_tables(F, l);
            gm::SchedMoe<false> S{tab, (const char*)hid, (const char*)(wl + WL_WD), list, 8, F.G, F.bx, F.ctl + CW_MFLAG + l * 160 * 16};
            gm::EpiMoe2 E{ffo};
            for (int rep_ = 0; rep_ < REPS(8); ++rep_) gm::gemm_phase<true, 1>(F.lds, S, E);
        } SEAM(pb + 6);
        if (PHON(9) && IN(pb + 7)) { PHASE_PTRS();
            if (MK_N_LAUNCHES != 1) moe_tables(F, l);
            LnArgs a{}; a.zin = z1; a.ffo = ffo; a.route = route; a.tab = tab; a.g = INP(17) + l * DM; a.b = INP(18) + l * DM;
            if (l + 1 < NLAYER) { a.hf = nullptr; a.hb = hb; a.h8 = ws + WS_HB8; a.whi = (const bf16_t*)(ws + WS_SKW + (size_t)(l + 1) * SKW_FGT_BYTES); a.wlo = a.whi + 16 * 2048; a.S12 = (const float*)(ws + WS_SKS + (size_t)(l + 1) * 512);
                a.bfor = INP(4) + (l + 1) * 8; a.logf = logf; for (int rep_ = 0; rep_ < REPS(9); ++rep_) ln_pass<2, 1, true>(F, a); }
            else { a.hf = F.out; a.hb = nullptr; ln_pass<2, 1, false>(F, a); }
        } SEAM(pb + 7);
    }
    { constexpr int l = 1;
        const int pb = 2 + 8 * l;
        if (PHON(2) && IN(pb + 0)) { PHASE_PTRS();
            gm::SchedDense S{(const char*)hb, (const char*)(wl + WL_WIN), 2048 * 2, 2048 * 2, 32, 64, N_BF16_TILES, F.G, F.bx, 1};
            gm::EpiProj E{proj, cosT, sinT, 1.f};
            for (int rep_ = 0; rep_ < REPS(2); ++rep_) gm::gemm_phase<true, 0>(F.lds, S, E);
            gm::SchedDense S8{(const char*)(ws + WS_HB8), (const char*)(wl + WL_WIN8), 2048, 2048, 16, 64, N_FP8_TILES, F.G, F.bx, 2};
            gm::EpiProj E8{proj, cosT, sinT, 1.f / W8_SCALE};
            for (int rep_ = 0; rep_ < REPS(2); ++rep_) gm::gemm_phase<true, 1>(F.lds, S8, E8);
        } SEAM(pb + 0);
        if (PHON(3) && IN(pb + 1)) { mixer_phase(l); } SEAM(pb + 1);
        if (PHON(4) && IN(pb + 2)) { PHASE_PTRS();
            gm::SchedMerge S{(const char*)yfox, (const char*)(wl + WL_WBF), (const char*)yret, (const char*)(wl + WL_WBR), 64, 8, F.G, F.bx};
            gm::EpiMerge E{proj, mg};
            for (int rep_ = 0; rep_ < REPS(4); ++rep_) gm::gemm_phase<true, 2>(F.lds, S, E);
        } SEAM(pb + 2);
        if (PHON(5) && IN(pb + 3)) { PHASE_PTRS();
            gm::SchedDense S{(const char*)mg, (const char*)(wl + WL_WOUT), 2048 * 2, 2048 * 2, 32, 64, 8, F.G, F.bx, 0};
            gm::EpiMix E{yret};
            for (int rep_ = 0; rep_ < REPS(5); ++rep_) gm::gemm_phase<true, 0>(F.lds, S, E);
        } SEAM(pb + 3);
        if (PHON(6) && IN(pb + 4)) { PHASE_PTRS();
            LnArgs a{}; a.zb = hb; a.mix = yret; a.hf = z1; a.hb = nullptr; a.h8 = ws + WS_MG; a.g = INP(8) + l * DM; a.b = INP(9) + l * DM;
            a.whi = (const bf16_t*)(ws + WS_SKW + 2 * SKW_FGT_BYTES + (size_t)l * SKW_RTR_BYTES); a.wlo = a.whi + 48 * 2048; a.S12 = (const float*)(ws + WS_SKS + (size_t)(2 + l) * 512);
            a.brg = INP(11) + l * 4; a.bre = INP(13) + l * 32; a.route_out = route; a.list = list; a.wlist = wlist; a.cnt = (unsigned*)(F.ctl + CW_CNT + l * 2048);
            ln_pass<1, 3, true>(F, a);
        } SEAM(pb + 4);
        if (PHON(7) && IN(pb + 5)) { PHASE_PTRS();
            moe_tables(F, l);
            gm::SchedMoe<true> S{tab, (const char*)(ws + WS_MG), (const char*)(wl + WL_WGU), list, 4, F.G, F.bx, nullptr};
            gm::EpiMoe1 E{(unsigned char*)hid, wlist, tab, F.ctl + CW_MFLAG + l * 160 * 16};
            for (int rep_ = 0; rep_ < REPS(7); ++rep_) gm::gemm_phase<true, 1>(F.lds, S, E);
        } SEAM_NOBAR(pb + 5);
        if (PHON(8) && IN(pb + 6)) { PHASE_PTRS();
            if (MK_N_LAUNCHES != 1) moe_tables(F, l);
            gm::SchedMoe<false> S{tab, (const char*)hid, (const char*)(wl + WL_WD), list, 8, F.G, F.bx, F.ctl + CW_MFLAG + l * 160 * 16};
            gm::EpiMoe2 E{ffo};
            for (int rep_ = 0; rep_ < REPS(8); ++rep_) gm::gemm_phase<true, 1>(F.lds, S, E);
        } SEAM(pb + 6);
        if (PHON(9) && IN(pb + 7)) { PHASE_PTRS();
            if (MK_N_LAUNCHES != 1) moe_tables(F, l);
            LnArgs a{}; a.zin = z1; a.ffo = ffo; a.route = route; a.tab = tab; a.g = INP(17) + l * DM; a.b = INP(18) + l * DM;
            if (l + 1 < NLAYER) { a.hf = nullptr; a.hb = hb; a.h8 = ws + WS_HB8; a.whi = (const bf16_t*)(ws + WS_SKW + (size_t)(l + 1) * SKW_FGT_BYTES); a.wlo = a.whi + 16 * 2048; a.S12 = (const float*)(ws + WS_SKS + (size_t)(l + 1) * 512);
                a.bfor = INP(4) + (l + 1) * 8; a.logf = logf; for (int rep_ = 0; rep_ < REPS(9); ++rep_) ln_pass<2, 1, true>(F, a); }
            else { a.hf = F.out; a.hb = nullptr; ln_pass<2, 1, false>(F, a); }
        } SEAM(pb + 7);
    }
    if (STAMP_K >= 0) { __syncthreads(); if (blockIdx.x == 0 && threadIdx.x == 0) { asm volatile("s_waitcnt vmcnt(0)" ::: "memory"); GAS unsigned long long* st_ = (GAS unsigned long long*)((GAS unsigned char*)args.ws + WS_CTL + 65536);
        ((GAS float*)args.out)[0] += (float)((STAMP_K == 100 ? st_[40] - st_[3] : STAMP_K == 101 ? st_[41] - st_[3] : st_[STAMP_K + 1] - st_[STAMP_K])) * 0.01f * 0.01f; } }
#undef IN
#undef SEAM
#undef GRID_BAR
}

extern "C" void kernel_launch(void* const* d_in, const int* in_sizes, int n_in, void* d_out, int out_size, void* d_ws, size_t ws_size, hipStream_t stream) {
    static int grid = 0;
    if (grid == 0) {
        if (n_in != 19 || out_size != NTOK * DM || ws_size < WS_END) { fprintf(stderr, "kernel_launch: unexpected problem (n_in %d, out %d, ws %zu)\n", n_in, out_size, ws_size); grid = -1; }
        int dev = 0, cus = 0;
        if (grid == 0 && (hipGetDevice(&dev) != hipSuccess || hipDeviceGetAttribute(&cus, hipDeviceAttributeMultiprocessorCount, dev) != hipSuccess)) grid = -1;
        if (grid == 0 && hipFuncSetAttribute((const void*)hybrid_fwd, hipFuncAttributeMaxDynamicSharedMemorySize, LDS_BYTES) != hipSuccess) { fprintf(stderr, "kernel_launch: hipFuncSetAttribute failed\n"); grid = -1; }
        (void)hipGetLastError();
        if (grid == 0) grid = cus;
    }
    if (grid < 0) { (void)hipMemsetAsync(d_out, 0xFF, (size_t)out_size * 4, stream); return; }
    if (hipMemsetAsync((char*)d_ws + WS_CTL, 0, CTL_ZERO_BYTES, stream) != hipSuccess) return;
    Args a{};
    for (int i = 0; i < 19; ++i) a.in[i] = (const float*)d_in[i];
    a.out = (float*)d_out; a.ws = (unsigned char*)d_ws;
#if MK_N_LAUNCHES == 1
    a.ph_lo = 0; a.ph_hi = N_PHASES;
    hipLaunchKernelGGL(hybrid_fwd, dim3(grid), dim3(NWAVES * 64), LDS_BYTES, stream, a);
#else
    for (int ph = 0; ph < N_PHASES; ++ph) { a.ph_lo = ph; a.ph_hi = ph + 1; hipLaunchKernelGGL(hybrid_fwd, dim3(grid), dim3(NWAVES * 64), LDS_BYTES, stream, a); }
#endif
}
```
